# Optimizing an MI355X kernel written in HIP

```python
import math
import jax, jax.numpy as jnp
from jax import lax
import numpy as np

D_MODEL = 1024
BATCH = 16
SEQ = 4096
DEPTH = 2

HEAD_DIM = 64
ROT_DIM = HEAD_DIM // 4
ROPE_THETA = 500000.0
N_EVEN = (DEPTH + 1) // 2
N_ODD = DEPTH // 2
BLK = 128
A_HEADS = 8
A_PATTERNS = ((128, 1), (512, 4), (2048, 16))
A_WIDTH = A_HEADS * HEAD_DIM
B_HEADS = 4
B_QK_WIDTH = B_HEADS * 2 * HEAD_DIM
B_WIDTH = B_HEADS * 2 * HEAD_DIM
QKV_COLS = 3 * A_WIDTH + 2 * B_QK_WIDTH + B_WIDTH
MIX_WIDTH = A_WIDTH + B_WIDTH
RWKV_HEADS = D_MODEL // HEAD_DIM
DECAY_LORA = 64
ICLR_LORA = 64
GATE_LORA = 160
GN_EPS = 64e-5
D_FF = 4 * D_MODEL
EPS = 1e-5

kernel_name = "hybrid_dilated_diff_rwkv7_block"


def rmsnorm(x, g):
    xf = x.astype(jnp.float32)
    y = xf * lax.rsqrt(jnp.mean(xf * xf, axis=-1, keepdims=True) + EPS)
    return (y * g.astype(jnp.float32)).astype(x.dtype)


def partial_rope(t, pos):
    half = ROT_DIM // 2
    inv_freq = ROPE_THETA ** (-jnp.arange(half, dtype=jnp.float32) / half)
    ang = pos.astype(jnp.float32)[:, None] * inv_freq[None, :]
    cos, sin = jnp.cos(ang), jnp.sin(ang)
    tf = t.astype(jnp.float32)
    t1, t2 = tf[..., :half], tf[..., half:ROT_DIM]
    out = jnp.concatenate([t1 * cos - t2 * sin, t2 * cos + t1 * sin, tf[..., ROT_DIM:]], axis=-1)
    return out.astype(t.dtype)


def dilated_window_attention(q, k, v, window, dilation):
    B, H, S, Dh = q.shape
    w_sub = window // dilation
    L = S // dilation
    nb = -(-L // BLK)
    Lp = nb * BLK

    def strided(t):
        t = t.reshape(B, H, L, dilation, Dh).transpose(0, 1, 3, 2, 4)
        return jnp.pad(t, ((0, 0), (0, 0), (0, 0), (0, Lp - L), (0, 0)))

    def banded(t):
        tb = jnp.pad(strided(t), ((0, 0), (0, 0), (0, 0), (BLK, 0), (0, 0)))
        tb = tb.reshape(B, H, dilation, nb + 1, BLK, Dh)
        return jnp.concatenate([tb[:, :, :, :-1], tb[:, :, :, 1:]], axis=4)

    qs = strided(q).reshape(B, H, dilation, nb, BLK, Dh)
    kw, vw = banded(k), banded(v)
    s = jnp.einsum('bhrnqd,bhrnkd->bhrnqk', qs, kw).astype(jnp.float32)
    qi = jnp.arange(BLK)[None, :, None]
    kc = jnp.arange(2 * BLK)[None, None, :]
    blk = jnp.arange(nb)[:, None, None]
    dist = BLK + qi - kc
    mask = (dist >= 0) & (dist <= w_sub) & ((blk - 1) * BLK + kc >= 0)
    s = jnp.where(mask, s, -jnp.inf)
    lse = jax.nn.logsumexp(s, axis=-1)
    p = jnp.exp(s - lse[..., None])
    o = jnp.einsum('bhrnqk,bhrnkd->bhrnqd', p.astype(v.dtype), vw)
    o = o.reshape(B, H, dilation, Lp, Dh)[:, :, :, :L].transpose(0, 1, 3, 2, 4).reshape(B, H, S, Dh)
    lse = lse.reshape(B, H, dilation, Lp)[..., :L].transpose(0, 1, 3, 2).reshape(B, H, S)
    return o, lse


def mixture_of_dilations(q, k, v):
    outs, lses = [], []
    for window, dilation in A_PATTERNS:
        o, l = dilated_window_attention(q, k, v, window, dilation)
        outs.append(o.astype(jnp.float32))
        lses.append(l)
    wts = jax.nn.softmax(jnp.stack(lses), axis=0)
    return jnp.sum(wts[..., None] * jnp.stack(outs), axis=0).astype(q.dtype)


def differential_attention(q, k, v, lam, gain, lam_init):
    B, H, _, S, Dh = q.shape
    nq = S // BLK
    qb = jnp.moveaxis(q.reshape(B, H, 2, nq, BLK, Dh), 3, 0)
    kpos = jnp.arange(S)

    def block(args):
        qblk, n = args
        s = jnp.einsum('bhcqd,bhckd->bhcqk', qblk, k).astype(jnp.float32)
        qpos = n * BLK + jnp.arange(BLK)
        s = jnp.where(qpos[:, None] >= kpos[None, :], s, -jnp.inf)
        p = jax.nn.softmax(s, axis=-1)
        attn = p[:, :, 0] - lam * p[:, :, 1]
        return jnp.einsum('bhqk,bhkd->bhqd', attn.astype(v.dtype), v)

    o = lax.map(block, (qb, jnp.arange(nq)))
    o = jnp.moveaxis(o, 0, 2).reshape(B, H, S, 2 * Dh)
    return rmsnorm(o, gain) * (1.0 - lam_init)


def hybrid_attention(h, w_in, w_out, lam_p, subln, lam_init):
    B, S, _ = h.shape
    pos = jnp.arange(S)
    scale = HEAD_DIM ** -0.5
    proj = h @ w_in
    cuts = [A_WIDTH, 2 * A_WIDTH, 3 * A_WIDTH, 3 * A_WIDTH + B_QK_WIDTH, 3 * A_WIDTH + 2 * B_QK_WIDTH]
    aq, ak, av, bq, bk, bv = jnp.split(proj, cuts, axis=-1)

    def heads(t, n):
        return t.reshape(B, S, n, -1).transpose(0, 2, 1, 3)

    aq = partial_rope(heads(aq, A_HEADS), pos) * scale
    ak = partial_rope(heads(ak, A_HEADS), pos)
    oa = mixture_of_dilations(aq, ak, heads(av, A_HEADS))
    oa = oa.transpose(0, 2, 1, 3).reshape(B, S, A_WIDTH)

    def two_maps(t):
        return t.reshape(B, S, B_HEADS, 2, HEAD_DIM).transpose(0, 2, 3, 1, 4)

    bq = partial_rope(two_maps(bq), pos) * scale
    bk = partial_rope(two_maps(bk), pos)
    lp = lam_p.astype(jnp.float32)
    lam = jnp.exp(jnp.sum(lp[0] * lp[1])) - jnp.exp(jnp.sum(lp[2] * lp[3])) + lam_init
    ob = differential_attention(bq, bk, heads(bv, B_HEADS), lam, subln, lam_init)
    ob = ob.transpose(0, 2, 1, 3).reshape(B, S, B_WIDTH)

    return jnp.concatenate([oa, ob], axis=-1) @ w_out


def rwkv7_time_mix(h, mu, w_r, w_k, w_v, w_o, w0, w1, w2, a0, a1, a2, g1, g2, k_k, k_a, r_k, ln_w, ln_b):
    B, S, C = h.shape
    H, N = RWKV_HEADS, HEAD_DIM
    xx = jnp.pad(h, ((0, 0), (1, 0), (0, 0)))[:, :-1] - h
    xr, xw, xk, xv, xa, xg = [h + xx * mu[i] for i in range(6)]
    r = xr @ w_r
    k = xk @ w_k
    v = xv @ w_v
    w = -jax.nn.softplus(-(w0 + jnp.tanh(xw @ w1) @ w2)) - 0.5
    decay = jnp.exp(-jnp.exp(w.astype(jnp.float32)))
    a = jax.nn.sigmoid(a0 + (xa @ a1) @ a2)
    g = jax.nn.sigmoid(xg @ g1) @ g2
    kk = (k * k_k).reshape(B, S, H, N).astype(jnp.float32)
    kk = kk / jnp.maximum(jnp.sqrt(jnp.sum(kk * kk, axis=-1, keepdims=True)), 1e-12)
    k = k * (1.0 + (a - 1.0) * k_a)

    def hd(t):
        return t.reshape(B, S, H, N).astype(jnp.float32)

    r_h, k_h, v_h, a_h = hd(r), hd(k), hd(v), hd(a)
    seqs = tuple(jnp.moveaxis(t, 1, 0) for t in (r_h, hd(decay), k_h, v_h, -kk, kk * a_h))

    def step(state, inp):
        r_t, w_t, k_t, v_t, a_t, b_t = inp
        sa = jnp.einsum('bhij,bhj->bhi', state, a_t)
        state = state * w_t[:, :, None, :] + sa[..., None] * b_t[:, :, None, :] + v_t[..., None] * k_t[:, :, None, :]
        return state, jnp.einsum('bhij,bhj->bhi', state, r_t)

    _, y = lax.scan(step, jnp.zeros((B, H, N, N), jnp.float32), seqs)
    y = jnp.moveaxis(y, 0, 1)
    mean = jnp.mean(y, axis=-1, keepdims=True)
    var = jnp.mean(jnp.square(y - mean), axis=-1, keepdims=True)
    yn = ((y - mean) * lax.rsqrt(var + GN_EPS)).reshape(B, S, C) * ln_w + ln_b
    bonus = jnp.sum(r_h * k_h * r_k.astype(jnp.float32), axis=-1, keepdims=True) * v_h
    out = (yn + bonus.reshape(B, S, C)).astype(h.dtype)
    return (out * g) @ w_o


def squared_relu_mlp(h, w1, w2):
    return jnp.square(jax.nn.relu(h @ w1)) @ w2


def setup_inputs(seed: int = 0) -> dict:
    key = jax.random.key(seed)
    ks = iter(jax.random.split(key, 40))
    C = D_MODEL

    def nrm(shape, scale):
        return jax.random.normal(next(ks), shape, jnp.float32) * scale

    def gain(shape, base=1.0):
        return base + nrm(shape, 0.02)

    return {
        "x": nrm((BATCH, SEQ, C), 1.0),
        "norm_mix": gain((DEPTH, C)),
        "norm_mlp": gain((DEPTH, C)),
        "norm_final": gain((C,)),
        "attn_w_in": nrm((N_EVEN, C, QKV_COLS), C ** -0.5),
        "attn_w_out": nrm((N_EVEN, MIX_WIDTH, C), MIX_WIDTH ** -0.5),
        "diff_lambda": nrm((N_EVEN, 4, HEAD_DIM), 0.1),
        "diff_subln": gain((N_EVEN, 2 * HEAD_DIM)),
        "rwkv_mu": jax.random.uniform(next(ks), (N_ODD, 6, C), jnp.float32),
        "rwkv_w_r": nrm((N_ODD, C, C), C ** -0.5),
        "rwkv_w_k": nrm((N_ODD, C, C), C ** -0.5),
        "rwkv_w_v": nrm((N_ODD, C, C), C ** -0.5),
        "rwkv_w_o": nrm((N_ODD, C, C), C ** -0.5),
        "rwkv_w0": jax.random.uniform(next(ks), (N_ODD, C), jnp.float32, -6.0, -1.0),
        "rwkv_w1": nrm((N_ODD, C, DECAY_LORA), C ** -0.5),
        "rwkv_w2": nrm((N_ODD, DECAY_LORA, C), 0.1 * DECAY_LORA ** -0.5),
        "rwkv_a0": nrm((N_ODD, C), 0.1),
        "rwkv_a1": nrm((N_ODD, C, ICLR_LORA), C ** -0.5),
        "rwkv_a2": nrm((N_ODD, ICLR_LORA, C), 0.1 * ICLR_LORA ** -0.5),
        "rwkv_g1": nrm((N_ODD, C, GATE_LORA), C ** -0.5),
        "rwkv_g2": nrm((N_ODD, GATE_LORA, C), GATE_LORA ** -0.5),
        "rwkv_k_k": gain((N_ODD, C), 0.85),
        "rwkv_k_a": gain((N_ODD, C)),
        "rwkv_r_k": nrm((N_ODD, RWKV_HEADS, HEAD_DIM), 0.1),
        "rwkv_ln_w": gain((N_ODD, C)),
        "rwkv_ln_b": nrm((N_ODD, C), 0.02),
        "mlp_w1": nrm((DEPTH, C, D_FF), C ** -0.5),
        "mlp_w2": nrm((DEPTH, D_FF, C), D_FF ** -0.5),
    }


def reference(x, norm_mix, norm_mlp, norm_final, attn_w_in, attn_w_out, diff_lambda, diff_subln,
              rwkv_mu, rwkv_w_r, rwkv_w_k, rwkv_w_v, rwkv_w_o, rwkv_w0, rwkv_w1, rwkv_w2,
              rwkv_a0, rwkv_a1, rwkv_a2, rwkv_g1, rwkv_g2, rwkv_k_k, rwkv_k_a, rwkv_r_k,
              rwkv_ln_w, rwkv_ln_b, mlp_w1, mlp_w2):
    h = x
    for layer in range(DEPTH):
        j = layer // 2
        hn = rmsnorm(h, norm_mix[layer])
        if layer % 2 == 0:
            lam_init = 0.8 - 0.6 * math.exp(-0.3 * layer)
            mix = hybrid_attention(hn, attn_w_in[j], attn_w_out[j], diff_lambda[j], diff_subln[j], lam_init)
        else:
            mix = rwkv7_time_mix(hn, rwkv_mu[j], rwkv_w_r[j], rwkv_w_k[j], rwkv_w_v[j], rwkv_w_o[j],
                                 rwkv_w0[j], rwkv_w1[j], rwkv_w2[j], rwkv_a0[j], rwkv_a1[j], rwkv_a2[j],
                                 rwkv_g1[j], rwkv_g2[j], rwkv_k_k[j], rwkv_k_a[j], rwkv_r_k[j],
                                 rwkv_ln_w[j], rwkv_ln_b[j])
        h = h + mix
        h = h + squared_relu_mlp(rmsnorm(h, norm_mlp[layer]), mlp_w1[layer], mlp_w2[layer])
    return rmsnorm(h, norm_final)
```

```cpp
#include <hip/hip_runtime.h>
#include <hip/hip_cooperative_groups.h>
#include <cstdio>
#include <cstdint>
namespace cg = cooperative_groups;
namespace pg8 {
#define PG8_LAS __attribute__((address_space(3)))
typedef unsigned short bf16_t;
typedef short bf16x8 __attribute__((ext_vector_type(8)));
typedef float f32x4 __attribute__((ext_vector_type(4)));
typedef unsigned u32x4 __attribute__((ext_vector_type(4)));
constexpr int BM = 256, BK = 64, HALF = 128, HTB = HALF * BK * 2  , STAGE_BYTES = 8 * HTB, NXCD = 8, WGM = 8;

__host__ __device__ __forceinline__ int lds_byte(int r, int c) { const int st = (r >> 4) * 2 + (c >> 5), rr = r & 15, cc = c & 31, ob = rr * 64 + cc * 2; return st * 1024 + (ob ^ (((ob >> 9) & 1) << 5)); }
__host__ __device__ __forceinline__ void stage_rc(int b, int& R, int& C) { const int st = b / 1024, sb = b % 1024, swz = sb ^ (((sb >> 9) & 1) << 5); R = (st >> 1) * 16 + swz / 64; C = (st & 1) * 32 + (swz % 64) / 2; }
__host__ __device__ __forceinline__ int perm32(int rho) { const int n = rho >> 4, i = rho & 15; return 8 * (i >> 2) + 4 * n + (i & 3); }

struct Unit { int pm, pn; };
struct Gemm { const bf16_t* A; const bf16_t* Bt; int M, N, K; };

struct StaticOrder {
    int nM, nN, nwg, G, c;
    __host__ __device__ void init(int M, int N, int G_, int c_) { nM = M / BM; nN = N / BM; nwg = nM * nN; G = G_; c = c_; }
    __host__ __device__ bool next(int i, Unit& u) const {
        const long L = (long)i * G + c; if (L >= nwg) return false;
        int wgid = (int)L; { const int q = nwg / NXCD, r = nwg % NXCD, xcd = wgid % NXCD, off = wgid / NXCD; wgid = (xcd < r ? xcd * (q + 1) : r * (q + 1) + (xcd - r) * q) + off; }
        const int nig = WGM * nN, gid = wgid / nig, fm = gid * WGM, gsz = (nM - fm) < WGM ? (nM - fm) : WGM;
        u.pm = fm + ((wgid % nig) % gsz); u.pn = (wgid % nig) / gsz; return true;
    }
    __device__ __forceinline__ void a_ready(const Unit&) const {}
    __device__ __forceinline__ void done(const Unit&) const {}
};

__device__ __forceinline__ unsigned cvt_pk_bf16(float lo, float hi) { unsigned r; asm volatile("v_cvt_pk_bf16_f32 %0, %1, %2" : "=v"(r) : "v"(lo), "v"(hi)); return r; }
typedef float f32x2 __attribute__((ext_vector_type(2)));
typedef unsigned u32x4 __attribute__((ext_vector_type(4)));
typedef _Float16 f16x2 __attribute__((ext_vector_type(2)));
__device__ __forceinline__ unsigned cvt_pk_f16(float lo, float hi) { f32x2 v = {lo, hi}; f16x2 h = __builtin_convertvector(v, f16x2); return __builtin_bit_cast(unsigned, h); }
enum { M_PLAIN = 0, M_RELU2 = 1, M_TANH = 2, M_SIGMOID = 3, M_QKV = 4, M_ASIG = 5, M_WLOG = 6 };
template <int MODE> struct Epi16 {
    static constexpr bool PERM = true, AFTER_DRAIN = false;
    bf16_t* O; int ldc; const float* vec;
    __device__ __forceinline__ void operator()(const f32x4 (&acc)[2][2][4][2], const Unit& u, int wr, int wc, int fr, int fq) const {
        const int row0 = u.pm * BM + wr * 64 + fr;
        const int col0 = u.pn * BM + wc * 32 + 8 * fq;
        const int sec = u.pn >> 1;
        const bool rope = (MODE == M_QKV) && (sec != 2) && (sec != 5);
        const bool rot_wave = rope && ((wc & 1) == 0);
        const float qs = (MODE == M_QKV && (sec == 0 || sec == 3)) ? (0.125f * 1.4426950408889634f) : 1.0f;
        f32x4 bias_[2][2];
        if (MODE == M_ASIG || MODE == M_WLOG) {
#pragma unroll
            for (int bj = 0; bj < 2; ++bj) { bias_[bj][0] = *(const f32x4*)(vec + col0 + bj * HALF); bias_[bj][1] = *(const f32x4*)(vec + col0 + bj * HALF + 4); }
        }
#pragma unroll
        for (int ai = 0; ai < 2; ++ai) {
            f32x4 tab[4][4];
            if (MODE == M_QKV) { if (rot_wave) {
#pragma unroll
                for (int m = 0; m < 4; ++m) { const float* t = vec + (size_t)((row0 + ai * HALF + m * 16) & 4095) * 16;
#pragma unroll
                    for (int q = 0; q < 4; ++q) tab[m][q] = *(const f32x4*)(t + 4 * q); } } }
#pragma unroll
            for (int m = 0; m < 4; ++m) {
                const int row = row0 + ai * HALF + m * 16;
                bf16_t* rowp = O + (size_t)row * ldc + col0;
                f32x4 cs0 = {1.f, 1.f, 1.f, 1.f}, cs1 = cs0, sn0 = {0.f, 0.f, 0.f, 0.f}, sn1 = sn0;
                if (MODE == M_QKV) { if (rot_wave) { cs0 = tab[m][0]; cs1 = tab[m][1]; sn0 = tab[m][2]; sn1 = tab[m][3]; } }
#pragma unroll
                for (int bj = 0; bj < 2; ++bj) {
                    f32x4 v0 = acc[ai][bj][m][0], v1 = acc[ai][bj][m][1];
                    if (MODE == M_QKV) {
                        if (rot_wave) {
                            f32x4 p0, p1;
#pragma unroll
                            for (int e = 0; e < 4; ++e) { p0[e] = __shfl_xor(v0[e], 16); p1[e] = __shfl_xor(v1[e], 16); }
                            if (fq < 2) { const float sg = (fq == 0) ? -1.f : 1.f; v0 = v0 * cs0 + (p0 * sn0) * sg; v1 = v1 * cs1 + (p1 * sn1) * sg; }
                        }
                        v0 = v0 * qs; v1 = v1 * qs;
                    }
                    if (MODE == M_RELU2) {
#pragma unroll
                        for (int e = 0; e < 4; ++e) { const float a = fmaxf(v0[e], 0.f), b = fmaxf(v1[e], 0.f); v0[e] = a * a; v1[e] = b * b; }
                    }
                    if (MODE == M_TANH) {
#pragma unroll
                        for (int e = 0; e < 4; ++e) { v0[e] = 1.f - 2.f * __builtin_amdgcn_rcpf(1.f + __builtin_amdgcn_exp2f(fminf(v0[e] * 2.885390081777927f, 60.f))); v1[e] = 1.f - 2.f * __builtin_amdgcn_rcpf(1.f + __builtin_amdgcn_exp2f(fminf(v1[e] * 2.885390081777927f, 60.f))); }
                    }
                    if (MODE == M_SIGMOID) {
#pragma unroll
                        for (int e = 0; e < 4; ++e) { v0[e] = 1.f / (1.f + __expf(-v0[e])); v1[e] = 1.f / (1.f + __expf(-v1[e])); }
                    }
                    if (MODE == M_ASIG) {
                        const f32x4 b0 = bias_[bj][0], b1 = bias_[bj][1];
#pragma unroll
                        for (int e = 0; e < 4; ++e) { v0[e] = 1.f / (1.f + __expf(-(v0[e] + b0[e]))); v1[e] = 1.f / (1.f + __expf(-(v1[e] + b1[e]))); }
                    }
                    u32x4 w;
                    if (MODE == M_WLOG) {
                        const f32x4 b0 = bias_[bj][0], b1 = bias_[bj][1];
#pragma unroll
                        for (int e = 0; e < 4; ++e) {
                            const float x0 = -(v0[e] + b0[e]), x1 = -(v1[e] + b1[e]);
                            const float s0 = fmaxf(x0, 0.f) + 0.6931471805599453f * __builtin_amdgcn_logf(1.f + __builtin_amdgcn_exp2f(-1.4426950408889634f * fabsf(x0)));
                            const float s1 = fmaxf(x1, 0.f) + 0.6931471805599453f * __builtin_amdgcn_logf(1.f + __builtin_amdgcn_exp2f(-1.4426950408889634f * fabsf(x1)));
                            v0[e] = -__builtin_amdgcn_exp2f(-1.4426950408889634f * (s0 + 0.5f)); v1[e] = -__builtin_amdgcn_exp2f(-1.4426950408889634f * (s1 + 0.5f));
                        }
                        w.x = cvt_pk_f16(v0[0], v0[1]); w.y = cvt_pk_f16(v0[2], v0[3]); w.z = cvt_pk_f16(v1[0], v1[1]); w.w = cvt_pk_f16(v1[2], v1[3]);
                    } else {
                        w.x = cvt_pk_bf16(v0[0], v0[1]); w.y = cvt_pk_bf16(v0[2], v0[3]); w.z = cvt_pk_bf16(v1[0], v1[1]); w.w = cvt_pk_bf16(v1[2], v1[3]);
                    }
                    *(u32x4*)(rowp + bj * HALF) = w;
                }
            }
        }
    }
};
struct EpiRes {
    static constexpr bool PERM = false, AFTER_DRAIN = false;
    const float* res; float* out; int ldc;
    __device__ __forceinline__ void operator()(const f32x4 (&acc)[2][2][4][2], const Unit& u, int wr, int wc, int fr, int fq) const {
        const int row0 = u.pm * BM + wr * 64 + fr, col0 = u.pn * BM + wc * 32 + 4 * fq;
#pragma unroll
        for (int ai = 0; ai < 2; ++ai)
#pragma unroll
            for (int m = 0; m < 4; ++m) {
                const size_t off = (size_t)(row0 + ai * HALF + m * 16) * ldc + col0;
#pragma unroll
                for (int bj = 0; bj < 2; ++bj)
#pragma unroll
                    for (int n = 0; n < 2; ++n) { const f32x4 r = *(const f32x4*)(res + off + bj * HALF + n * 16); *(f32x4*)(out + off + bj * HALF + n * 16) = r + acc[ai][bj][m][n]; }
            }
    }
};
template <class Epi, class Sched, bool ALIGN_EPI = false, bool SP2 = false>
__device__ __forceinline__ void gemm_phase(PG8_LAS unsigned char* lds, const Gemm g, const Sched& S, const Epi& E) {
    int tid = threadIdx.x; asm volatile("" : "+v"(tid)); const int wid = __builtin_amdgcn_readfirstlane(tid >> 6), lane = tid & 63, wr = wid >> 2, wc = wid & 3, fr = lane & 15, fq = lane >> 4;
    const int K = g.K, nt = K / BK;
    unsigned voffA[2], voffB[2];
#pragma unroll
    for (int i = 0; i < 2; ++i) { int R, C; stage_rc(tid * 16 + i * 8192, R, C); const int Rb = Epi::PERM ? ((R & ~31) + perm32(R & 31)) : R;
        voffA[i] = (unsigned)(R * K + C) * 2u; voffB[i] = (unsigned)(Rb * K + C) * 2u; }
    const size_t kstep = (size_t)(BK * 2);
    const size_t hstep = (size_t)HALF * K * 2;
    const size_t tstep = 2 * hstep;
    const unsigned ldsw = (unsigned)wid * 1024u;
    const int aoff = lds_byte(wr * 64 + fr, fq * 8), boff = lds_byte(wc * 32 + fr, fq * 8);
#define PG8_SA(b, h) (((b) * 2 + (h)) * HTB)
#define PG8_SB(b, h) ((4 + (b) * 2 + (h)) * HTB)
#define PG8_STAGE(bufoff, gbase, voff) do { _Pragma("unroll") for (int _i = 0; _i < 2; ++_i) \
        __builtin_amdgcn_global_load_lds((const unsigned*)((const char*)(gbase) + (voff)[_i]), (PG8_LAS unsigned*)(lds + (bufoff) + ldsw + _i * 8192), 16, 0, 0); } while (0)
#define PG8_LDA(dst, b, h) do { _Pragma("unroll") for (int m = 0; m < 4; ++m) _Pragma("unroll") for (int k = 0; k < 2; ++k) dst[m][k] = *(const PG8_LAS bf16x8*)(lds + PG8_SA(b, h) + aoff + m * 2048 + k * 1024); } while (0)
#define PG8_LDB(dst, b, h) do { _Pragma("unroll") for (int n = 0; n < 2; ++n) _Pragma("unroll") for (int k = 0; k < 2; ++k) dst[n][k] = *(const PG8_LAS bf16x8*)(lds + PG8_SB(b, h) + boff + n * 2048 + k * 1024); } while (0)
#define PG8_MMA(ai, bj, At, Bt) do { __builtin_amdgcn_s_setprio(1); _Pragma("unroll") for (int m = 0; m < 4; ++m) _Pragma("unroll") for (int n = 0; n < 2; ++n) _Pragma("unroll") for (int k = 0; k < 2; ++k) \
        acc[ai][bj][m][n] = __builtin_amdgcn_mfma_f32_16x16x32_bf16(Bt[n][k], At[m][k], acc[ai][bj][m][n], 0, 0, 0); __builtin_amdgcn_s_setprio(0); } while (0)
#define PG8_WAIT_V(n) asm volatile("s_waitcnt vmcnt(" #n ")" ::: "memory")
#define PG8_WAIT_L(n) asm volatile("s_waitcnt lgkmcnt(" #n ")" ::: "memory")
#define PG8_BAR __builtin_amdgcn_s_barrier()
#define PG8_SCHED __builtin_amdgcn_sched_barrier(0)
    Unit cur, nxt; int ui = 0;
    if (!S.next(0, cur)) return;
    f32x4 acc[2][2][4][2];
#pragma unroll
    for (int a = 0; a < 2; ++a)
#pragma unroll
        for (int b = 0; b < 2; ++b)
#pragma unroll
            for (int m = 0; m < 4; ++m)
#pragma unroll
                for (int n = 0; n < 2; ++n) acc[a][b][m][n] = (f32x4){0.f, 0.f, 0.f, 0.f};
    bf16x8 At[4][2], B0[2][2], B1[2][2];
    const char* cA = (const char*)g.A + (size_t)cur.pm * tstep; const char* cB = (const char*)g.Bt + (size_t)cur.pn * tstep;
    S.a_ready(cur);
    if constexpr (SP2) {
        PG8_STAGE(PG8_SB(0, 0), cB, voffB); PG8_STAGE(PG8_SB(0, 1), cB + hstep, voffB); PG8_STAGE(PG8_SA(0, 0), cA, voffA); PG8_STAGE(PG8_SA(0, 1), cA + hstep, voffA);
        if (wr == 1) PG8_BAR;
        PG8_WAIT_V(2); PG8_BAR;
        PG8_STAGE(PG8_SB(1, 0), cB + kstep, voffB); PG8_STAGE(PG8_SA(1, 0), cA + kstep, voffA); PG8_STAGE(PG8_SB(1, 1), cB + hstep + kstep, voffB);
        PG8_WAIT_V(6); PG8_BAR;
    } else {
        PG8_STAGE(PG8_SB(0, 0), cB, voffB); PG8_STAGE(PG8_SA(0, 0), cA, voffA); PG8_STAGE(PG8_SB(0, 1), cB + hstep, voffB); PG8_STAGE(PG8_SA(0, 1), cA + hstep, voffA);
        if (wr == 1) PG8_BAR;
        PG8_WAIT_V(4); PG8_BAR;
        PG8_STAGE(PG8_SB(1, 0), cB + kstep, voffB); PG8_STAGE(PG8_SA(1, 0), cA + kstep, voffA); PG8_STAGE(PG8_SB(1, 1), cB + hstep + kstep, voffB);
        PG8_WAIT_V(6); PG8_BAR;
    }
    for (;;) {
        const bool has_next = S.next(ui + 1, nxt);
        const char* nA = has_next ? (const char*)g.A + (size_t)nxt.pm * tstep : cA; const char* nB = has_next ? (const char*)g.Bt + (size_t)nxt.pn * tstep : cB;
        for (int t = 0; t < nt; t += 2) {
            const bool last = (t == nt - 2);
            const char* a1 = cA + (size_t)(t + 1) * kstep;
            const char* a2 = last ? nA : cA + (size_t)(t + 2) * kstep; const char* b2 = last ? nB : cB + (size_t)(t + 2) * kstep;
            const char* a3 = a2 + kstep; const char* b3 = b2 + kstep;
            if (last && has_next) S.a_ready(nxt);
            if constexpr (SP2) {
            PG8_LDB(B0, 0, 0); PG8_LDB(B1, 0, 1); PG8_SCHED; PG8_LDA(At, 0, 0); PG8_STAGE(PG8_SA(1, 1), a1 + hstep, voffA);
            PG8_WAIT_V(8); PG8_WAIT_L(0); PG8_BAR; PG8_MMA(0, 0, At, B0); PG8_MMA(0, 1, At, B1); PG8_BAR; PG8_SCHED;
            PG8_LDA(At, 0, 1); PG8_STAGE(PG8_SB(0, 0), b2, voffB); PG8_STAGE(PG8_SB(0, 1), b2 + hstep, voffB); PG8_STAGE(PG8_SA(0, 0), a2, voffA);
            PG8_WAIT_V(8); PG8_WAIT_L(0); PG8_BAR; PG8_MMA(1, 0, At, B0); PG8_MMA(1, 1, At, B1); PG8_BAR; PG8_SCHED;
            PG8_LDB(B0, 1, 0); PG8_LDB(B1, 1, 1); PG8_SCHED; PG8_LDA(At, 1, 0); PG8_STAGE(PG8_SA(0, 1), a2 + hstep, voffA);
            PG8_WAIT_V(8); PG8_WAIT_L(0); PG8_BAR; PG8_MMA(0, 0, At, B0); PG8_MMA(0, 1, At, B1); PG8_BAR; PG8_SCHED;
            PG8_LDA(At, 1, 1); PG8_STAGE(PG8_SB(1, 0), b3, voffB); PG8_STAGE(PG8_SB(1, 1), b3 + hstep, voffB); PG8_STAGE(PG8_SA(1, 0), a3, voffA);
            PG8_WAIT_V(8); PG8_WAIT_L(0); PG8_BAR; PG8_MMA(1, 0, At, B0); PG8_MMA(1, 1, At, B1); PG8_BAR; PG8_SCHED;
            } else {
            PG8_LDB(B0, 0, 0); PG8_SCHED; PG8_LDA(At, 0, 0); PG8_STAGE(PG8_SA(1, 1), a1 + hstep, voffA);
            PG8_WAIT_L(8); PG8_BAR; PG8_WAIT_L(0); PG8_MMA(0, 0, At, B0); PG8_BAR; PG8_SCHED;
            PG8_LDB(B1, 0, 1); PG8_STAGE(PG8_SB(0, 0), b2, voffB);
            PG8_BAR; PG8_WAIT_L(0); PG8_MMA(0, 1, At, B1); PG8_BAR;
            PG8_LDA(At, 0, 1); PG8_STAGE(PG8_SA(0, 0), a2, voffA);
            PG8_BAR; PG8_WAIT_L(0); PG8_MMA(1, 0, At, B0); PG8_BAR; PG8_SCHED;
            PG8_STAGE(PG8_SB(0, 1), b2 + hstep, voffB);
            PG8_WAIT_V(6); PG8_BAR; PG8_MMA(1, 1, At, B1); PG8_BAR;
            PG8_LDB(B0, 1, 0); PG8_SCHED; PG8_LDA(At, 1, 0); PG8_STAGE(PG8_SA(0, 1), a2 + hstep, voffA);
            PG8_WAIT_L(8); PG8_BAR; PG8_WAIT_L(0); PG8_MMA(0, 0, At, B0); PG8_BAR; PG8_SCHED;
            PG8_LDB(B1, 1, 1); PG8_STAGE(PG8_SB(1, 0), b3, voffB);
            PG8_BAR; PG8_WAIT_L(0); PG8_MMA(0, 1, At, B1); PG8_BAR;
            PG8_LDA(At, 1, 1); PG8_STAGE(PG8_SA(1, 0), a3, voffA);
            PG8_BAR; PG8_WAIT_L(0); PG8_MMA(1, 0, At, B0); PG8_BAR; PG8_SCHED;
            PG8_STAGE(PG8_SB(1, 1), b3 + hstep, voffB);
            PG8_WAIT_V(6); PG8_BAR; PG8_MMA(1, 1, At, B1); PG8_BAR;
            }
        }
        if constexpr (ALIGN_EPI) { if (wr == 0) PG8_BAR; }
        if constexpr (!Epi::AFTER_DRAIN) { E(acc, cur, wr, wc, fr, fq); S.done(cur); }
        if (!has_next) break;
#pragma unroll
        for (int a = 0; a < 2; ++a)
#pragma unroll
            for (int b = 0; b < 2; ++b)
#pragma unroll
                for (int m = 0; m < 4; ++m)
#pragma unroll
                    for (int n = 0; n < 2; ++n) acc[a][b][m][n] = (f32x4){0.f, 0.f, 0.f, 0.f};
        cur = nxt; cA = nA; cB = nB; ++ui;
        if constexpr (ALIGN_EPI) { if (wr == 1) PG8_BAR; }
    }
    PG8_WAIT_V(0);
    if constexpr (!ALIGN_EPI) { if (wr == 0) PG8_BAR; }
    PG8_BAR;
    if constexpr (Epi::AFTER_DRAIN) { E.fused(acc, cur, wr, wc, fr, fq, lds, wid, lane); S.done(cur); }
#undef PG8_SA
#undef PG8_SB
#undef PG8_STAGE
#undef PG8_LDA
#undef PG8_LDB
#undef PG8_MMA
#undef PG8_WAIT_V
#undef PG8_WAIT_L
#undef PG8_BAR
#undef PG8_SCHED
}
}
#define LAS __attribute__((address_space(3)))
typedef unsigned short bf16;
typedef float f32x4 __attribute__((ext_vector_type(4)));
typedef float f32x2 __attribute__((ext_vector_type(2)));
typedef float f32x16 __attribute__((ext_vector_type(16)));
typedef short bf16x8 __attribute__((ext_vector_type(8)));
typedef short s16x4 __attribute__((ext_vector_type(4)));
typedef unsigned u32x4 __attribute__((ext_vector_type(4)));
typedef unsigned u32x2 __attribute__((ext_vector_type(2)));

#ifndef REP_LORA
#define REP_LORA 1
#endif
#ifndef REP_UP
#define REP_UP 1
#endif
#ifndef REP_RMS
#define REP_RMS 1
#endif
#ifndef REP_XMIX
#define REP_XMIX 1
#endif
#ifndef REP_ATTN
#define REP_ATTN 1
#endif
#ifndef REP_ATTNA
#define REP_ATTNA 1
#endif
#ifndef REP_SCAN
#define REP_SCAN 1
#endif
constexpr int NWAVES = 8, NTHR = 512;
constexpr int NTOK = 65536, DM = 1024, SEQ = 4096, NBATCH = 16, DFF = 4096, QKVC = 3072;
constexpr size_t MiB = (size_t)1 << 20;
constexpr size_t WS_CTL = 0;
constexpr size_t WS_WIN = 1 * MiB, WS_WOUT = 7 * MiB, WS_W1_0 = 9 * MiB, WS_W2_0 = 17 * MiB, WS_W1_1 = 25 * MiB, WS_W2_1 = 33 * MiB;
constexpr size_t WS_WR = 41 * MiB, WS_WK = 43 * MiB, WS_WV = 45 * MiB, WS_WO = 47 * MiB;
constexpr size_t WS_LW1 = 49 * MiB, WS_LA1 = WS_LW1 + 512 * 1024, WS_LG1 = 50 * MiB, WS_LW2 = WS_LG1 + 512 * 1024, WS_LA2 = 51 * MiB, WS_LG2 = WS_LA2 + 512 * 1024;
constexpr size_t WS_ROPE = 52 * MiB;
constexpr size_t WS_HN = 65 * MiB;
constexpr size_t WS_QKV = 193 * MiB;
constexpr size_t WS_ATT = 577 * MiB;
constexpr size_t WS_OAP = 705 * MiB;
constexpr size_t WS_LSE = 897 * MiB;
constexpr size_t WS_U = 193 * MiB;
constexpr size_t WS_X6 = 65 * MiB;
constexpr size_t WS_T = 833 * MiB;
constexpr size_t WS_RKV = 449 * MiB;
constexpr size_t WS_WAG = 65 * MiB;
constexpr size_t WS_Z = 833 * MiB;
constexpr size_t WS_END = 961 * MiB;
constexpr size_t ACT = (size_t)NTOK * DM * 2;

constexpr int RING_BYTES = 131072, LDS_BYTES = 147456;
constexpr int LDS_BARST = 147200;
constexpr size_t WS_BAR = 16384;
constexpr size_t CTL_ZERO_BYTES = 65536;
#define XB_TMO      128
#define XB_XCNT(j)  (256  + 64 * (j))
#define XB_XSUB(j)  (1280 + 64 * (j))
#define XB_XGEN(j)  (2304 + 64 * (j))
#define XB_TOP      3328
#define XB_TOPGEN   3392
#define XCD_BAR_WORDS 3456
#define XB_SPIN_CAP (1u << 18)

__device__ __forceinline__ unsigned xb_ld(unsigned* p)              { return __hip_atomic_load(p, __ATOMIC_RELAXED, __HIP_MEMORY_SCOPE_AGENT); }
__device__ __forceinline__ unsigned xb_add(unsigned* p, unsigned v) { return __hip_atomic_fetch_add(p, v, __ATOMIC_RELAXED, __HIP_MEMORY_SCOPE_AGENT); }
__device__ __forceinline__ unsigned xb_xcc_id() { return (unsigned)__builtin_amdgcn_s_getreg((3 << 11) | 20) & 0xFu; }
#define XB_SPIN(cond, bar) do { unsigned _sp = 0; while (cond) { __builtin_amdgcn_s_sleep(1); \
    if ((++_sp & 255u) == 0u) { if (xb_ld(&(bar)[XB_TMO])) break; if (_sp > XB_SPIN_CAP) { atomicAdd(&(bar)[XB_TMO], 1u); break; } } } } while (0)

struct XcdBarrier {
    unsigned* bar; unsigned x;
    volatile LAS unsigned* st;
};

__device__ __forceinline__ XcdBarrier xcd_barrier_post(unsigned* bar, volatile LAS unsigned* st) {
    XcdBarrier b; b.bar = bar; b.x = xb_xcc_id(); b.st = st;
    if (threadIdx.x == 0) (void)xb_add(&bar[XB_XCNT(b.x)], 1u);
    return b;
}
__device__ __forceinline__ void xcd_barrier_complete(unsigned* bar, unsigned x, unsigned& nloc, unsigned& nx) {
    const unsigned G = gridDim.x * gridDim.y * gridDim.z;
    unsigned sum, cnt, mine, sp = 0u;
    for (;;) {
        sum = 0u; cnt = 0u; mine = 0u;
#pragma unroll
        for (unsigned j = 0; j < 16; ++j) { const unsigned c = xb_ld(&bar[XB_XCNT(j)]); sum += c; cnt += (c > 0u) ? 1u : 0u; mine = (j == x) ? c : mine; }
        if (sum == G) break;
        __builtin_amdgcn_s_sleep(1);
        if ((++sp & 255u) == 0u) { if (xb_ld(&bar[XB_TMO])) break; if (sp > XB_SPIN_CAP) { atomicAdd(&bar[XB_TMO], 1u); break; } }
    }
    nloc = mine > 0u ? mine : 1u; nx = cnt > 0u ? cnt : 1u;
}

__device__ __forceinline__ void xcd_barrier(const XcdBarrier& b) {
    asm volatile("s_waitcnt vmcnt(0)" ::: "memory");
    __syncthreads();
    if (threadIdx.x == 0) {
        unsigned* bar = b.bar;
        __builtin_amdgcn_s_waitcnt(0);
        unsigned nloc = b.st[0], nx = b.st[1];
        if (nloc == 0u) { xcd_barrier_complete(bar, b.x, nloc, nx); b.st[0] = nloc; b.st[1] = nx; }
        const unsigned old = xb_add(&bar[XB_XSUB(b.x)], 1u);
        const unsigned gen = old / nloc;
        if (old + 1u == (gen + 1u) * nloc) {
            __builtin_amdgcn_fence(__ATOMIC_RELEASE, "agent");
            asm volatile("s_waitcnt vmcnt(0)" ::: "memory");
            const unsigned og = xb_add(&bar[XB_TOP], 1u);
            const unsigned tg = og / nx;
            if (og + 1u == (tg + 1u) * nx) xb_add(&bar[XB_TOPGEN], 1u);
            else XB_SPIN(xb_ld(&bar[XB_TOPGEN]) == tg, bar);
            __builtin_amdgcn_fence(__ATOMIC_ACQUIRE, "agent");
            xb_add(&bar[XB_XGEN(b.x)], 1u);
            asm volatile("s_waitcnt vmcnt(0)" ::: "memory");
        } else {
            XB_SPIN(xb_ld(&bar[XB_XGEN(b.x)]) == gen, bar);
            __builtin_amdgcn_fence(__ATOMIC_ACQUIRE, "agent");
            asm volatile("s_waitcnt vmcnt(0)" ::: "memory");
        }
    }
    __syncthreads();
}


__device__ __forceinline__ unsigned pkbf(float lo, float hi) { return pg8::cvt_pk_bf16(lo, hi); }
__device__ __forceinline__ float bf2f(unsigned short h) { return __uint_as_float(((unsigned)h) << 16); }
__device__ __forceinline__ float bflo(unsigned w) { return __uint_as_float(w << 16); }
__device__ __forceinline__ float bfhi(unsigned w) { return __uint_as_float(w & 0xffff0000u); }
__device__ __forceinline__ float wave_sum(float v) {
#pragma unroll
    for (int o = 1; o < 64; o <<= 1) v += __shfl_xor(v, o);
    return v;
}

struct Args {
    const float* x; const float* norm_mix; const float* norm_mlp; const float* norm_final;
    const float* attn_w_in; const float* attn_w_out; const float* diff_lambda; const float* diff_subln;
    const float* rwkv_mu; const float* rwkv_w_r; const float* rwkv_w_k; const float* rwkv_w_v; const float* rwkv_w_o;
    const float* rwkv_w0; const float* rwkv_w1; const float* rwkv_w2; const float* rwkv_a0; const float* rwkv_a1; const float* rwkv_a2;
    const float* rwkv_g1; const float* rwkv_g2; const float* rwkv_k_k; const float* rwkv_k_a; const float* rwkv_r_k;
    const float* rwkv_ln_w; const float* rwkv_ln_b; const float* mlp_w1; const float* mlp_w2;
    float* out; unsigned char* ws; int ph_lo, ph_hi;
};

__device__ __forceinline__ void transpose_item(const float* __restrict__ W, int N, bf16* __restrict__ WT, int pitch, LAS float* scr, int item, int lane) {
    const int nblk = N >> 5, kb = item / nblk, nb = item - kb * nblk, k0 = kb * 32, n0 = nb * 32;
#pragma unroll 4
    for (int i = 0; i < 16; ++i) { const int kk = 2 * i + (lane >> 5); scr[kk * 33 + (lane & 31)] = W[(size_t)(k0 + kk) * N + n0 + (lane & 31)]; }
    asm volatile("s_waitcnt lgkmcnt(0)" ::: "memory");
    const int c = lane & 3;
#pragma unroll
    for (int j = 0; j < 2; ++j) { const int n = (lane >> 2) + 16 * j; const LAS float* s = scr + (8 * c) * 33 + n;
        u32x4 o; o.x = pkbf(s[0], s[33]); o.y = pkbf(s[66], s[99]); o.z = pkbf(s[132], s[165]); o.w = pkbf(s[198], s[231]);
        *(u32x4*)(WT + (size_t)(n0 + n) * pitch + k0 + 8 * c) = o; }
    asm volatile("s_waitcnt lgkmcnt(0)" ::: "memory");
}
__device__ __forceinline__ void zero_region(bf16* p, int pitch, int r0, int r1, int c0, int c1, int gt, int ngt) {
    const int cw = (c1 - c0) >> 3, n = (r1 - r0) * cw;
    for (int i = gt; i < n; i += ngt) { const int r = r0 + i / cw, c = c0 + (i % cw) * 8; *(u32x4*)(p + (size_t)r * pitch + c) = (u32x4){0u, 0u, 0u, 0u}; }
}
__device__ __forceinline__ void rms_row_bf16(const float* xrow, const float* gain, bf16* orow, int lane) {
    const f32x4* xr = (const f32x4*)xrow + lane; const f32x4* gr = (const f32x4*)gain + lane;
    f32x4 v[4]; float s = 0.f;
#pragma unroll
    for (int j = 0; j < 4; ++j) { v[j] = xr[64 * j]; s += (v[j].x * v[j].x + v[j].y * v[j].y) + (v[j].z * v[j].z + v[j].w * v[j].w); }
    const float rstd = 1.f / sqrtf(wave_sum(s) * (1.f / 1024.f) + 1e-5f);
    u32x2* o8 = (u32x2*)orow + lane;
#pragma unroll
    for (int j = 0; j < 4; ++j) { const f32x4 g = gr[64 * j]; u32x2 w; w.x = pkbf(v[j].x * rstd * g.x, v[j].y * rstd * g.y); w.y = pkbf(v[j].z * rstd * g.z, v[j].w * rstd * g.w); o8[64 * j] = w; }
}
__device__ __forceinline__ void rms_phase_bf16(const float* __restrict__ src, const float* __restrict__ gain, bf16* __restrict__ dst, int gw, int ngw, int lane) {
    const f32x4* gr = (const f32x4*)gain + lane;
    for (int m = 2 * gw; m < NTOK; m += 2 * ngw) {
        const f32x4* x0 = (const f32x4*)(src + (size_t)m * DM) + lane; const f32x4* x1 = x0 + DM / 4;
        f32x4 v[4], u[4]; float s = 0.f, t = 0.f;
#pragma unroll
        for (int j = 0; j < 4; ++j) { v[j] = x0[64 * j]; u[j] = x1[64 * j]; }
#pragma unroll
        for (int j = 0; j < 4; ++j) { s += (v[j].x * v[j].x + v[j].y * v[j].y) + (v[j].z * v[j].z + v[j].w * v[j].w); t += (u[j].x * u[j].x + u[j].y * u[j].y) + (u[j].z * u[j].z + u[j].w * u[j].w); }
        const float r0 = 1.f / sqrtf(wave_sum(s) * (1.f / 1024.f) + 1e-5f), r1 = 1.f / sqrtf(wave_sum(t) * (1.f / 1024.f) + 1e-5f);
        u32x2* o0 = (u32x2*)(dst + (size_t)m * DM) + lane; u32x2* o1 = o0 + DM / 4;
#pragma unroll
        for (int j = 0; j < 4; ++j) { const f32x4 g = gr[64 * j];
            u32x2 w; w.x = pkbf(v[j].x * r0 * g.x, v[j].y * r0 * g.y); w.y = pkbf(v[j].z * r0 * g.z, v[j].w * r0 * g.w); o0[64 * j] = w;
            u32x2 z; z.x = pkbf(u[j].x * r1 * g.x, u[j].y * r1 * g.y); z.y = pkbf(u[j].z * r1 * g.z, u[j].w * r1 * g.w); o1[64 * j] = z; }
    }
}
__device__ __forceinline__ void rms_phase_f32(const float* src, const float* gain, float* dst, int gw, int ngw, int lane) {
    const f32x4* gr = (const f32x4*)gain + lane;
    for (int m = 2 * gw; m < NTOK; m += 2 * ngw) {
        const f32x4* x0 = (const f32x4*)(src + (size_t)m * DM) + lane; const f32x4* x1 = x0 + DM / 4;
        f32x4 v[4], u[4]; float s = 0.f, t = 0.f;
#pragma unroll
        for (int j = 0; j < 4; ++j) { v[j] = x0[64 * j]; u[j] = x1[64 * j]; }
#pragma unroll
        for (int j = 0; j < 4; ++j) { s += (v[j].x * v[j].x + v[j].y * v[j].y) + (v[j].z * v[j].z + v[j].w * v[j].w); t += (u[j].x * u[j].x + u[j].y * u[j].y) + (u[j].z * u[j].z + u[j].w * u[j].w); }
        const float r0 = 1.f / sqrtf(wave_sum(s) * (1.f / 1024.f) + 1e-5f), r1 = 1.f / sqrtf(wave_sum(t) * (1.f / 1024.f) + 1e-5f);
        f32x4* o0 = (f32x4*)(dst + (size_t)m * DM) + lane; f32x4* o1 = o0 + DM / 4;
#pragma unroll
        for (int j = 0; j < 4; ++j) { const f32x4 g = gr[64 * j]; o0[64 * j] = v[j] * r0 * g; o1[64 * j] = u[j] * r1 * g; }
    }
}

__device__ __forceinline__ void xmix_phase(const float* __restrict__ h, const float* __restrict__ gain, const float* __restrict__ mu, bf16* __restrict__ X6, int gw, int ngw, int lane) {
    f32x4 g4[4], m6[6][4];
#pragma unroll
    for (int j = 0; j < 4; ++j) g4[j] = ((const f32x4*)gain + lane)[64 * j];
#pragma unroll
    for (int i = 0; i < 6; ++i) {
        const int mi = (i == 1) ? 2 : ((i == 2) ? 3 : ((i == 3) ? 1 : i));
#pragma unroll
        for (int j = 0; j < 4; ++j) m6[i][j] = ((const f32x4*)(mu + mi * DM) + lane)[64 * j];
    }
    for (int chunk = gw; chunk < NTOK / 32; chunk += ngw) {
        const int t0 = chunk * 32;
        f32x4 prev[4];
        if ((t0 & (SEQ - 1)) == 0) {
#pragma unroll
            for (int j = 0; j < 4; ++j) prev[j] = (f32x4){0.f, 0.f, 0.f, 0.f};
        } else {
            const f32x4* xr = (const f32x4*)(h + (size_t)(t0 - 1) * DM) + lane; float s = 0.f;
#pragma unroll
            for (int j = 0; j < 4; ++j) { prev[j] = xr[64 * j]; s += (prev[j].x * prev[j].x + prev[j].y * prev[j].y) + (prev[j].z * prev[j].z + prev[j].w * prev[j].w); }
            const float rstd = 1.f / sqrtf(wave_sum(s) * (1.f / 1024.f) + 1e-5f);
#pragma unroll
            for (int j = 0; j < 4; ++j) prev[j] = prev[j] * rstd * g4[j];
        }
        f32x4 nx[4];
        { const f32x4* xr = (const f32x4*)(h + (size_t)t0 * DM) + lane;
#pragma unroll
          for (int j = 0; j < 4; ++j) nx[j] = xr[64 * j]; }
        for (int t = t0; t < t0 + 32; ++t) {
            f32x4 v[4]; float s = 0.f;
#pragma unroll
            for (int j = 0; j < 4; ++j) v[j] = nx[j];
            if (t + 1 < t0 + 32) { const f32x4* xr = (const f32x4*)(h + (size_t)(t + 1) * DM) + lane;
#pragma unroll
              for (int j = 0; j < 4; ++j) nx[j] = xr[64 * j]; }
#pragma unroll
            for (int j = 0; j < 4; ++j) s += (v[j].x * v[j].x + v[j].y * v[j].y) + (v[j].z * v[j].z + v[j].w * v[j].w);
            const float rstd = 1.f / sqrtf(wave_sum(s) * (1.f / 1024.f) + 1e-5f);
#pragma unroll
            for (int j = 0; j < 4; ++j) v[j] = v[j] * rstd * g4[j];
#pragma unroll
            for (int i = 0; i < 6; ++i) {
                u32x2* o8 = (u32x2*)(X6 + (size_t)i * NTOK * DM + (size_t)t * DM) + lane;
#pragma unroll
                for (int j = 0; j < 4; ++j) { const f32x4 xx = v[j] + (prev[j] - v[j]) * m6[i][j]; u32x2 w; w.x = pkbf(xx.x, xx.y); w.y = pkbf(xx.z, xx.w); o8[64 * j] = w; }
            }
#pragma unroll
            for (int j = 0; j < 4; ++j) prev[j] = v[j];
        }
    }
}

__device__ __forceinline__ int crow(int r, int hi) { return (r & 3) + 8 * (r >> 2) + 4 * hi; }
__device__ __forceinline__ s16x4 vtr(const LAS unsigned char* p) {
    typedef short v4i16_t __attribute__((ext_vector_type(4)));
    return __builtin_bit_cast(s16x4, __builtin_amdgcn_ds_read_tr16_b64_v4i16((LAS v4i16_t*)p));
}
__device__ __forceinline__ bf16x8 vfrag(const LAS unsigned char* p, int row8) {
    const s16x4 lo = vtr(p), hi = vtr(p + row8);
    return (bf16x8){lo[0], lo[1], lo[2], lo[3], hi[0], hi[1], hi[2], hi[3]};
}
__device__ __forceinline__ bf16x8 packp(const f32x16& p, int b) {
    u32x4 w; w.x = pkbf(p[b], p[b + 1]); w.y = pkbf(p[b + 2], p[b + 3]); w.z = pkbf(p[b + 4], p[b + 5]); w.w = pkbf(p[b + 6], p[b + 7]);
    return __builtin_bit_cast(bf16x8, w);
}
__device__ __forceinline__ float max16(const f32x16& p) {
    float a = fmaxf(fmaxf(p[0], p[1]), fmaxf(p[2], p[3])), b = fmaxf(fmaxf(p[4], p[5]), fmaxf(p[6], p[7]));
    float c = fmaxf(fmaxf(p[8], p[9]), fmaxf(p[10], p[11])), d = fmaxf(fmaxf(p[12], p[13]), fmaxf(p[14], p[15]));
    return fmaxf(fmaxf(a, b), fmaxf(c, d));
}
__device__ __forceinline__ float sum16(const f32x16& p) {
    return ((p[0] + p[1]) + (p[2] + p[3])) + ((p[4] + p[5]) + (p[6] + p[7])) + ((p[8] + p[9]) + (p[10] + p[11])) + ((p[12] + p[13]) + (p[14] + p[15]));
}
#define MFMA32(a, b, c) __builtin_amdgcn_mfma_f32_32x32x16_bf16((a), (b), (c), 0, 0, 0)

constexpr int KB_STR = 144, VB_STR = 320, KB_BYTES = 64 * KB_STR, VB_BYTES = 64 * VB_STR, BBUF = 2 * KB_BYTES + VB_BYTES;
constexpr int BX_OFF = 2 * BBUF;
__device__ __forceinline__ void diffattn_unit(const bf16* __restrict__ QKV, bf16* __restrict__ ATT, const float* subln, float lam, int b, int h, int qb, LAS unsigned char* lds) {
    int tid = threadIdx.x; asm volatile("" : "+v"(tid)); const int lane = tid & 63, wid = __builtin_amdgcn_readfirstlane(tid >> 6), c = wid >> 2, g = wid & 3, i32 = lane & 31, hi = lane >> 5;
    const size_t tok0 = (size_t)b * SEQ;
    const int qrow = qb * 128 + 32 * g + i32;
    bf16x8 qf[4];
    { const bf16* qp = QKV + (tok0 + qrow) * QKVC + 1536 + h * 128 + c * 64 + 8 * hi;
#pragma unroll
      for (int s = 0; s < 4; ++s) qf[s] = *(const bf16x8*)(qp + 16 * s); }
    const int krow = tid >> 3, kch = tid & 7;
    const bf16* ksrc = QKV + (tok0 + krow) * QKVC + 2048 + h * 128 + kch * 8;
    const int vrow0 = tid >> 4, vch = tid & 15;
    const bf16* vsrc = QKV + (tok0 + vrow0) * QKVC + 2560 + h * 128 + vch * 8;
    const int kdst = krow * KB_STR + kch * 16, vdst = vrow0 * VB_STR + vch * 16;
    const int NT = 2 * qb + 2;
    u32x4 rk0, rk1, rv0, rv1;
#define B_LOAD(t) do { const size_t o_ = (size_t)(t) * 64 * QKVC; rk0 = *(const u32x4*)(ksrc + o_); rk1 = *(const u32x4*)(ksrc + o_ + 64); rv0 = *(const u32x4*)(vsrc + o_); rv1 = *(const u32x4*)(vsrc + o_ + (size_t)32 * QKVC); } while (0)
#define B_STORE(buf) do { LAS unsigned char* b_ = lds + (buf) * BBUF; *(LAS u32x4*)(b_ + kdst) = rk0; *(LAS u32x4*)(b_ + KB_BYTES + kdst) = rk1; *(LAS u32x4*)(b_ + 2 * KB_BYTES + vdst) = rv0; *(LAS u32x4*)(b_ + 2 * KB_BYTES + vdst + 32 * VB_STR) = rv1; } while (0)
    B_LOAD(0);
    f32x16 o[4];
#pragma unroll
    for (int d = 0; d < 4; ++d) o[d] = (f32x16){};
    float m_ref = 0.f, l_run = 0.f;
    const int qmin = qb * 128 + 32 * g;
    const int lg = lane & 15, gg = (lane >> 4) & 1;
    const int voff = (4 * hi + (lg >> 2)) * VB_STR + (16 * gg + 4 * (lg & 3)) * 2;
    for (int t = 0; t < NT; ++t) {
        B_STORE(t & 1);
        __syncthreads();
        if (t + 1 < NT) B_LOAD(t + 1);
        const int k0 = 64 * t;
        if (k0 <= qmin + 31) {
            const LAS unsigned char* kb = lds + (t & 1) * BBUF + c * KB_BYTES;
            const LAS unsigned char* vb = lds + (t & 1) * BBUF + 2 * KB_BYTES + voff;
            f32x16 p0 = (f32x16){}, p1 = (f32x16){};
#pragma unroll
            for (int s = 0; s < 4; ++s) {
                const bf16x8 a0 = *(const LAS bf16x8*)(kb + i32 * KB_STR + 32 * s + 16 * hi);
                const bf16x8 a1 = *(const LAS bf16x8*)(kb + (32 + i32) * KB_STR + 32 * s + 16 * hi);
                p0 = MFMA32(a0, qf[s], p0); p1 = MFMA32(a1, qf[s], p1);
            }
            if (k0 + 63 > qmin) {
#pragma unroll
                for (int r = 0; r < 16; ++r) { const int kv = k0 + crow(r, hi); if (kv > qrow) p0[r] = -INFINITY; if (kv + 32 > qrow) p1[r] = -INFINITY; }
            }
            float mx = fmaxf(max16(p0), max16(p1));
            mx = fmaxf(mx, __shfl_xor(mx, 32));
            if (t == 0) m_ref = mx;
            else if (__any(mx - m_ref > 8.f)) {
                const float dl = fmaxf(mx - m_ref, 0.f);
                m_ref += dl;
                const float alpha = __builtin_amdgcn_exp2f(-dl);
                l_run *= alpha;
#pragma unroll
                for (int d = 0; d < 4; ++d) o[d] = o[d] * alpha;
            }
#pragma unroll
            for (int r = 0; r < 16; ++r) { p0[r] = __builtin_amdgcn_exp2f(p0[r] - m_ref); p1[r] = __builtin_amdgcn_exp2f(p1[r] - m_ref); }
            l_run += sum16(p0) + sum16(p1);
#pragma unroll
            for (int s4 = 0; s4 < 4; ++s4) {
                const bf16x8 pfs = packp((s4 < 2) ? p0 : p1, 8 * (s4 & 1));
#pragma unroll
                for (int d = 0; d < 4; ++d) { const bf16x8 a = vfrag(vb + s4 * 16 * VB_STR + d * 64, 8 * VB_STR); o[d] = MFMA32(a, pfs, o[d]); }
                __builtin_amdgcn_sched_barrier(0);
            }
        }
    }
#undef B_LOAD
#undef B_STORE
    __syncthreads();
    float l_tot = l_run + __shfl_xor(l_run, 32);
    const float inv = 1.f / l_tot;
    LAS float* X = (LAS float*)(lds + BX_OFF) + g * 4096;
    if (c == 1) {
        const float sc = inv * lam;
#pragma unroll
        for (int d = 0; d < 4; ++d)
#pragma unroll
            for (int r = 0; r < 16; ++r) X[(32 * d + crow(r, hi)) * 32 + i32] = o[d][r] * sc;
    }
    __syncthreads();
    if (c == 0) {
        float ss = 0.f;
#pragma unroll
        for (int d = 0; d < 4; ++d)
#pragma unroll
            for (int r = 0; r < 16; ++r) { const float v = o[d][r] * inv - X[(32 * d + crow(r, hi)) * 32 + i32]; o[d][r] = v; ss += v * v; }
        ss += __shfl_xor(ss, 32);
        const float rs = (1.f / sqrtf(ss * (1.f / 128.f) + 1e-5f)) * 0.8f;
        bf16* op = ATT + (tok0 + qrow) * DM + 512 + h * 128;
#pragma unroll
        for (int d = 0; d < 4; ++d)
#pragma unroll
            for (int r4 = 0; r4 < 4; ++r4) {
                const int dv = 32 * d + 8 * r4 + 4 * hi; const f32x4 gn = *(const f32x4*)(subln + dv);
                u32x2 w; w.x = pkbf(o[d][4 * r4] * rs * gn.x, o[d][4 * r4 + 1] * rs * gn.y); w.y = pkbf(o[d][4 * r4 + 2] * rs * gn.z, o[d][4 * r4 + 3] * rs * gn.w);
                *(u32x2*)(op + dv) = w;
            }
    }
    __syncthreads();
}

constexpr int KA_STR = 144, VA_STR = 192, KA_BYTES = 384 * KA_STR, VA_BYTES = 384 * VA_STR;
__device__ __forceinline__ void dilattn_unit(const bf16* __restrict__ QKV, bf16* __restrict__ OAP, float* __restrict__ LSE, int b, int h, int dil, int res, int n, LAS unsigned char* lds) {
    int tid = threadIdx.x; asm volatile("" : "+v"(tid)); const int lane = tid & 63, wid = __builtin_amdgcn_readfirstlane(tid >> 6), i32 = lane & 31, hi = lane >> 5;
    const size_t tok0 = (size_t)b * SEQ;
    {
#pragma unroll
        for (int i = 0; i < 6; ++i) {
            const int e = tid + 512 * i, kr = e >> 3, ch = e & 7, j = 256 * n - 128 + kr;
            u32x4 kv = (u32x4){0u, 0u, 0u, 0u}, vv = kv;
            if (j >= 0) { const bf16* p = QKV + (tok0 + (size_t)j * dil + res) * QKVC + h * 64 + ch * 8; kv = *(const u32x4*)(p + 512); vv = *(const u32x4*)(p + 1024); }
            *(LAS u32x4*)(lds + kr * KA_STR + ch * 16) = kv;
            *(LAS u32x4*)(lds + KA_BYTES + kr * VA_STR + ch * 16) = vv;
        }
    }
    const int jq = 256 * n + 32 * wid + i32;
    const size_t qtok = tok0 + (size_t)jq * dil + res;
    bf16x8 qf[4];
    { const bf16* qp = QKV + qtok * QKVC + h * 64 + 8 * hi;
#pragma unroll
      for (int s = 0; s < 4; ++s) qf[s] = *(const bf16x8*)(qp + 16 * s); }
    __syncthreads();
    f32x16 p[5];
    const int ufirst = (n == 0) ? ((wid < 4) ? 4 - wid : 0) : 0;
#pragma unroll
    for (int u = 0; u < 5; ++u) {
        p[u] = (f32x16){};
        if (u >= ufirst) {
            const LAS unsigned char* kb = lds + (32 * (wid + u) + i32) * KA_STR + 16 * hi;
#pragma unroll
            for (int s = 0; s < 4; ++s) { const bf16x8 a = *(const LAS bf16x8*)(kb + 32 * s); p[u] = MFMA32(a, qf[s], p[u]); }
        } else {
#pragma unroll
            for (int r = 0; r < 16; ++r) p[u][r] = -INFINITY;
        }
    }
#pragma unroll
    for (int r = 0; r < 16; ++r) { const int kl = crow(r, hi); if (kl < i32) p[0][r] = -INFINITY; if (kl > i32) p[4][r] = -INFINITY; }
    float mx = fmaxf(fmaxf(fmaxf(max16(p[0]), max16(p[1])), fmaxf(max16(p[2]), max16(p[3]))), max16(p[4]));
    mx = fmaxf(mx, __shfl_xor(mx, 32));
    float l = 0.f;
#pragma unroll
    for (int u = 0; u < 5; ++u) {
#pragma unroll
        for (int r = 0; r < 16; ++r) p[u][r] = __builtin_amdgcn_exp2f(p[u][r] - mx);
        l += sum16(p[u]);
    }
    l += __shfl_xor(l, 32);
    f32x16 o[2]; o[0] = (f32x16){}; o[1] = (f32x16){};
    const int lg = lane & 15, gg = (lane >> 4) & 1;
    const LAS unsigned char* vb = lds + KA_BYTES + (4 * hi + (lg >> 2)) * VA_STR + (16 * gg + 4 * (lg & 3)) * 2;
#pragma unroll
    for (int u = 0; u < 5; ++u) {
        if (u >= ufirst) {
#pragma unroll
            for (int s2 = 0; s2 < 2; ++s2) {
                const bf16x8 pf = packp(p[u], 8 * s2);
#pragma unroll
                for (int d = 0; d < 2; ++d) { const bf16x8 a = vfrag(vb + (32 * (wid + u) + 16 * s2) * VA_STR + d * 64, 8 * VA_STR); o[d] = MFMA32(a, pf, o[d]); }
            }
        }
    }
    const float inv = 1.f / l;
    const int pat = (dil == 1) ? 0 : ((dil == 4) ? 1 : 2);
    bf16* op = OAP + (size_t)pat * NTOK * 512 + qtok * 512 + h * 64;
#pragma unroll
    for (int d = 0; d < 2; ++d)
#pragma unroll
        for (int r4 = 0; r4 < 4; ++r4) {
            const int dv = 32 * d + 8 * r4 + 4 * hi;
            u32x2 w; w.x = pkbf(o[d][4 * r4] * inv, o[d][4 * r4 + 1] * inv); w.y = pkbf(o[d][4 * r4 + 2] * inv, o[d][4 * r4 + 3] * inv);
            *(u32x2*)(op + dv) = w;
        }
    if (hi == 0) LSE[(size_t)pat * NTOK * 8 + qtok * 8 + h] = mx + __builtin_amdgcn_logf(l);
    __syncthreads();
}

__device__ __forceinline__ void combine_phase(const bf16* __restrict__ OAP, const float* __restrict__ LSE, bf16* __restrict__ ATT, int gt, int ngt) {
    for (int i = gt; i < NTOK * 64; i += ngt) {
        const int tokh = i >> 3, ch = i & 7; const size_t tok = (size_t)(tokh >> 3); const int h = tokh & 7;
        const float l0 = LSE[tokh], l1 = LSE[(size_t)NTOK * 8 + tokh], l2 = LSE[(size_t)2 * NTOK * 8 + tokh];
        const float m = fmaxf(l0, fmaxf(l1, l2));
        float w0 = __builtin_amdgcn_exp2f(l0 - m), w1 = __builtin_amdgcn_exp2f(l1 - m), w2 = __builtin_amdgcn_exp2f(l2 - m);
        const float is = 1.f / (w0 + w1 + w2); w0 *= is; w1 *= is; w2 *= is;
        const size_t off = tok * 512 + h * 64 + ch * 8;
        const u32x4 a = *(const u32x4*)(OAP + off), bq = *(const u32x4*)(OAP + (size_t)NTOK * 512 + off), cq = *(const u32x4*)(OAP + (size_t)2 * NTOK * 512 + off);
        u32x4 o;
#pragma unroll
        for (int e = 0; e < 4; ++e) o[e] = pkbf(w0 * bflo(a[e]) + w1 * bflo(bq[e]) + w2 * bflo(cq[e]), w0 * bfhi(a[e]) + w1 * bfhi(bq[e]) + w2 * bfhi(cq[e]));
        *(u32x4*)(ATT + tok * DM + h * 64 + ch * 8) = o;
    }
}

constexpr int SC_T = 32, SC_VEC = SC_T * 64 * 4, SC_BUF = 6 * SC_VEC + 256;
constexpr int SC_BON = 2 * SC_BUF + 2 * SC_T * 64 * 4;
constexpr int SC_Y = 2 * SC_BUF;
template <int CTRL> __device__ __forceinline__ float dpp_add(float v) {
    const int m = __builtin_amdgcn_update_dpp(0, __float_as_int(v), CTRL, 0xf, 0xf, true);
    return v + __int_as_float(m);
}
#ifdef DBG_SHFL
__device__ __forceinline__ float red8(float v) { v += __shfl_xor(v, 1); v += __shfl_xor(v, 2); v += __shfl_xor(v, 4); return v; }
#else
__device__ __forceinline__ float red8(float v) { v = dpp_add<0xB1>(v); v = dpp_add<0x4E>(v); v = dpp_add<0x141>(v); return v; }
#endif
__device__ __forceinline__ float red16x2(float v0, float v1, bool odd) {
    const float keep = odd ? v1 : v0, send = odd ? v0 : v1;
    float x = keep + __int_as_float(__builtin_amdgcn_update_dpp(0, __float_as_int(send), 0xB1, 0xf, 0xf, true));
    x = dpp_add<0x4E>(x);
    x = dpp_add<0x124>(x);
    x = dpp_add<0x128>(x);
    return x;
}
__device__ __forceinline__ u32x2 ld8_agent(const void* p) {
    const unsigned long long v = __hip_atomic_load((const unsigned long long*)p, __ATOMIC_RELAXED, __HIP_MEMORY_SCOPE_AGENT);
    return __builtin_bit_cast(u32x2, v);
}
__device__ __forceinline__ unsigned short ld2_agent(const unsigned short* p) {
    const unsigned* q = (const unsigned*)((size_t)p & ~(size_t)3);
    const unsigned w = __hip_atomic_load(q, __ATOMIC_RELAXED, __HIP_MEMORY_SCOPE_AGENT);
    return (unsigned short)(((size_t)p & 2) ? (w >> 16) : (w & 0xffffu));
}
__device__ __forceinline__ float wave_sum_dpp(float v) {
    v = dpp_add<0xB1>(v);
    v = dpp_add<0x4E>(v);
    v = dpp_add<0x124>(v);
    v = dpp_add<0x128>(v);
    v += __int_as_float(__builtin_amdgcn_update_dpp(0, __float_as_int(v), 0x142, 0xA, 0xF, false));
    v += __int_as_float(__builtin_amdgcn_update_dpp(0, __float_as_int(v), 0x143, 0xC, 0xF, false));
    return __int_as_float(__builtin_amdgcn_readlane(__float_as_int(v), 63));
}
__device__ __forceinline__ float red16_dpp(float v) {
    v = dpp_add<0xB1>(v); v = dpp_add<0x4E>(v); v = dpp_add<0x124>(v); v = dpp_add<0x128>(v); return v;
}
struct ScanRegs { u32x2 r, k, v, a, w; };
__device__ __forceinline__ float red8x2(float v0, float v1, bool odd) {
    const float keep = odd ? v1 : v0, send = odd ? v0 : v1;
    float x = keep + __int_as_float(__builtin_amdgcn_update_dpp(0, __float_as_int(send), 0xB1, 0xf, 0xf, true));
    x = dpp_add<0x4E>(x);
    int t = __builtin_amdgcn_update_dpp(0, __float_as_int(x), 0x104, 0xf, 0x5, false);
    t = __builtin_amdgcn_update_dpp(t, __float_as_int(x), 0x114, 0xf, 0xA, false);
    return x + __int_as_float(t);
}
__device__ __forceinline__ float dot8(const f32x4& sa, const f32x4& sb, const f32x4& va, const f32x4& vb) {
    f32x2 acc = (f32x2){sa.x, sa.y} * (f32x2){va.x, va.y};
    acc = __builtin_elementwise_fma((f32x2){sa.z, sa.w}, (f32x2){va.z, va.w}, acc);
    acc = __builtin_elementwise_fma((f32x2){sb.x, sb.y}, (f32x2){vb.x, vb.y}, acc);
    acc = __builtin_elementwise_fma((f32x2){sb.z, sb.w}, (f32x2){vb.z, vb.w}, acc);
    asm volatile("" : "+v"(acc));
    return acc.x + acc.y;
}
__device__ __forceinline__ void scan_unit(const bf16* __restrict__ R, const bf16* __restrict__ Kb, const bf16* __restrict__ Vb, const unsigned short* __restrict__ W16, const bf16* __restrict__ Ab,
                                          const bf16* __restrict__ Gb, const float* k_k, const float* k_a, const float* r_k, const float* ln_w, const float* ln_b, bf16* __restrict__ Z,
                                          int b, int h, LAS unsigned char* lds) {
    int tid = threadIdx.x; asm volatile("" : "+v"(tid)); const int lane = tid & 63, wid = __builtin_amdgcn_readfirstlane(tid >> 6);
    const size_t tok0 = (size_t)b * SEQ;
    constexpr int NC = SEQ / SC_T;
    constexpr int SC_YB = SC_T * 64 * 4;
    if (wid >= 4) {
        const int ht = tid - 256, ptt = ht >> 4, pj0 = 4 * (ht & 15), pcol = h * 64 + pj0, hw = wid - 4;
        const f32x4 kk4 = *(const f32x4*)(k_k + pcol), ka4 = *(const f32x4*)(k_a + pcol), rk4 = *(const f32x4*)(r_k + pcol);
        const int col = h * 64 + lane;
        const float lnw = ln_w[col], lnb = ln_b[col];
        ScanRegs pr, pq;
#define S_LOAD1(P, c, TT) do { const size_t o_ = (tok0 + (size_t)(c) * SC_T + (TT)) * DM + pcol; P.r = ld8_agent(R + o_); P.k = ld8_agent(Kb + o_); P.v = ld8_agent(Vb + o_); P.a = ld8_agent(Ab + o_); P.w = ld8_agent(W16 + o_); } while (0)
#define S_PREP1(P, buf, TT, BIDX) do { \
        LAS unsigned char* b_ = lds + (buf) * SC_BUF; \
        const f32x4 r4 = {bflo(P.r[0]), bfhi(P.r[0]), bflo(P.r[1]), bfhi(P.r[1])}; \
        const f32x4 k4 = {bflo(P.k[0]), bfhi(P.k[0]), bflo(P.k[1]), bfhi(P.k[1])}; \
        const f32x4 v4 = {bflo(P.v[0]), bfhi(P.v[0]), bflo(P.v[1]), bfhi(P.v[1])}; \
        const f32x4 a4 = {bflo(P.a[0]), bfhi(P.a[0]), bflo(P.a[1]), bfhi(P.a[1])}; \
        const unsigned wx_ = P.w[0], wy_ = P.w[1]; \
        const pg8::f16x2 wlo_ = __builtin_bit_cast(pg8::f16x2, wx_); const pg8::f16x2 whi_ = __builtin_bit_cast(pg8::f16x2, wy_); \
        const f32x4 w4 = {__expf((float)wlo_.x), __expf((float)wlo_.y), __expf((float)whi_.x), __expf((float)whi_.y)}; \
        f32x4 kk = k4 * kk4; float ss = (kk.x * kk.x + kk.y * kk.y) + (kk.z * kk.z + kk.w * kk.w); \
        ss = red16_dpp(ss); \
        kk = kk * fminf(__builtin_amdgcn_rsqf(ss), 1e12f); \
        const f32x4 km = k4 * (1.f + (a4 - 1.f) * ka4); \
        float bo = (r4.x * km.x * rk4.x + r4.y * km.y * rk4.y) + (r4.z * km.z * rk4.z + r4.w * km.w * rk4.w); \
        bo = red16_dpp(bo); \
        const int eo_ = ((TT) * 64 + pj0) * 4; \
        *(LAS f32x4*)(b_ + 0 * SC_VEC + eo_) = r4; *(LAS f32x4*)(b_ + 1 * SC_VEC + eo_) = w4; *(LAS f32x4*)(b_ + 2 * SC_VEC + eo_) = km; \
        *(LAS f32x4*)(b_ + 3 * SC_VEC + eo_) = -kk; *(LAS f32x4*)(b_ + 4 * SC_VEC + eo_) = kk * a4; *(LAS f32x4*)(b_ + 5 * SC_VEC + eo_) = v4; \
        if ((ht & 15) == 0) *(LAS float*)(lds + SC_BON + (BIDX) * 128 + (TT) * 4) = bo; } while (0)
        S_LOAD1(pr, 0, ptt); S_LOAD1(pq, 0, ptt + 16); S_PREP1(pr, 0, ptt, 0); S_PREP1(pq, 0, ptt + 16, 0);
        __syncthreads();
        for (int c = 0; c <= NC; ++c) {
            if (c + 1 < NC) { S_LOAD1(pr, c + 1, ptt); S_LOAD1(pq, c + 1, ptt + 16); }
            if (c >= 1) {
                const int cp = c - 1;
                const LAS float* ybuf = (const LAS float*)(lds + SC_Y + (cp & 1) * SC_YB);
#pragma unroll
                for (int q = 0; q < SC_T / 4; ++q) {
                    const int tt = hw + 4 * q;
                    const float y = ybuf[tt * 64 + lane];
                    const float mean = wave_sum_dpp(y) * (1.f / 64.f); const float dy = y - mean;
                    const float var = wave_sum_dpp(dy * dy) * (1.f / 64.f);
                    const float yn = dy * __builtin_amdgcn_rsqf(var + 64e-5f) * lnw + lnb;
                    const size_t o_ = (tok0 + (size_t)cp * SC_T + tt) * DM + col;
                    const float bo = *(const LAS float*)(lds + SC_BON + (cp % 3) * 128 + tt * 4), vv = bf2f(ld2_agent(Vb + o_));
                    const float gt = bf2f(ld2_agent(Gb + o_));
                    const float outv = (yn + bo * vv) * gt;
                    Z[o_] = (bf16)(pkbf(outv, outv) & 0xffffu);
                }
            }
            if (c + 1 < NC) { const int bi_ = (c + 1) % 3; S_PREP1(pr, (c + 1) & 1, ptt, bi_); S_PREP1(pq, (c + 1) & 1, ptt + 16, bi_); }
            __syncthreads();
        }
#undef S_LOAD1
#undef S_PREP1
    } else {
        const int sq = lane & 7, si0 = 16 * wid + 2 * (lane >> 3), sj = 8 * sq;
        const bool odd = (sq & 1) != 0;
        f32x4 S0a = {0.f, 0.f, 0.f, 0.f}, S0b = S0a, S1a = S0a, S1b = S0a;
        __syncthreads();
        for (int c = 0; c <= NC; ++c) {
            if (c < NC) {
                const LAS unsigned char* bb = lds + (c & 1) * SC_BUF;
                LAS float* ybuf = (LAS float*)(lds + SC_Y + (c & 1) * SC_YB);
                const LAS unsigned char* vp_ = bb + sj * 4;
                const LAS unsigned char* vv_ = bb + 5 * SC_VEC + si0 * 4;
#define LD8(dstA, dstB, slot, TT) dstA = *(const LAS f32x4*)(vp_ + (slot) * SC_VEC + (TT) * 256); dstB = *(const LAS f32x4*)(vp_ + (slot) * SC_VEC + (TT) * 256 + 16)
                f32x4 rA, rB, wA, wB, kA, kB, aA, aB, bA, bB; f32x2 v2;
                LD8(rA, rB, 0, 0); LD8(wA, wB, 1, 0); LD8(kA, kB, 2, 0); LD8(aA, aB, 3, 0); LD8(bA, bB, 4, 0); v2 = *(const LAS f32x2*)(vv_);
#pragma unroll 2
                for (int tt = 0; tt < SC_T; ++tt) {
                    const int tn = (tt + 1) & (SC_T - 1);
                    f32x4 nrA, nrB, nwA, nwB, nkA, nkB, naA, naB, nbA, nbB;
                    LD8(nrA, nrB, 0, tn); LD8(nwA, nwB, 1, tn); LD8(nkA, nkB, 2, tn); LD8(naA, naB, 3, tn); LD8(nbA, nbB, 4, tn);
                    const f32x2 nv2 = *(const LAS f32x2*)(vv_ + tn * 256);
                    const float sx = red8x2(dot8(S0a, S0b, aA, aB), dot8(S1a, S1b, aA, aB), odd);
                    const float sa0 = __int_as_float(__builtin_amdgcn_update_dpp(0, __float_as_int(sx), 0x00, 0xf, 0xf, true));
                    const float sa1 = __int_as_float(__builtin_amdgcn_update_dpp(0, __float_as_int(sx), 0x55, 0xf, 0xf, true));
                    S0a = S0a * wA + (bA * sa0 + kA * v2.x); S0b = S0b * wB + (bB * sa0 + kB * v2.x);
                    S1a = S1a * wA + (bA * sa1 + kA * v2.y); S1b = S1b * wB + (bB * sa1 + kB * v2.y);
                    const float yx = red8x2(dot8(S0a, S0b, rA, rB), dot8(S1a, S1b, rA, rB), odd);
                    if (sq < 2) ybuf[tt * 64 + si0 + sq] = yx;
                    rA = nrA; rB = nrB; wA = nwA; wB = nwB; kA = nkA; kB = nkB; aA = naA; aB = naB; bA = nbA; bB = nbB; v2 = nv2;
                }
#undef LD8
            }
            __syncthreads();
        }
    }
    __syncthreads();
}

#ifdef DBG_CHECK
__device__ __forceinline__ unsigned hsh(unsigned x) { x ^= x >> 16; x *= 0x7feb352dU; x ^= x >> 15; x *= 0x846ca68bU; x ^= x >> 16; return x; }
__device__ __forceinline__ float dotcol(const bf16* arow, const float* W, int N, int c, int K, int lane) {
    float s = 0.f; for (int k = lane; k < K; k += 64) s += bf2f(arow[k]) * W[(size_t)k * N + c]; return wave_sum(s);
}
#define ERR_ACC(ref, fast) do { const float r_ = (ref), f_ = (fast); d2 += (r_ - f_) * (r_ - f_); r2 += r_ * r_; } while (0)
#define ERR_DONE(stage) do { d2 = wave_sum(d2); r2 = wave_sum(r2); if (lane == 0) CTLp[16 + (stage)] = sqrtf(d2 / fmaxf(r2, 1e-30f)); } while (0)
__device__ __forceinline__ void dbg_check(int ph, const Args* Ap, LAS unsigned char* lds, int lane) {
    asm volatile("" : "+s"(Ap)); const Args& A = *Ap; unsigned char* ws = A.ws; float* CTLp = (float*)(ws + WS_CTL);
    const bf16* HN = (const bf16*)(ws + WS_HN); const bf16* QKV = (const bf16*)(ws + WS_QKV); const bf16* ATT = (const bf16*)(ws + WS_ATT); const bf16* U = (const bf16*)(ws + WS_U);
    const bf16* X6 = (const bf16*)(ws + WS_X6); const bf16* TT = (const bf16*)(ws + WS_T); const bf16* RKV = (const bf16*)(ws + WS_RKV); const bf16* WAG = (const bf16*)(ws + WS_WAG); const bf16* Z = (const bf16*)(ws + WS_Z);
    const float* H = A.out; LAS float* sl = (LAS float*)lds;
    float d2 = 0.f, r2 = 0.f;
    if (ph == 1) {
        for (int smp = 0; smp < 48; ++smp) {
            const int t = hsh(smp) & 65535; int c = hsh(smp + 1000) % 3072; if (smp % 3 == 0) c = (c & ~63) | (hsh(smp + 7) & 15);
            const int sec = c / 512, hc = c & 63; const bf16* ar = HN + (size_t)t * DM;
            float v = dotcol(ar, A.attn_w_in, 3072, c, 1024, lane);
            if (sec != 2 && sec != 5 && hc < 16) { const float vp = dotcol(ar, A.attn_w_in, 3072, c ^ 8, 1024, lane); const float ang = (float)(t & 4095) * powf(500000.f, -(float)(hc & 7) / 8.f);
                v = (hc < 8) ? v * cosf(ang) - vp * sinf(ang) : v * cosf(ang) + vp * sinf(ang); }
            if (sec == 0 || sec == 3) v *= 0.125f * 1.4426950408889634f;
            if (lane == 0) ERR_ACC(v, bf2f(QKV[(size_t)t * QKVC + c]));
        }
        ERR_DONE(1);
    }
    if (ph == 2) {
        const float lam = CTLp[0];
        for (int smp = 0; smp < 7; ++smp) {
            int q = 0; if (smp == 1) q = 63; if (smp == 2) q = 64; if (smp == 3) q = 127; if (smp == 4) q = 128; if (smp == 5) q = 1000; if (smp == 6) q = 4095;
            const int b = hsh(smp + 50) & 15, h = hsh(smp + 60) & 3; const size_t tok0 = (size_t)b * SEQ;
            float mc[2], lc[2];
            for (int c = 0; c < 2; ++c) {
                const bf16* qp = QKV + (tok0 + q) * QKVC + 1536 + h * 128 + c * 64; float m = -INFINITY;
                for (int k = lane; k <= q; k += 64) { const bf16* kp = QKV + (tok0 + k) * QKVC + 2048 + h * 128 + c * 64; float s = 0.f; for (int d = 0; d < 64; ++d) s += bf2f(qp[d]) * bf2f(kp[d]); sl[c * 4096 + k] = s; m = fmaxf(m, s); }
#pragma unroll
                for (int o = 1; o < 64; o <<= 1) m = fmaxf(m, __shfl_xor(m, o));
                float l = 0.f; for (int k = lane; k <= q; k += 64) l += exp2f(sl[c * 4096 + k] - m);
                mc[c] = m; lc[c] = wave_sum(l);
            }
            asm volatile("s_waitcnt lgkmcnt(0)" ::: "memory");
            float o0 = 0.f, o1 = 0.f;
            for (int k = 0; k <= q; ++k) { const float a = exp2f(sl[k] - mc[0]) / lc[0] - lam * exp2f(sl[4096 + k] - mc[1]) / lc[1]; const bf16* vp = QKV + (tok0 + k) * QKVC + 2560 + h * 128; o0 += a * bf2f(vp[lane]); o1 += a * bf2f(vp[64 + lane]); }
            const float ss = wave_sum(o0 * o0 + o1 * o1), rs = 0.8f / sqrtf(ss / 128.f + 1e-5f);
            const bf16* ap = ATT + (tok0 + q) * DM + 512 + h * 128;
            ERR_ACC(o0 * rs * A.diff_subln[lane], bf2f(ap[lane])); ERR_ACC(o1 * rs * A.diff_subln[64 + lane], bf2f(ap[64 + lane]));
        }
        ERR_DONE(2);
    }
    if (ph == 3) {
        for (int smp = 0; smp < 10; ++smp) {
            int t = 0; if (smp == 1) t = 1; if (smp == 2) t = 127; if (smp == 3) t = 128; if (smp == 4) t = 129; if (smp == 5) t = 515; if (smp == 6) t = 2047; if (smp == 7) t = 2048; if (smp == 8) t = 4095; if (smp == 9) t = 3001;
            const int b = hsh(smp + 150) & 15, h = hsh(smp + 160) & 7; const size_t tok0 = (size_t)b * SEQ;
            const bf16* qp = QKV + (tok0 + t) * QKVC + h * 64; float m = -INFINITY;
            for (int e = lane; e < 387; e += 64) { const int pat = e / 129, mm = e % 129, dil = (pat == 0) ? 1 : ((pat == 1) ? 4 : 16), pos = t - mm * dil; float s = -INFINITY;
                if (pos >= 0) { const bf16* kp = QKV + (tok0 + pos) * QKVC + 512 + h * 64; s = 0.f; for (int d = 0; d < 64; ++d) s += bf2f(qp[d]) * bf2f(kp[d]); }
                sl[e] = s; m = fmaxf(m, s); }
#pragma unroll
            for (int o = 1; o < 64; o <<= 1) m = fmaxf(m, __shfl_xor(m, o));
            float l = 0.f; for (int e = lane; e < 387; e += 64) l += exp2f(sl[e] - m);
            l = wave_sum(l);
            asm volatile("s_waitcnt lgkmcnt(0)" ::: "memory");
            float o = 0.f;
            for (int e = 0; e < 387; ++e) { const int pat = e / 129, mm = e % 129, dil = (pat == 0) ? 1 : ((pat == 1) ? 4 : 16), pos = t - mm * dil; if (pos >= 0) o += exp2f(sl[e] - m) / l * bf2f(QKV[(tok0 + pos) * QKVC + 1024 + h * 64 + lane]); }
            ERR_ACC(o, bf2f(ATT[(tok0 + t) * DM + h * 64 + lane]));
        }
        ERR_DONE(3);
    }
    if (ph == 4) {
        for (int smp = 0; smp < 32; ++smp) { const int t = hsh(smp + 300) & 65535, c = hsh(smp + 400) & 1023;
            const float v = A.x[(size_t)t * DM + c] + dotcol(ATT + (size_t)t * DM, A.attn_w_out, 1024, c, 1024, lane); if (lane == 0) ERR_ACC(v, H[(size_t)t * DM + c]); }
        ERR_DONE(4);
    }
    if (ph == 6) {
        for (int smp = 0; smp < 32; ++smp) { const int t = hsh(smp + 500) & 65535, c = hsh(smp + 600) & 4095;
            float v = fmaxf(dotcol(HN + (size_t)t * DM, A.mlp_w1, 4096, c, 1024, lane), 0.f); v *= v; if (lane == 0) ERR_ACC(v, bf2f(U[(size_t)t * DFF + c])); }
        ERR_DONE(6);
    }
    if (ph == 8) {
        for (int smp = 0; smp < 12; ++smp) { int t = hsh(smp + 700) & 65535; if (smp == 0) t = 4096; if (smp == 1) t = 4095; if (smp == 2) t = 32; const int slot = smp % 6, mi = (slot == 1) ? 2 : ((slot == 2) ? 3 : ((slot == 3) ? 1 : slot));
            float s0 = 0.f, s1 = 0.f; const bool hp = (t & 4095) != 0;
            for (int k = lane; k < 1024; k += 64) { const float a = H[(size_t)t * DM + k]; s0 += a * a; if (hp) { const float p = H[(size_t)(t - 1) * DM + k]; s1 += p * p; } }
            const float r0 = 1.f / sqrtf(wave_sum(s0) / 1024.f + 1e-5f), r1 = 1.f / sqrtf(wave_sum(s1) / 1024.f + 1e-5f);
            for (int k = lane; k < 1024; k += 64) { const float g = A.norm_mix[DM + k]; const float hn = H[(size_t)t * DM + k] * r0 * g, hpv = hp ? H[(size_t)(t - 1) * DM + k] * r1 * g : 0.f;
                ERR_ACC(hn + (hpv - hn) * A.rwkv_mu[mi * DM + k], bf2f(X6[(size_t)slot * NTOK * DM + (size_t)t * DM + k])); } }
        ERR_DONE(8);
    }
    if (ph == 9) {
        for (int smp = 0; smp < 30; ++smp) { const int t = hsh(smp + 800) & 65535, wh = smp % 3, nn = (wh == 2) ? 160 : 64, c = hsh(smp + 900) % nn;
            const float* W = (wh == 0) ? A.rwkv_w1 : ((wh == 1) ? A.rwkv_a1 : A.rwkv_g1);
            float v = dotcol(X6 + (size_t)(3 + wh) * NTOK * DM + (size_t)t * DM, W, nn, c, 1024, lane); if (wh == 0) v = tanhf(v); if (wh == 2) v = 1.f / (1.f + expf(-v));
            if (lane == 0) ERR_ACC(v, bf2f(TT[(size_t)wh * NTOK * 256 + (size_t)t * 256 + c])); }
        ERR_DONE(9);
    }
    if (ph == 10) {
        for (int smp = 0; smp < 30; ++smp) { const int t = hsh(smp + 1100) & 65535, wh = smp % 3, c = hsh(smp + 1200) & 1023;
            const float* W = (wh == 0) ? A.rwkv_w_r : ((wh == 1) ? A.rwkv_w_k : A.rwkv_w_v);
            const float v = dotcol(X6 + (size_t)wh * NTOK * DM + (size_t)t * DM, W, 1024, c, 1024, lane); if (lane == 0) ERR_ACC(v, bf2f(RKV[(size_t)wh * NTOK * DM + (size_t)t * DM + c])); }
        ERR_DONE(10);
    }
    if (ph == 11) {
        for (int smp = 0; smp < 30; ++smp) { const int t = hsh(smp + 1300) & 65535, wh = smp % 3, kk = (wh == 2) ? 160 : 64, c = hsh(smp + 1400) & 1023;
            const float* W = (wh == 0) ? A.rwkv_w2 : ((wh == 1) ? A.rwkv_a2 : A.rwkv_g2);
            float v = dotcol(TT + (size_t)wh * NTOK * 256 + (size_t)t * 256, W, 1024, c, kk, lane); float f;
            const unsigned short raw = WAG[(size_t)wh * NTOK * DM + (size_t)t * DM + c];
            if (wh == 0) { const float z = A.rwkv_w0[c] + v; const float sp = fmaxf(-z, 0.f) + log1pf(expf(-fabsf(z))); v = -expf(-sp - 0.5f); f = (float)__builtin_bit_cast(_Float16, raw); }
            else if (wh == 1) { v = 1.f / (1.f + expf(-(A.rwkv_a0[c] + v))); f = bf2f(raw); } else f = bf2f(raw);
            if (lane == 0) ERR_ACC(v, f); }
        ERR_DONE(11);
    }
    if (ph == 12) {
        float ed[5] = {0.f, 0.f, 0.f, 0.f, 0.f}, er[5] = {0.f, 0.f, 0.f, 0.f, 0.f};
#pragma unroll
        for (int smp = 0; smp < 3; ++smp) {
            const int b = 0, h = smp; const size_t tok0 = (size_t)b * SEQ; const int col = h * 64 + lane;
            LAS float* sv = sl + 4096;
            for (int i = 0; i < 64; ++i) sl[i * 64 + lane] = 0.f;
            for (int t = 0; t < 40; ++t) {
                const size_t o = (tok0 + t) * DM + col;
                const float r = bf2f(RKV[o]), k = bf2f(RKV[(size_t)NTOK * DM + o]), v = bf2f(RKV[2 * (size_t)NTOK * DM + o]);
                const float w = expf((float)__builtin_bit_cast(_Float16, (unsigned short)WAG[o])), a = bf2f(WAG[(size_t)NTOK * DM + o]);
                float kk = k * A.rwkv_k_k[col]; kk = kk / fmaxf(sqrtf(wave_sum(kk * kk)), 1e-12f);
                const float km = k * (1.f + (a - 1.f) * A.rwkv_k_a[col]);
                float yl = 0.f;
                sv[lane] = v; asm volatile("s_waitcnt lgkmcnt(0)" ::: "memory");
#pragma unroll 1
                for (int i = 0; i < 64; ++i) { float st = sl[i * 64 + lane]; const float sa = wave_sum(st * (-kk)); st = st * w + sa * (kk * a) + sv[i] * km; sl[i * 64 + lane] = st; const float y = wave_sum(st * r); if (lane == i) yl = sa; }
                const float bonus = wave_sum(r * km * A.rwkv_r_k[col]);
                const float f_ = bf2f(Z[o]);
                if (smp == 0) { const float dd = (yl - f_) * (yl - f_), rr = yl * yl; if (t == 1) { ed[0] += 36.f * dd; er[0] += rr; } if (t == 2) { ed[3] += 36.f * dd; er[3] += rr; } if (t < 32) { ed[4] += dd; er[4] += rr; } }
                if (smp == 1) { ed[1] += (1.f - w - f_) * (1.f - w - f_); er[1] += (1.f - w) * (1.f - w); }
                if (smp == 2) { ed[2] += (kk * a - f_) * (kk * a - f_); er[2] += kk * a * kk * a; }
            }
        }
#pragma unroll
        for (int q = 0; q < 5; ++q) { d2 = ed[q]; r2 = er[q]; ERR_DONE(12 + q); }
    }
    if (ph == 13) {
    }
}
#endif
#define AS4 __attribute__((address_space(4)))
__device__ __forceinline__ const unsigned char AS4* kargs() { const unsigned char AS4* p = (const unsigned char AS4*)__builtin_amdgcn_kernarg_segment_ptr(); asm volatile("" : "+s"(p)); return p; }
#define KA(member) (*(decltype(Args::member) const AS4*)(kargs() + offsetof(Args, member)))
#define WSB(off) ((bf16*)(KA(ws) + (off)))
#define P_W_IN WSB(WS_WIN)
#define P_W_OUT WSB(WS_WOUT)
#define P_W1_0 WSB(WS_W1_0)
#define P_W2_0 WSB(WS_W2_0)
#define P_W1_1 WSB(WS_W1_1)
#define P_W2_1 WSB(WS_W2_1)
#define P_WR WSB(WS_WR)
#define P_WK WSB(WS_WK)
#define P_WV WSB(WS_WV)
#define P_WO WSB(WS_WO)
#define P_LW1 WSB(WS_LW1)
#define P_LA1 WSB(WS_LA1)
#define P_LG1 WSB(WS_LG1)
#define P_LW2 WSB(WS_LW2)
#define P_LA2 WSB(WS_LA2)
#define P_LG2 WSB(WS_LG2)
#define P_HN WSB(WS_HN)
#define P_QKV WSB(WS_QKV)
#define P_ATT WSB(WS_ATT)
#define P_OAP WSB(WS_OAP)
#define P_U WSB(WS_U)
#define P_X6 WSB(WS_X6)
#define P_TT WSB(WS_T)
#define P_RKV WSB(WS_RKV)
#define P_WAG WSB(WS_WAG)
#define P_Z WSB(WS_Z)
#define P_ROPE ((float*)(KA(ws) + WS_ROPE))
#define P_CTL ((float*)(KA(ws) + WS_CTL))
#define P_LSE ((float*)(KA(ws) + WS_LSE))
#define P_H (KA(out))
__global__ void __launch_bounds__(NTHR, 2) hybrid_fwd(Args A_unused) {
    extern __shared__ __attribute__((aligned(16))) unsigned char lds_raw[];
    LAS unsigned char* lds = (LAS unsigned char*)lds_raw;
    cg::grid_group grid = cg::this_grid();
    { int t0_ = threadIdx.x; asm volatile("" : "+v"(t0_)); if (t0_ < 2) ((LAS unsigned*)(lds + LDS_BARST))[t0_] = 0u; }
    __syncthreads();
    (void)xcd_barrier_post((unsigned*)(KA(ws) + WS_BAR), (volatile LAS unsigned*)(lds + LDS_BARST));
    const int G = gridDim.x, bx = blockIdx.x, ngw = G * NWAVES, ngt = G * NTHR;
#define TIDV int tid = threadIdx.x; asm volatile("" : "+v"(tid)); const int lane = tid & 63, wave = __builtin_amdgcn_readfirstlane(tid >> 6), gw = bx * NWAVES + wave, gt = bx * NTHR + tid; (void)lane; (void)gw; (void)gt;
    constexpr int lo = 0, hi = 18;
    int ph = 0;
#define PHASE_BEGIN if (ph >= lo && ph < hi) { TIDV
#ifdef DBG_CHECK
#define PHASE_END   } grid.sync(); { int t2_ = threadIdx.x; asm volatile("" : "+v"(t2_)); if (bx == 0 && t2_ < 64) dbg_check(ph, (const Args*)(const void*)__builtin_amdgcn_kernarg_segment_ptr(), lds, t2_); } grid.sync(); ++ph;
#else
#define PHASE_END   if (ph + 1 < hi) { if (ph == 0) grid.sync(); else { XcdBarrier xb_; xb_.bar = (unsigned*)(KA(ws) + WS_BAR); xb_.x = xb_xcc_id(); xb_.st = (volatile LAS unsigned*)(lds + LDS_BARST); xcd_barrier(xb_); } } } ++ph;
#endif
#define GEMM(EPI, Aptr, Bptr, N_, K_, ...) do { pg8::Gemm g_{(const pg8::bf16_t*)(Aptr), (const pg8::bf16_t*)(Bptr), NTOK, (N_), (K_)}; pg8::StaticOrder S_; S_.init(NTOK, (N_), G, bx); \
        EPI E_{__VA_ARGS__}; pg8::gemm_phase<EPI, pg8::StaticOrder, true, true>(lds, g_, S_, E_); } while (0)

    PHASE_BEGIN
    {
        LAS float* scr = (LAS float*)(lds + wave * 8192);
        int it0 = gw;
#define TJOB(W, K_, N_, WT, PITCH) { const int ni_ = ((K_) / 32) * ((N_) / 32); for (; it0 < ni_; it0 += ngw) transpose_item((W), (N_), (WT), (PITCH), scr, it0, lane); it0 -= ni_; }
        TJOB(KA(attn_w_in), 1024, 3072, P_W_IN, 1024)
        TJOB(KA(attn_w_out), 1024, 1024, P_W_OUT, 1024)
        TJOB(KA(mlp_w1), 1024, 4096, P_W1_0, 1024)
        TJOB(KA(mlp_w1) + (size_t)1024 * 4096, 1024, 4096, P_W1_1, 1024)
        TJOB(KA(mlp_w2), 4096, 1024, P_W2_0, 4096)
        TJOB(KA(mlp_w2) + (size_t)4096 * 1024, 4096, 1024, P_W2_1, 4096)
        TJOB(KA(rwkv_w_r), 1024, 1024, P_WR, 1024)
        TJOB(KA(rwkv_w_k), 1024, 1024, P_WK, 1024)
        TJOB(KA(rwkv_w_v), 1024, 1024, P_WV, 1024)
        TJOB(KA(rwkv_w_o), 1024, 1024, P_WO, 1024)
        TJOB(KA(rwkv_w1), 1024, 64, P_LW1, 1024)
        TJOB(KA(rwkv_a1), 1024, 64, P_LA1, 1024)
        TJOB(KA(rwkv_g1), 1024, 160, P_LG1, 1024)
        TJOB(KA(rwkv_w2), 64, 1024, P_LW2, 256)
        TJOB(KA(rwkv_a2), 64, 1024, P_LA2, 256)
        TJOB(KA(rwkv_g2), 160, 1024, P_LG2, 256)
#undef TJOB
        zero_region(P_LW1, 1024, 64, 256, 0, 1024, gt, ngt); zero_region(P_LA1, 1024, 64, 256, 0, 1024, gt, ngt); zero_region(P_LG1, 1024, 160, 256, 0, 1024, gt, ngt);
        zero_region(P_LW2, 256, 0, 1024, 64, 256, gt, ngt); zero_region(P_LA2, 256, 0, 1024, 64, 256, gt, ngt); zero_region(P_LG2, 256, 0, 1024, 160, 256, gt, ngt);
        for (int i = gt; i < 4096 * 8; i += ngt) {
            const int pos = i >> 3, f = i & 7;
            const float invf = (float)exp(-(double)f * 0.125 * log(500000.0));
            const float ang = (float)pos * invf;
            P_ROPE[pos * 16 + f] = (float)cos((double)ang); P_ROPE[pos * 16 + 8 + f] = (float)sin((double)ang);
        }
        if (bx == 0 && wave == 0) {
            const float* lp = KA(diff_lambda);
            const float s01 = wave_sum(lp[lane] * lp[64 + lane]), s23 = wave_sum(lp[128 + lane] * lp[192 + lane]);
            if (lane == 0) P_CTL[0] = expf(s01) - expf(s23) + 0.2f;
        }
        rms_phase_bf16(KA(x), KA(norm_mix), P_HN, gw, ngw, lane);
    }
    PHASE_END
    PHASE_BEGIN
    GEMM(pg8::Epi16<pg8::M_QKV>, P_HN, P_W_IN, QKVC, 1024, P_QKV, QKVC, P_ROPE);
    PHASE_END
    PHASE_BEGIN
    {
        const float lam = P_CTL[0];
        for (int rep_ = 0; rep_ < REP_ATTN; ++rep_)
        for (int u = bx; u < 2048; u += G) {
            const int i = u >> 8, cidx = u & 255, bh = cidx >> 2, s = (cidx & 3) * 4 + (i >> 1), qb = (i & 1) ? 31 - s : s;
            diffattn_unit(P_QKV, P_ATT, KA(diff_subln), lam, bh >> 2, bh & 3, qb, lds);
        }
        for (int rep_ = 0; rep_ < REP_ATTNA; ++rep_)
        for (int v = bx; v < 6144; v += G) {
            const int bh = v / 48, r48 = v - bh * 48, pat = r48 >> 4, q16 = r48 & 15;
            const int dil = (pat == 0) ? 1 : ((pat == 1) ? 4 : 16);
            const int nper = 16 / dil;
            const int res = q16 / nper, n = q16 - res * nper;
            dilattn_unit(P_QKV, P_OAP, P_LSE, bh >> 3, bh & 7, dil, res, n, lds);
        }
    }
    PHASE_END
    PHASE_BEGIN
    combine_phase(P_OAP, P_LSE, P_ATT, gt, ngt);
    PHASE_END
    PHASE_BEGIN
    GEMM(pg8::EpiRes, P_ATT, P_W_OUT, 1024, 1024, KA(x), P_H, DM);
    PHASE_END
    PHASE_BEGIN
    for (int rep_ = 0; rep_ < REP_RMS; ++rep_)
    rms_phase_bf16(P_H, KA(norm_mlp), P_HN, gw, ngw, lane);
    PHASE_END
    PHASE_BEGIN
    for (int rep_ = 0; rep_ < REP_UP; ++rep_)
    GEMM(pg8::Epi16<pg8::M_RELU2>, P_HN, P_W1_0, DFF, 1024, P_U, DFF, nullptr);
    PHASE_END
    PHASE_BEGIN
    GEMM(pg8::EpiRes, P_U, P_W2_0, 1024, DFF, P_H, P_H, DM);
    PHASE_END
    PHASE_BEGIN
    for (int rep_ = 0; rep_ < REP_XMIX; ++rep_)
    xmix_phase(P_H, KA(norm_mix) + DM, KA(rwkv_mu), P_X6, gw, ngw, lane);
    PHASE_END
    PHASE_BEGIN
    for (int rep_ = 0; rep_ < REP_LORA; ++rep_) {
    GEMM(pg8::Epi16<pg8::M_TANH>, P_X6 + 3 * (size_t)NTOK * DM, P_LW1, 256, 1024, P_TT, 256, nullptr);
    GEMM(pg8::Epi16<pg8::M_PLAIN>, P_X6 + 4 * (size_t)NTOK * DM, P_LA1, 256, 1024, P_TT + (size_t)NTOK * 256, 256, nullptr);
    GEMM(pg8::Epi16<pg8::M_SIGMOID>, P_X6 + 5 * (size_t)NTOK * DM, P_LG1, 256, 1024, P_TT + (size_t)2 * NTOK * 256, 256, nullptr); }
    PHASE_END
    PHASE_BEGIN
    GEMM(pg8::Epi16<pg8::M_PLAIN>, P_X6, P_WR, 1024, 1024, P_RKV, DM, nullptr);
    GEMM(pg8::Epi16<pg8::M_PLAIN>, P_X6 + (size_t)NTOK * DM, P_WK, 1024, 1024, P_RKV + (size_t)NTOK * DM, DM, nullptr);
    GEMM(pg8::Epi16<pg8::M_PLAIN>, P_X6 + 2 * (size_t)NTOK * DM, P_WV, 1024, 1024, P_RKV + 2 * (size_t)NTOK * DM, DM, nullptr);
    PHASE_END
    PHASE_BEGIN
    for (int rep_ = 0; rep_ < REP_LORA; ++rep_) {
    GEMM(pg8::Epi16<pg8::M_WLOG>, P_TT, P_LW2, 1024, 256, P_WAG, DM, KA(rwkv_w0));
    GEMM(pg8::Epi16<pg8::M_ASIG>, P_TT + (size_t)NTOK * 256, P_LA2, 1024, 256, P_WAG + (size_t)NTOK * DM, DM, KA(rwkv_a0));
    GEMM(pg8::Epi16<pg8::M_PLAIN>, P_TT + (size_t)2 * NTOK * 256, P_LG2, 1024, 256, P_WAG + 2 * (size_t)NTOK * DM, DM, nullptr); }
    PHASE_END
    PHASE_BEGIN
    for (int rep_ = 0; rep_ < REP_SCAN; ++rep_)
    for (int u = bx; u < 256; u += G)
        scan_unit(P_RKV, P_RKV + (size_t)NTOK * DM, P_RKV + 2 * (size_t)NTOK * DM, (const unsigned short*)P_WAG, P_WAG + (size_t)NTOK * DM, P_WAG + 2 * (size_t)NTOK * DM,
                  KA(rwkv_k_k), KA(rwkv_k_a), KA(rwkv_r_k), KA(rwkv_ln_w), KA(rwkv_ln_b), P_Z, u >> 4, u & 15, lds);
    PHASE_END
    PHASE_BEGIN
    GEMM(pg8::EpiRes, P_Z, P_WO, 1024, 1024, P_H, P_H, DM);
    PHASE_END
    PHASE_BEGIN
    rms_phase_bf16(P_H, KA(norm_mlp) + DM, P_HN, gw, ngw, lane);
    PHASE_END
    PHASE_BEGIN
    GEMM(pg8::Epi16<pg8::M_RELU2>, P_HN, P_W1_1, DFF, 1024, P_U, DFF, nullptr);
    PHASE_END
    PHASE_BEGIN
    GEMM(pg8::EpiRes, P_U, P_W2_1, 1024, DFF, P_H, P_H, DM);
    PHASE_END
    PHASE_BEGIN
    rms_phase_f32(P_H, KA(norm_final), P_H, gw, ngw, lane);
    PHASE_END
#ifdef DBG_CHECK
    { TIDV
      const float* CTLp = P_CTL; int bad = 0; float ev = 0.f;
      for (int k = 1; k < 20; ++k) { const float e = CTLp[16 + k]; if (bad == 0 && !(e < 0.03f)) { bad = k; ev = (e == e) ? e : 9.99f; } }
      if (bad) { float* o = P_H; const float c = sqrtf(10.f * (float)bad); for (size_t i = gt; i < (size_t)NTOK * DM; i += ngt) o[i] = c; if (gt == 0) o[0] = 1000.f * ev; } }
#endif
}
constexpr int N_PHASES = 18;

extern "C" void kernel_launch(void* const* d_in, const int* in_sizes, int n_in, void* d_out, int out_size, void* d_ws, size_t ws_size, hipStream_t stream) {
    static int grid = 0;
    if (grid == 0) {
        if (n_in != 28 || in_sizes[0] != NTOK * DM || out_size != NTOK * DM || ws_size < WS_END) { fprintf(stderr, "kernel_launch: unexpected shapes (n_in %d, ws %zu)\n", n_in, ws_size); grid = -1; return; }
        int dev = 0, cus = 0, per_cu = 0;
        hipGetDevice(&dev); hipDeviceGetAttribute(&cus, hipDeviceAttributeMultiprocessorCount, dev);
        if (hipFuncSetAttribute((const void*)hybrid_fwd, hipFuncAttributeMaxDynamicSharedMemorySize, LDS_BYTES) != hipSuccess) { fprintf(stderr, "kernel_launch: hipFuncSetAttribute failed\n"); grid = -1; return; }
        hipOccupancyMaxActiveBlocksPerMultiprocessor(&per_cu, (const void*)hybrid_fwd, NTHR, LDS_BYTES);
        (void)hipGetLastError();
        if (per_cu < 1) per_cu = 1;
        grid = cus * per_cu;
        fprintf(stderr, "kernel_launch: %d CUs x %d -> grid %d\n", cus, per_cu, grid);
    }
    if (grid < 0) return;
    if (hipMemsetAsync(d_ws, 0, CTL_ZERO_BYTES, stream) != hipSuccess) { fprintf(stderr, "kernel_launch: hipMemsetAsync failed\n"); return; }
    Args a{};
    const float** fp = (const float**)&a;
    for (int i = 0; i < 28; ++i) fp[i] = (const float*)d_in[i];
    a.out = (float*)d_out; a.ws = (unsigned char*)d_ws; a.ph_lo = 0; a.ph_hi = N_PHASES;
    void* args[] = {&a};
    hipError_t e = hipLaunchCooperativeKernel((const void*)hybrid_fwd, dim3(grid), dim3(NTHR), args, LDS_BYTES, stream);
    if (e != hipSuccess) fprintf(stderr, "cooperative launch failed: %s (grid %d)\n", hipGetErrorString(e), grid);
}
```

```cpp
#include <hip/hip_runtime.h>
#include <hip/hip_cooperative_groups.h>
#include <cstdio>
#include <cstdint>
namespace cg = cooperative_groups;
namespace pg8 {
#define PG8_LAS __attribute__((address_space(3)))
typedef unsigned short bf16_t;
typedef short bf16x8 __attribute__((ext_vector_type(8)));
typedef float f32x4 __attribute__((ext_vector_type(4)));
typedef unsigned u32x4 __attribute__((ext_vector_type(4)));
constexpr int BM = 256, BK = 64, HALF = 128, HTB = HALF * BK * 2  , STAGE_BYTES = 8 * HTB, NXCD = 8, WGM = 8;

__host__ __device__ __forceinline__ int lds_byte(int r, int c) { const int st = (r >> 4) * 2 + (c >> 5), rr = r & 15, cc = c & 31, ob = rr * 64 + cc * 2; return st * 1024 + (ob ^ (((ob >> 9) & 1) << 5)); }
__host__ __device__ __forceinline__ void stage_rc(int b, int& R, int& C) { const int st = b / 1024, sb = b % 1024, swz = sb ^ (((sb >> 9) & 1) << 5); R = (st >> 1) * 16 + swz / 64; C = (st & 1) * 32 + (swz % 64) / 2; }
__host__ __device__ __forceinline__ int perm32(int rho) { const int n = rho >> 4, i = rho & 15; return 8 * (i >> 2) + 4 * n + (i & 3); }

struct Unit { int pm, pn; };
struct Gemm { const bf16_t* A; const bf16_t* Bt; int M, N, K; };

struct StaticOrder {
    int nM, nN, nwg, G, c;
    __host__ __device__ void init(int M, int N, int G_, int c_) { nM = M / BM; nN = N / BM; nwg = nM * nN; G = G_; c = c_; }
    __host__ __device__ bool next(int i, Unit& u) const {
        const long L = (long)i * G + c; if (L >= nwg) return false;
        int wgid = (int)L; { const int q = nwg / NXCD, r = nwg % NXCD, xcd = wgid % NXCD, off = wgid / NXCD; wgid = (xcd < r ? xcd * (q + 1) : r * (q + 1) + (xcd - r) * q) + off; }
        const int nig = WGM * nN, gid = wgid / nig, fm = gid * WGM, gsz = (nM - fm) < WGM ? (nM - fm) : WGM;
        u.pm = fm + ((wgid % nig) % gsz); u.pn = (wgid % nig) / gsz; return true;
    }
    __device__ __forceinline__ void a_ready(const Unit&) const {}
    __device__ __forceinline__ void done(const Unit&) const {}
};

__device__ __forceinline__ unsigned cvt_pk_bf16(float lo, float hi) { unsigned r; asm volatile("v_cvt_pk_bf16_f32 %0, %1, %2" : "=v"(r) : "v"(lo), "v"(hi)); return r; }
typedef float f32x2 __attribute__((ext_vector_type(2)));
typedef unsigned u32x4 __attribute__((ext_vector_type(4)));
typedef _Float16 f16x2 __attribute__((ext_vector_type(2)));
__device__ __forceinline__ unsigned cvt_pk_f16(float lo, float hi) { f32x2 v = {lo, hi}; f16x2 h = __builtin_convertvector(v, f16x2); return __builtin_bit_cast(unsigned, h); }
enum { M_PLAIN = 0, M_RELU2 = 1, M_TANH = 2, M_SIGMOID = 3, M_QKV = 4, M_ASIG = 5, M_WLOG = 6 };
template <int MODE> struct Epi16 {
    static constexpr bool PERM = true, AFTER_DRAIN = false;
    bf16_t* O; int ldc; const float* vec;
    __device__ __forceinline__ void operator()(const f32x4 (&acc)[2][2][4][2], const Unit& u, int wr, int wc, int fr, int fq) const {
        const int row0 = u.pm * BM + wr * 64 + fr;
        const int col0 = u.pn * BM + wc * 32 + 8 * fq;
        const int sec = u.pn >> 1;
        const bool rope = (MODE == M_QKV) && (sec != 2) && (sec != 5);
        const bool rot_wave = rope && ((wc & 1) == 0);
        const float qs = (MODE == M_QKV && (sec == 0 || sec == 3)) ? (0.125f * 1.4426950408889634f) : 1.0f;
        f32x4 bias_[2][2];
        if (MODE == M_ASIG || MODE == M_WLOG) {
#pragma unroll
            for (int bj = 0; bj < 2; ++bj) { bias_[bj][0] = *(const f32x4*)(vec + col0 + bj * HALF); bias_[bj][1] = *(const f32x4*)(vec + col0 + bj * HALF + 4); }
        }
#pragma unroll
        for (int ai = 0; ai < 2; ++ai) {
            f32x4 tab[4][4];
            if (MODE == M_QKV) { if (rot_wave) {
#pragma unroll
                for (int m = 0; m < 4; ++m) { const float* t = vec + (size_t)((row0 + ai * HALF + m * 16) & 4095) * 16;
#pragma unroll
                    for (int q = 0; q < 4; ++q) tab[m][q] = *(const f32x4*)(t + 4 * q); } } }
#pragma unroll
            for (int m = 0; m < 4; ++m) {
                const int row = row0 + ai * HALF + m * 16;
                bf16_t* rowp = O + (size_t)row * ldc + col0;
                f32x4 cs0 = {1.f, 1.f, 1.f, 1.f}, cs1 = cs0, sn0 = {0.f, 0.f, 0.f, 0.f}, sn1 = sn0;
                if (MODE == M_QKV) { if (rot_wave) { cs0 = tab[m][0]; cs1 = tab[m][1]; sn0 = tab[m][2]; sn1 = tab[m][3]; } }
#pragma unroll
                for (int bj = 0; bj < 2; ++bj) {
                    f32x4 v0 = acc[ai][bj][m][0], v1 = acc[ai][bj][m][1];
                    if (MODE == M_QKV) {
                        if (rot_wave) {
                            f32x4 p0, p1;
#pragma unroll
                            for (int e = 0; e < 4; ++e) { p0[e] = __shfl_xor(v0[e], 16); p1[e] = __shfl_xor(v1[e], 16); }
                            if (fq < 2) { const float sg = (fq == 0) ? -1.f : 1.f; v0 = v0 * cs0 + (p0 * sn0) * sg; v1 = v1 * cs1 + (p1 * sn1) * sg; }
                        }
                        v0 = v0 * qs; v1 = v1 * qs;
                    }
                    if (MODE == M_RELU2) {
#pragma unroll
                        for (int e = 0; e < 4; ++e) { const float a = fmaxf(v0[e], 0.f), b = fmaxf(v1[e], 0.f); v0[e] = a * a; v1[e] = b * b; }
                    }
                    if (MODE == M_TANH) {
#pragma unroll
                        for (int e = 0; e < 4; ++e) { v0[e] = 1.f - 2.f * __builtin_amdgcn_rcpf(1.f + __builtin_amdgcn_exp2f(fminf(v0[e] * 2.885390081777927f, 60.f))); v1[e] = 1.f - 2.f * __builtin_amdgcn_rcpf(1.f + __builtin_amdgcn_exp2f(fminf(v1[e] * 2.885390081777927f, 60.f))); }
                    }
                    if (MODE == M_SIGMOID) {
#pragma unroll
                        for (int e = 0; e < 4; ++e) { v0[e] = 1.f / (1.f + __expf(-v0[e])); v1[e] = 1.f / (1.f + __expf(-v1[e])); }
                    }
                    if (MODE == M_ASIG) {
                        const f32x4 b0 = bias_[bj][0], b1 = bias_[bj][1];
#pragma unroll
                        for (int e = 0; e < 4; ++e) { v0[e] = 1.f / (1.f + __expf(-(v0[e] + b0[e]))); v1[e] = 1.f / (1.f + __expf(-(v1[e] + b1[e]))); }
                    }
                    u32x4 w;
                    if (MODE == M_WLOG) {
                        const f32x4 b0 = bias_[bj][0], b1 = bias_[bj][1];
#pragma unroll
                        for (int e = 0; e < 4; ++e) {
                            const float x0 = -(v0[e] + b0[e]), x1 = -(v1[e] + b1[e]);
                            const float s0 = fmaxf(x0, 0.f) + 0.6931471805599453f * __builtin_amdgcn_logf(1.f + __builtin_amdgcn_exp2f(-1.4426950408889634f * fabsf(x0)));
                            const float s1 = fmaxf(x1, 0.f) + 0.6931471805599453f * __builtin_amdgcn_logf(1.f + __builtin_amdgcn_exp2f(-1.4426950408889634f * fabsf(x1)));
                            v0[e] = -__builtin_amdgcn_exp2f(-1.4426950408889634f * (s0 + 0.5f)); v1[e] = -__builtin_amdgcn_exp2f(-1.4426950408889634f * (s1 + 0.5f));
                        }
                        w.x = cvt_pk_f16(v0[0], v0[1]); w.y = cvt_pk_f16(v0[2], v0[3]); w.z = cvt_pk_f16(v1[0], v1[1]); w.w = cvt_pk_f16(v1[2], v1[3]);
                    } else {
                        w.x = cvt_pk_bf16(v0[0], v0[1]); w.y = cvt_pk_bf16(v0[2], v0[3]); w.z = cvt_pk_bf16(v1[0], v1[1]); w.w = cvt_pk_bf16(v1[2], v1[3]);
                    }
                    *(u32x4*)(rowp + bj * HALF) = w;
                }
            }
        }
    }
};
struct EpiRes {
    static constexpr bool PERM = false, AFTER_DRAIN = false;
    const float* res; float* out; int ldc;
    __device__ __forceinline__ void operator()(const f32x4 (&acc)[2][2][4][2], const Unit& u, int wr, int wc, int fr, int fq) const {
        const int row0 = u.pm * BM + wr * 64 + fr, col0 = u.pn * BM + wc * 32 + 4 * fq;
#pragma unroll
        for (int ai = 0; ai < 2; ++ai)
#pragma unroll
            for (int m = 0; m < 4; ++m) {
                const size_t off = (size_t)(row0 + ai * HALF + m * 16) * ldc + col0;
#pragma unroll
                for (int bj = 0; bj < 2; ++bj)
#pragma unroll
                    for (int n = 0; n < 2; ++n) { const f32x4 r = *(const f32x4*)(res + off + bj * HALF + n * 16); *(f32x4*)(out + off + bj * HALF + n * 16) = r + acc[ai][bj][m][n]; }
            }
    }
};
template <class Epi, class Sched, bool ALIGN_EPI = false, bool SP2 = false>
__device__ __forceinline__ void gemm_phase(PG8_LAS unsigned char* lds, const Gemm g, const Sched& S, const Epi& E) {
    int tid = threadIdx.x; asm volatile("" : "+v"(tid)); const int wid = __builtin_amdgcn_readfirstlane(tid >> 6), lane = tid & 63, wr = wid >> 2, wc = wid & 3, fr = lane & 15, fq = lane >> 4;
    const int K = g.K, nt = K / BK;
    unsigned voffA[2], voffB[2];
#pragma unroll
    for (int i = 0; i < 2; ++i) { int R, C; stage_rc(tid * 16 + i * 8192, R, C); const int Rb = Epi::PERM ? ((R & ~31) + perm32(R & 31)) : R;
        voffA[i] = (unsigned)(R * K + C) * 2u; voffB[i] = (unsigned)(Rb * K + C) * 2u; }
    const size_t kstep = (size_t)(BK * 2);
    const size_t hstep = (size_t)HALF * K * 2;
    const size_t tstep = 2 * hstep;
    const unsigned ldsw = (unsigned)wid * 1024u;
    const int aoff = lds_byte(wr * 64 + fr, fq * 8), boff = lds_byte(wc * 32 + fr, fq * 8);
#define PG8_SA(b, h) (((b) * 2 + (h)) * HTB)
#define PG8_SB(b, h) ((4 + (b) * 2 + (h)) * HTB)
#define PG8_STAGE(bufoff, gbase, voff) do { _Pragma("unroll") for (int _i = 0; _i < 2; ++_i) \
        __builtin_amdgcn_global_load_lds((const unsigned*)((const char*)(gbase) + (voff)[_i]), (PG8_LAS unsigned*)(lds + (bufoff) + ldsw + _i * 8192), 16, 0, 0); } while (0)
#define PG8_LDA(dst, b, h) do { _Pragma("unroll") for (int m = 0; m < 4; ++m) _Pragma("unroll") for (int k = 0; k < 2; ++k) dst[m][k] = *(const PG8_LAS bf16x8*)(lds + PG8_SA(b, h) + aoff + m * 2048 + k * 1024); } while (0)
#define PG8_LDB(dst, b, h) do { _Pragma("unroll") for (int n = 0; n < 2; ++n) _Pragma("unroll") for (int k = 0; k < 2; ++k) dst[n][k] = *(const PG8_LAS bf16x8*)(lds + PG8_SB(b, h) + boff + n * 2048 + k * 1024); } while (0)
#define PG8_MMA(ai, bj, At, Bt) do { __builtin_amdgcn_s_setprio(1); _Pragma("unroll") for (int m = 0; m < 4; ++m) _Pragma("unroll") for (int n = 0; n < 2; ++n) _Pragma("unroll") for (int k = 0; k < 2; ++k) \
        acc[ai][bj][m][n] = __builtin_amdgcn_mfma_f32_16x16x32_bf16(Bt[n][k], At[m][k], acc[ai][bj][m][n], 0, 0, 0); __builtin_amdgcn_s_setprio(0); } while (0)
#define PG8_WAIT_V(n) asm volatile("s_waitcnt vmcnt(" #n ")" ::: "memory")
#define PG8_WAIT_L(n) asm volatile("s_waitcnt lgkmcnt(" #n ")" ::: "memory")
#define PG8_BAR __builtin_amdgcn_s_barrier()
#define PG8_SCHED __builtin_amdgcn_sched_barrier(0)
    Unit cur, nxt; int ui = 0;
    if (!S.next(0, cur)) return;
    f32x4 acc[2][2][4][2];
#pragma unroll
    for (int a = 0; a < 2; ++a)
#pragma unroll
        for (int b = 0; b < 2; ++b)
#pragma unroll
            for (int m = 0; m < 4; ++m)
#pragma unroll
                for (int n = 0; n < 2; ++n) acc[a][b][m][n] = (f32x4){0.f, 0.f, 0.f, 0.f};
    bf16x8 At[4][2], B0[2][2], B1[2][2];
    const char* cA = (const char*)g.A + (size_t)cur.pm * tstep; const char* cB = (const char*)g.Bt + (size_t)cur.pn * tstep;
    S.a_ready(cur);
    if constexpr (SP2) {
        PG8_STAGE(PG8_SB(0, 0), cB, voffB); PG8_STAGE(PG8_SB(0, 1), cB + hstep, voffB); PG8_STAGE(PG8_SA(0, 0), cA, voffA); PG8_STAGE(PG8_SA(0, 1), cA + hstep, voffA);
        if (wr == 1) PG8_BAR;
        PG8_WAIT_V(2); PG8_BAR;
        PG8_STAGE(PG8_SB(1, 0), cB + kstep, voffB); PG8_STAGE(PG8_SA(1, 0), cA + kstep, voffA); PG8_STAGE(PG8_SB(1, 1), cB + hstep + kstep, voffB);
        PG8_WAIT_V(6); PG8_BAR;
    } else {
        PG8_STAGE(PG8_SB(0, 0), cB, voffB); PG8_STAGE(PG8_SA(0, 0), cA, voffA); PG8_STAGE(PG8_SB(0, 1), cB + hstep, voffB); PG8_STAGE(PG8_SA(0, 1), cA + hstep, voffA);
        if (wr == 1) PG8_BAR;
        PG8_WAIT_V(4); PG8_BAR;
        PG8_STAGE(PG8_SB(1, 0), cB + kstep, voffB); PG8_STAGE(PG8_SA(1, 0), cA + kstep, voffA); PG8_STAGE(PG8_SB(1, 1), cB + hstep + kstep, voffB);
        PG8_WAIT_V(6); PG8_BAR;
    }
    for (;;) {
        const bool has_next = S.next(ui + 1, nxt);
        const char* nA = has_next ? (const char*)g.A + (size_t)nxt.pm * tstep : cA; const char* nB = has_next ? (const char*)g.Bt + (size_t)nxt.pn * tstep : cB;
        for (int t = 0; t < nt; t += 2) {
            const bool last = (t == nt - 2);
            const char* a1 = cA + (size_t)(t + 1) * kstep;
            const char* a2 = last ? nA : cA + (size_t)(t + 2) * kstep; const char* b2 = last ? nB : cB + (size_t)(t + 2) * kstep;
            const char* a3 = a2 + kstep; const char* b3 = b2 + kstep;
            if (last && has_next) S.a_ready(nxt);
            if constexpr (SP2) {
            PG8_LDB(B0, 0, 0); PG8_LDB(B1, 0, 1); PG8_SCHED; PG8_LDA(At, 0, 0); PG8_STAGE(PG8_SA(1, 1), a1 + hstep, voffA);
            PG8_WAIT_V(8); PG8_WAIT_L(0); PG8_BAR; PG8_MMA(0, 0, At, B0); PG8_MMA(0, 1, At, B1); PG8_BAR; PG8_SCHED;
            PG8_LDA(At, 0, 1); PG8_STAGE(PG8_SB(0, 0), b2, voffB); PG8_STAGE(PG8_SB(0, 1), b2 + hstep, voffB); PG8_STAGE(PG8_SA(0, 0), a2, voffA);
            PG8_WAIT_V(8); PG8_WAIT_L(0); PG8_BAR; PG8_MMA(1, 0, At, B0); PG8_MMA(1, 1, At, B1); PG8_BAR; PG8_SCHED;
            PG8_LDB(B0, 1, 0); PG8_LDB(B1, 1, 1); PG8_SCHED; PG8_LDA(At, 1, 0); PG8_STAGE(PG8_SA(0, 1), a2 + hstep, voffA);
            PG8_WAIT_V(8); PG8_WAIT_L(0); PG8_BAR; PG8_MMA(0, 0, At, B0); PG8_MMA(0, 1, At, B1); PG8_BAR; PG8_SCHED;
            PG8_LDA(At, 1, 1); PG8_STAGE(PG8_SB(1, 0), b3, voffB); PG8_STAGE(PG8_SB(1, 1), b3 + hstep, voffB); PG8_STAGE(PG8_SA(1, 0), a3, voffA);
            PG8_WAIT_V(8); PG8_WAIT_L(0); PG8_BAR; PG8_MMA(1, 0, At, B0); PG8_MMA(1, 1, At, B1); PG8_BAR; PG8_SCHED;
            } else {
            PG8_LDB(B0, 0, 0); PG8_SCHED; PG8_LDA(At, 0, 0); PG8_STAGE(PG8_SA(1, 1), a1 + hstep, voffA);
            PG8_WAIT_L(8); PG8_BAR; PG8_WAIT_L(0); PG8_MMA(0, 0, At, B0); PG8_BAR; PG8_SCHED;
            PG8_LDB(B1, 0, 1); PG8_STAGE(PG8_SB(0, 0), b2, voffB);
            PG8_BAR; PG8_WAIT_L(0); PG8_MMA(0, 1, At, B1); PG8_BAR;
            PG8_LDA(At, 0, 1); PG8_STAGE(PG8_SA(0, 0), a2, voffA);
            PG8_BAR; PG8_WAIT_L(0); PG8_MMA(1, 0, At, B0); PG8_BAR; PG8_SCHED;
            PG8_STAGE(PG8_SB(0, 1), b2 + hstep, voffB);
            PG8_WAIT_V(6); PG8_BAR; PG8_MMA(1, 1, At, B1); PG8_BAR;
            PG8_LDB(B0, 1, 0); PG8_SCHED; PG8_LDA(At, 1, 0); PG8_STAGE(PG8_SA(0, 1), a2 + hstep, voffA);
            PG8_WAIT_L(8); PG8_BAR; PG8_WAIT_L(0); PG8_MMA(0, 0, At, B0); PG8_BAR; PG8_SCHED;
            PG8_LDB(B1, 1, 1); PG8_STAGE(PG8_SB(1, 0), b3, voffB);
            PG8_BAR; PG8_WAIT_L(0); PG8_MMA(0, 1, At, B1); PG8_BAR;
            PG8_LDA(At, 1, 1); PG8_STAGE(PG8_SA(1, 0), a3, voffA);
            PG8_BAR; PG8_WAIT_L(0); PG8_MMA(1, 0, At, B0); PG8_BAR; PG8_SCHED;
            PG8_STAGE(PG8_SB(1, 1), b3 + hstep, voffB);
            PG8_WAIT_V(6); PG8_BAR; PG8_MMA(1, 1, At, B1); PG8_BAR;
            }
        }
        if constexpr (ALIGN_EPI) { if (wr == 0) PG8_BAR; }
        if constexpr (!Epi::AFTER_DRAIN) { E(acc, cur, wr, wc, fr, fq); S.done(cur); }
        if (!has_next) break;
#pragma unroll
        for (int a = 0; a < 2; ++a)
#pragma unroll
            for (int b = 0; b < 2; ++b)
#pragma unroll
                for (int m = 0; m < 4; ++m)
#pragma unroll
                    for (int n = 0; n < 2; ++n) acc[a][b][m][n] = (f32x4){0.f, 0.f, 0.f, 0.f};
        cur = nxt; cA = nA; cB = nB; ++ui;
        if constexpr (ALIGN_EPI) { if (wr == 1) PG8_BAR; }
    }
    PG8_WAIT_V(0);
    if constexpr (!ALIGN_EPI) { if (wr == 0) PG8_BAR; }
    PG8_BAR;
    if constexpr (Epi::AFTER_DRAIN) { E.fused(acc, cur, wr, wc, fr, fq, lds, wid, lane); S.done(cur); }
#undef PG8_SA
#undef PG8_SB
#undef PG8_STAGE
#undef PG8_LDA
#undef PG8_LDB
#undef PG8_MMA
#undef PG8_WAIT_V
#undef PG8_WAIT_L
#undef PG8_BAR
#undef PG8_SCHED
}
}
#define LAS __attribute__((address_space(3)))
typedef unsigned short bf16;
typedef float f32x4 __attribute__((ext_vector_type(4)));
typedef float f32x2 __attribute__((ext_vector_type(2)));
typedef float f32x16 __attribute__((ext_vector_type(16)));
typedef short bf16x8 __attribute__((ext_vector_type(8)));
typedef short s16x4 __attribute__((ext_vector_type(4)));
typedef unsigned u32x4 __attribute__((ext_vector_type(4)));
typedef unsigned u32x2 __attribute__((ext_vector_type(2)));

#ifndef REP_LORA
#define REP_LORA 1
#endif
#ifndef REP_UP
#define REP_UP 1
#endif
#ifndef REP_RMS
#define REP_RMS 1
#endif
#ifndef REP_XMIX
#define REP_XMIX 1
#endif
#ifndef REP_ATTN
#define REP_ATTN 1
#endif
#ifndef REP_ATTNA
#define REP_ATTNA 1
#endif
#ifndef REP_SCAN
#define REP_SCAN 1
#endif
constexpr int NWAVES = 8, NTHR = 512;
constexpr int NTOK = 65536, DM = 1024, SEQ = 4096, NBATCH = 16, DFF = 4096, QKVC = 3072;
constexpr size_t MiB = (size_t)1 << 20;
constexpr size_t WS_CTL = 0;
constexpr size_t WS_WIN = 1 * MiB, WS_WOUT = 7 * MiB, WS_W1_0 = 9 * MiB, WS_W2_0 = 17 * MiB, WS_W1_1 = 25 * MiB, WS_W2_1 = 33 * MiB;
constexpr size_t WS_WR = 41 * MiB, WS_WK = 43 * MiB, WS_WV = 45 * MiB, WS_WO = 47 * MiB;
constexpr size_t WS_LW1 = 49 * MiB, WS_LA1 = WS_LW1 + 512 * 1024, WS_LG1 = 50 * MiB, WS_LW2 = WS_LG1 + 512 * 1024, WS_LA2 = 51 * MiB, WS_LG2 = WS_LA2 + 512 * 1024;
constexpr size_t WS_ROPE = 52 * MiB;
constexpr size_t WS_HN = 65 * MiB;
constexpr size_t WS_QKV = 193 * MiB;
constexpr size_t WS_ATT = 577 * MiB;
constexpr size_t WS_OAP = 705 * MiB;
constexpr size_t WS_LSE = 897 * MiB;
constexpr size_t WS_U = 193 * MiB;
constexpr size_t WS_X6 = 65 * MiB;
constexpr size_t WS_T = 833 * MiB;
constexpr size_t WS_RKV = 449 * MiB;
constexpr size_t WS_WAG = 65 * MiB;
constexpr size_t WS_Z = 833 * MiB;
constexpr size_t WS_END = 961 * MiB;
constexpr size_t ACT = (size_t)NTOK * DM * 2;

constexpr int RING_BYTES = 131072, LDS_BYTES = 147456;
constexpr int LDS_BARST = 147200;
constexpr size_t WS_BAR = 16384;
constexpr size_t CTL_ZERO_BYTES = 65536;
#define XB_TMO      128
#define XB_XCNT(j)  (256  + 64 * (j))
#define XB_XSUB(j)  (1280 + 64 * (j))
#define XB_XGEN(j)  (2304 + 64 * (j))
#define XB_TOP      3328
#define XB_TOPGEN   3392
#define XCD_BAR_WORDS 3456
#define XB_SPIN_CAP (1u << 18)

__device__ __forceinline__ unsigned xb_ld(unsigned* p)              { return __hip_atomic_load(p, __ATOMIC_RELAXED, __HIP_MEMORY_SCOPE_AGENT); }
__device__ __forceinline__ unsigned xb_add(unsigned* p, unsigned v) { return __hip_atomic_fetch_add(p, v, __ATOMIC_RELAXED, __HIP_MEMORY_SCOPE_AGENT); }
__device__ __forceinline__ unsigned xb_xcc_id() { return (unsigned)__builtin_amdgcn_s_getreg((3 << 11) | 20) & 0xFu; }
#define XB_SPIN(cond, bar) do { unsigned _sp = 0; while (cond) { __builtin_amdgcn_s_sleep(1); \
    if ((++_sp & 255u) == 0u) { if (xb_ld(&(bar)[XB_TMO])) break; if (_sp > XB_SPIN_CAP) { atomicAdd(&(bar)[XB_TMO], 1u); break; } } } } while (0)

struct XcdBarrier {
    unsigned* bar; unsigned x;
    volatile LAS unsigned* st;
};

__device__ __forceinline__ XcdBarrier xcd_barrier_post(unsigned* bar, volatile LAS unsigned* st) {
    XcdBarrier b; b.bar = bar; b.x = xb_xcc_id(); b.st = st;
    if (threadIdx.x == 0) (void)xb_add(&bar[XB_XCNT(b.x)], 1u);
    return b;
}
__device__ __forceinline__ void xcd_barrier_complete(unsigned* bar, unsigned x, unsigned& nloc, unsigned& nx) {
    const unsigned G = gridDim.x * gridDim.y * gridDim.z;
    unsigned sum, cnt, mine, sp = 0u;
    for (;;) {
        sum = 0u; cnt = 0u; mine = 0u;
#pragma unroll
        for (unsigned j = 0; j < 16; ++j) { const unsigned c = xb_ld(&bar[XB_XCNT(j)]); sum += c; cnt += (c > 0u) ? 1u : 0u; mine = (j == x) ? c : mine; }
        if (sum == G) break;
        __builtin_amdgcn_s_sleep(1);
        if ((++sp & 255u) == 0u) { if (xb_ld(&bar[XB_TMO])) break; if (sp > XB_SPIN_CAP) { atomicAdd(&bar[XB_TMO], 1u); break; } }
    }
    nloc = mine > 0u ? mine : 1u; nx = cnt > 0u ? cnt : 1u;
}

__device__ __forceinline__ void xcd_barrier(const XcdBarrier& b) {
    asm volatile("s_waitcnt vmcnt(0)" ::: "memory");
    __syncthreads();
    if (threadIdx.x == 0) {
        unsigned* bar = b.bar;
        __builtin_amdgcn_s_waitcnt(0);
        unsigned nloc = b.st[0], nx = b.st[1];
        if (nloc == 0u) { xcd_barrier_complete(bar, b.x, nloc, nx); b.st[0] = nloc; b.st[1] = nx; }
        const unsigned old = xb_add(&bar[XB_XSUB(b.x)], 1u);
        const unsigned gen = old / nloc;
        if (old + 1u == (gen + 1u) * nloc) {
            __builtin_amdgcn_fence(__ATOMIC_RELEASE, "agent");
            asm volatile("s_waitcnt vmcnt(0)" ::: "memory");
            const unsigned og = xb_add(&bar[XB_TOP], 1u);
            const unsigned tg = og / nx;
            if (og + 1u == (tg + 1u) * nx) xb_add(&bar[XB_TOPGEN], 1u);
            else XB_SPIN(xb_ld(&bar[XB_TOPGEN]) == tg, bar);
            __builtin_amdgcn_fence(__ATOMIC_ACQUIRE, "agent");
            xb_add(&bar[XB_XGEN(b.x)], 1u);
            asm volatile("s_waitcnt vmcnt(0)" ::: "memory");
        } else {
            XB_SPIN(xb_ld(&bar[XB_XGEN(b.x)]) == gen, bar);
            __builtin_amdgcn_fence(__ATOMIC_ACQUIRE, "agent");
            asm volatile("s_waitcnt vmcnt(0)" ::: "memory");
        }
    }
    __syncthreads();
}


__device__ __forceinline__ unsigned pkbf(float lo, float hi) { return pg8::cvt_pk_bf16(lo, hi); }
__device__ __forceinline__ float bf2f(unsigned short h) { return __uint_as_float(((unsigned)h) << 16); }
__device__ __forceinline__ float bflo(unsigned w) { return __uint_as_float(w << 16); }
__device__ __forceinline__ float bfhi(unsigned w) { return __uint_as_float(w & 0xffff0000u); }
__device__ __forceinline__ float wave_sum(float v) {
#pragma unroll
    for (int o = 1; o < 64; o <<= 1) v += __shfl_xor(v, o);
    return v;
}

struct Args {
    const float* x; const float* norm_mix; const float* norm_mlp; const float* norm_final;
    const float* attn_w_in; const float* attn_w_out; const float* diff_lambda; const float* diff_subln;
    const float* rwkv_mu; const float* rwkv_w_r; const float* rwkv_w_k; const float* rwkv_w_v; const float* rwkv_w_o;
    const float* rwkv_w0; const float* rwkv_w1; const float* rwkv_w2; const float* rwkv_a0; const float* rwkv_a1; const float* rwkv_a2;
    const float* rwkv_g1; const float* rwkv_g2; const float* rwkv_k_k; const float* rwkv_k_a; const float* rwkv_r_k;
    const float* rwkv_ln_w; const float* rwkv_ln_b; const float* mlp_w1; const float* mlp_w2;
    float* out; unsigned char* ws; int ph_lo, ph_hi;
};

__device__ __forceinline__ void transpose_item(const float* __restrict__ W, int N, bf16* __restrict__ WT, int pitch, LAS float* scr, int item, int lane) {
    const int nblk = N >> 5, kb = item / nblk, nb = item - kb * nblk, k0 = kb * 32, n0 = nb * 32;
#pragma unroll 4
    for (int i = 0; i < 16; ++i) { const int kk = 2 * i + (lane >> 5); scr[kk * 33 + (lane & 31)] = W[(size_t)(k0 + kk) * N + n0 + (lane & 31)]; }
    asm volatile("s_waitcnt lgkmcnt(0)" ::: "memory");
    const int c = lane & 3;
#pragma unroll
    for (int j = 0; j < 2; ++j) { const int n = (lane >> 2) + 16 * j; const LAS float* s = scr + (8 * c) * 33 + n;
        u32x4 o; o.x = pkbf(s[0], s[33]); o.y = pkbf(s[66], s[99]); o.z = pkbf(s[132], s[165]); o.w = pkbf(s[198], s[231]);
        *(u32x4*)(WT + (size_t)(n0 + n) * pitch + k0 + 8 * c) = o; }
    asm volatile("s_waitcnt lgkmcnt(0)" ::: "memory");
}
__device__ __forceinline__ void zero_region(bf16* p, int pitch, int r0, int r1, int c0, int c1, int gt, int ngt) {
    const int cw = (c1 - c0) >> 3, n = (r1 - r0) * cw;
    for (int i = gt; i < n; i += ngt) { const int r = r0 + i / cw, c = c0 + (i % cw) * 8; *(u32x4*)(p + (size_t)r * pitch + c) = (u32x4){0u, 0u, 0u, 0u}; }
}
__device__ __forceinline__ void rms_row_bf16(const float* xrow, const float* gain, bf16* orow, int lane) {
    const f32x4* xr = (const f32x4*)xrow + lane; const f32x4* gr = (const f32x4*)gain + lane;
    f32x4 v[4]; float s = 0.f;
#pragma unroll
    for (int j = 0; j < 4; ++j) { v[j] = xr[64 * j]; s += (v[j].x * v[j].x + v[j].y * v[j].y) + (v[j].z * v[j].z + v[j].w * v[j].w); }
    const float rstd = 1.f / sqrtf(wave_sum(s) * (1.f / 1024.f) + 1e-5f);
    u32x2* o8 = (u32x2*)orow + lane;
#pragma unroll
    for (int j = 0; j < 4; ++j) { const f32x4 g = gr[64 * j]; u32x2 w; w.x = pkbf(v[j].x * rstd * g.x, v[j].y * rstd * g.y); w.y = pkbf(v[j].z * rstd * g.z, v[j].w * rstd * g.w); o8[64 * j] = w; }
}
__device__ __forceinline__ void rms_phase_bf16(const float* __restrict__ src, const float* __restrict__ gain, bf16* __restrict__ dst, int gw, int ngw, int lane) {
    const f32x4* gr = (const f32x4*)gain + lane;
    for (int m = 2 * gw; m < NTOK; m += 2 * ngw) {
        const f32x4* x0 = (const f32x4*)(src + (size_t)m * DM) + lane; const f32x4* x1 = x0 + DM / 4;
        f32x4 v[4], u[4]; float s = 0.f, t = 0.f;
#pragma unroll
        for (int j = 0; j < 4; ++j) { v[j] = x0[64 * j]; u[j] = x1[64 * j]; }
#pragma unroll
        for (int j = 0; j < 4; ++j) { s += (v[j].x * v[j].x + v[j].y * v[j].y) + (v[j].z * v[j].z + v[j].w * v[j].w); t += (u[j].x * u[j].x + u[j].y * u[j].y) + (u[j].z * u[j].z + u[j].w * u[j].w); }
        const float r0 = 1.f / sqrtf(wave_sum(s) * (1.f / 1024.f) + 1e-5f), r1 = 1.f / sqrtf(wave_sum(t) * (1.f / 1024.f) + 1e-5f);
        u32x2* o0 = (u32x2*)(dst + (size_t)m * DM) + lane; u32x2* o1 = o0 + DM / 4;
#pragma unroll
        for (int j = 0; j < 4; ++j) { const f32x4 g = gr[64 * j];
            u32x2 w; w.x = pkbf(v[j].x * r0 * g.x, v[j].y * r0 * g.y); w.y = pkbf(v[j].z * r0 * g.z, v[j].w * r0 * g.w); o0[64 * j] = w;
            u32x2 z; z.x = pkbf(u[j].x * r1 * g.x, u[j].y * r1 * g.y); z.y = pkbf(u[j].z * r1 * g.z, u[j].w * r1 * g.w); o1[64 * j] = z; }
    }
}
__device__ __forceinline__ void rms_phase_f32(const float* src, const float* gain, float* dst, int gw, int ngw, int lane) {
    const f32x4* gr = (const f32x4*)gain + lane;
    for (int m = 2 * gw; m < NTOK; m += 2 * ngw) {
        const f32x4* x0 = (const f32x4*)(src + (size_t)m * DM) + lane; const f32x4* x1 = x0 + DM / 4;
        f32x4 v[4], u[4]; float s = 0.f, t = 0.f;
#pragma unroll
        for (int j = 0; j < 4; ++j) { v[j] = x0[64 * j]; u[j] = x1[64 * j]; }
#pragma unroll
        for (int j = 0; j < 4; ++j) { s += (v[j].x * v[j].x + v[j].y * v[j].y) + (v[j].z * v[j].z + v[j].w * v[j].w); t += (u[j].x * u[j].x + u[j].y * u[j].y) + (u[j].z * u[j].z + u[j].w * u[j].w); }
        const float r0 = 1.f / sqrtf(wave_sum(s) * (1.f / 1024.f) + 1e-5f), r1 = 1.f / sqrtf(wave_sum(t) * (1.f / 1024.f) + 1e-5f);
        f32x4* o0 = (f32x4*)(dst + (size_t)m * DM) + lane; f32x4* o1 = o0 + DM / 4;
#pragma unroll
        for (int j = 0; j < 4; ++j) { const f32x4 g = gr[64 * j]; o0[64 * j] = v[j] * r0 * g; o1[64 * j] = u[j] * r1 * g; }
    }
}

__device__ __forceinline__ void xmix_phase(const float* __restrict__ h, const float* __restrict__ gain, const float* __restrict__ mu, bf16* __restrict__ X6, int gw, int ngw, int lane) {
    f32x4 g4[4], m6[6][4];
#pragma unroll
    for (int j = 0; j < 4; ++j) g4[j] = ((const f32x4*)gain + lane)[64 * j];
#pragma unroll
    for (int i = 0; i < 6; ++i) {
        const int mi = (i == 1) ? 2 : ((i == 2) ? 3 : ((i == 3) ? 1 : i));
#pragma unroll
        for (int j = 0; j < 4; ++j) m6[i][j] = ((const f32x4*)(mu + mi * DM) + lane)[64 * j];
    }
    for (int chunk = gw; chunk < NTOK / 32; chunk += ngw) {
        const int t0 = chunk * 32;
        f32x4 prev[4];
        if ((t0 & (SEQ - 1)) == 0) {
#pragma unroll
            for (int j = 0; j < 4; ++j) prev[j] = (f32x4){0.f, 0.f, 0.f, 0.f};
        } else {
            const f32x4* xr = (const f32x4*)(h + (size_t)(t0 - 1) * DM) + lane; float s = 0.f;
#pragma unroll
            for (int j = 0; j < 4; ++j) { prev[j] = xr[64 * j]; s += (prev[j].x * prev[j].x + prev[j].y * prev[j].y) + (prev[j].z * prev[j].z + prev[j].w * prev[j].w); }
            const float rstd = 1.f / sqrtf(wave_sum(s) * (1.f / 1024.f) + 1e-5f);
#pragma unroll
            for (int j = 0; j < 4; ++j) prev[j] = prev[j] * rstd * g4[j];
        }
        f32x4 nx[4];
        { const f32x4* xr = (const f32x4*)(h + (size_t)t0 * DM) + lane;
#pragma unroll
          for (int j = 0; j < 4; ++j) nx[j] = xr[64 * j]; }
        for (int t = t0; t < t0 + 32; ++t) {
            f32x4 v[4]; float s = 0.f;
#pragma unroll
            for (int j = 0; j < 4; ++j) v[j] = nx[j];
            if (t + 1 < t0 + 32) { const f32x4* xr = (const f32x4*)(h + (size_t)(t + 1) * DM) + lane;
#pragma unroll
              for (int j = 0; j < 4; ++j) nx[j] = xr[64 * j]; }
#pragma unroll
            for (int j = 0; j < 4; ++j) s += (v[j].x * v[j].x + v[j].y * v[j].y) + (v[j].z * v[j].z + v[j].w * v[j].w);
            const float rstd = 1.f / sqrtf(wave_sum(s) * (1.f / 1024.f) + 1e-5f);
#pragma unroll
            for (int j = 0; j < 4; ++j) v[j] = v[j] * rstd * g4[j];
#pragma unroll
            for (int i = 0; i < 6; ++i) {
                u32x2* o8 = (u32x2*)(X6 + (size_t)i * NTOK * DM + (size_t)t * DM) + lane;
#pragma unroll
                for (int j = 0; j < 4; ++j) { const f32x4 xx = v[j] + (prev[j] - v[j]) * m6[i][j]; u32x2 w; w.x = pkbf(xx.x, xx.y); w.y = pkbf(xx.z, xx.w); o8[64 * j] = w; }
            }
#pragma unroll
            for (int j = 0; j < 4; ++j) prev[j] = v[j];
        }
    }
}

__device__ __forceinline__ int crow(int r, int hi) { return (r & 3) + 8 * (r >> 2) + 4 * hi; }
__device__ __forceinline__ s16x4 vtr(const LAS unsigned char* p) {
    typedef short v4i16_t __attribute__((ext_vector_type(4)));
    return __builtin_bit_cast(s16x4, __builtin_amdgcn_ds_read_tr16_b64_v4i16((LAS v4i16_t*)p));
}
__device__ __forceinline__ bf16x8 vfrag(const LAS unsigned char* p, int row8) {
    const s16x4 lo = vtr(p), hi = vtr(p + row8);
    return (bf16x8){lo[0], lo[1], lo[2], lo[3], hi[0], hi[1], hi[2], hi[3]};
}
__device__ __forceinline__ bf16x8 packp(const f32x16& p, int b) {
    u32x4 w; w.x = pkbf(p[b], p[b + 1]); w.y = pkbf(p[b + 2], p[b + 3]); w.z = pkbf(p[b + 4], p[b + 5]); w.w = pkbf(p[b + 6], p[b + 7]);
    return __builtin_bit_cast(bf16x8, w);
}
__device__ __forceinline__ float max16(const f32x16& p) {
    float a = fmaxf(fmaxf(p[0], p[1]), fmaxf(p[2], p[3])), b = fmaxf(fmaxf(p[4], p[5]), fmaxf(p[6], p[7]));
    float c = fmaxf(fmaxf(p[8], p[9]), fmaxf(p[10], p[11])), d = fmaxf(fmaxf(p[12], p[13]), fmaxf(p[14], p[15]));
    return fmaxf(fmaxf(a, b), fmaxf(c, d));
}
__device__ __forceinline__ float sum16(const f32x16& p) {
    return ((p[0] + p[1]) + (p[2] + p[3])) + ((p[4] + p[5]) + (p[6] + p[7])) + ((p[8] + p[9]) + (p[10] + p[11])) + ((p[12] + p[13]) + (p[14] + p[15]));
}
__device__ __forceinline__ float other_half(float v) {
    const unsigned b = __float_as_uint(v);
    auto rr = __builtin_amdgcn_permlane32_swap(b, b, false, false);
    return __uint_as_float(((threadIdx.x & 32) != 0) ? rr[0] : rr[1]);
}
#define MFMA32(a, b, c) __builtin_amdgcn_mfma_f32_32x32x16_bf16((a), (b), (c), 0, 0, 0)

constexpr int KB_STR = 144, VB_STR = 320, KB_BYTES = 64 * KB_STR, VB_BYTES = 64 * VB_STR, BBUF = 2 * KB_BYTES + VB_BYTES;
constexpr int BX_OFF = 2 * BBUF;
__device__ __forceinline__ void diffattn_unit(const bf16* __restrict__ QKV, bf16* __restrict__ ATT, const float* subln, float lam, int b, int h, int qb, LAS unsigned char* lds) {
    int tid = threadIdx.x; asm volatile("" : "+v"(tid)); const int lane = tid & 63, wid = __builtin_amdgcn_readfirstlane(tid >> 6), c = wid >> 2, g = wid & 3, i32 = lane & 31, hi = lane >> 5;
    const size_t tok0 = (size_t)b * SEQ;
    const int qrow = qb * 128 + 32 * g + i32;
    bf16x8 qf[4];
    { const bf16* qp = QKV + (tok0 + qrow) * QKVC + 1536 + h * 128 + c * 64 + 8 * hi;
#pragma unroll
      for (int s = 0; s < 4; ++s) qf[s] = *(const bf16x8*)(qp + 16 * s); }
    const int krow = tid >> 3, kch = tid & 7;
    const bf16* ksrc = QKV + (tok0 + krow) * QKVC + 2048 + h * 128 + kch * 8;
    const int vrow0 = tid >> 4, vch = tid & 15;
    const bf16* vsrc = QKV + (tok0 + vrow0) * QKVC + 2560 + h * 128 + vch * 8;
    const int kdst = krow * KB_STR + kch * 16, vdst = vrow0 * VB_STR + vch * 16;
    const int NT = 2 * qb + 2;
    u32x4 rk0, rk1, rv0, rv1;
#define B_LOAD(t) do { const size_t o_ = (size_t)(t) * 64 * QKVC; rk0 = *(const u32x4*)(ksrc + o_); rk1 = *(const u32x4*)(ksrc + o_ + 64); rv0 = *(const u32x4*)(vsrc + o_); rv1 = *(const u32x4*)(vsrc + o_ + (size_t)32 * QKVC); } while (0)
#define B_STORE(buf) do { LAS unsigned char* b_ = lds + (buf) * BBUF; *(LAS u32x4*)(b_ + kdst) = rk0; *(LAS u32x4*)(b_ + KB_BYTES + kdst) = rk1; *(LAS u32x4*)(b_ + 2 * KB_BYTES + vdst) = rv0; *(LAS u32x4*)(b_ + 2 * KB_BYTES + vdst + 32 * VB_STR) = rv1; } while (0)
    B_LOAD(0);
    f32x16 o[4];
#pragma unroll
    for (int d = 0; d < 4; ++d) o[d] = (f32x16){};
    float m_ref = 0.f, l_run = 0.f;
    const int qmin = qb * 128 + 32 * g;
    const int lg = lane & 15, gg = (lane >> 4) & 1;
    const int voff = (4 * hi + (lg >> 2)) * VB_STR + (16 * gg + 4 * (lg & 3)) * 2;
    for (int t = 0; t < NT; ++t) {
        B_STORE(t & 1);
        __syncthreads();
        if (t + 1 < NT) B_LOAD(t + 1);
        const int k0 = 64 * t;
        if (k0 <= qmin + 31) {
            const LAS unsigned char* kb = lds + (t & 1) * BBUF + c * KB_BYTES;
            const LAS unsigned char* vb = lds + (t & 1) * BBUF + 2 * KB_BYTES + voff;
            f32x16 p0 = (f32x16){}, p1 = (f32x16){};
#pragma unroll
            for (int s = 0; s < 4; ++s) {
                const bf16x8 a0 = *(const LAS bf16x8*)(kb + i32 * KB_STR + 32 * s + 16 * hi);
                const bf16x8 a1 = *(const LAS bf16x8*)(kb + (32 + i32) * KB_STR + 32 * s + 16 * hi);
                p0 = MFMA32(a0, qf[s], p0); p1 = MFMA32(a1, qf[s], p1);
            }
            if (k0 + 63 > qmin) {
#pragma unroll
                for (int r = 0; r < 16; ++r) { const int kv = k0 + crow(r, hi); if (kv > qrow) p0[r] = -INFINITY; if (kv + 32 > qrow) p1[r] = -INFINITY; }
            }
            float mx = fmaxf(max16(p0), max16(p1));
            mx = fmaxf(mx, other_half(mx));
            if (t == 0) m_ref = mx;
            else if (__any(mx - m_ref > 8.f)) {
                const float dl = fmaxf(mx - m_ref, 0.f);
                m_ref += dl;
                const float alpha = __builtin_amdgcn_exp2f(-dl);
                l_run *= alpha;
#pragma unroll
                for (int d = 0; d < 4; ++d) o[d] = o[d] * alpha;
            }
#pragma unroll
            for (int r = 0; r < 16; ++r) { p0[r] = __builtin_amdgcn_exp2f(p0[r] - m_ref); p1[r] = __builtin_amdgcn_exp2f(p1[r] - m_ref); }
            l_run += sum16(p0) + sum16(p1);
#pragma unroll
            for (int s4 = 0; s4 < 4; ++s4) {
                const bf16x8 pfs = packp((s4 < 2) ? p0 : p1, 8 * (s4 & 1));
#pragma unroll
                for (int d = 0; d < 4; ++d) { const bf16x8 a = vfrag(vb + s4 * 16 * VB_STR + d * 64, 8 * VB_STR); o[d] = MFMA32(a, pfs, o[d]); }
                __builtin_amdgcn_sched_barrier(0);
            }
        }
    }
#undef B_LOAD
#undef B_STORE
    __syncthreads();
    float l_tot = l_run + __shfl_xor(l_run, 32);
    const float inv = 1.f / l_tot;
    LAS float* X = (LAS float*)(lds + BX_OFF) + g * 4096;
    if (c == 1) {
        const float sc = inv * lam;
#pragma unroll
        for (int d = 0; d < 4; ++d)
#pragma unroll
            for (int r = 0; r < 16; ++r) X[(32 * d + crow(r, hi)) * 32 + i32] = o[d][r] * sc;
    }
    __syncthreads();
    if (c == 0) {
        float ss = 0.f;
#pragma unroll
        for (int d = 0; d < 4; ++d)
#pragma unroll
            for (int r = 0; r < 16; ++r) { const float v = o[d][r] * inv - X[(32 * d + crow(r, hi)) * 32 + i32]; o[d][r] = v; ss += v * v; }
        ss += __shfl_xor(ss, 32);
        const float rs = (1.f / sqrtf(ss * (1.f / 128.f) + 1e-5f)) * 0.8f;
        bf16* op = ATT + (tok0 + qrow) * DM + 512 + h * 128;
#pragma unroll
        for (int d = 0; d < 4; ++d)
#pragma unroll
            for (int r4 = 0; r4 < 4; ++r4) {
                const int dv = 32 * d + 8 * r4 + 4 * hi; const f32x4 gn = *(const f32x4*)(subln + dv);
                u32x2 w; w.x = pkbf(o[d][4 * r4] * rs * gn.x, o[d][4 * r4 + 1] * rs * gn.y); w.y = pkbf(o[d][4 * r4 + 2] * rs * gn.z, o[d][4 * r4 + 3] * rs * gn.w);
                *(u32x2*)(op + dv) = w;
            }
    }
    __syncthreads();
}

constexpr int KA_STR = 144, VA_STR = 192, KA_BYTES = 384 * KA_STR, VA_BYTES = 384 * VA_STR;
__device__ __forceinline__ void dilattn_unit(const bf16* __restrict__ QKV, bf16* __restrict__ OAP, float* __restrict__ LSE, int b, int h, int dil, int res, int n, LAS unsigned char* lds) {
    int tid = threadIdx.x; asm volatile("" : "+v"(tid)); const int lane = tid & 63, wid = __builtin_amdgcn_readfirstlane(tid >> 6), i32 = lane & 31, hi = lane >> 5;
    const size_t tok0 = (size_t)b * SEQ;
    {
#pragma unroll
        for (int i = 0; i < 6; ++i) {
            const int e = tid + 512 * i, kr = e >> 3, ch = e & 7, j = 256 * n - 128 + kr;
            u32x4 kv = (u32x4){0u, 0u, 0u, 0u}, vv = kv;
            if (j >= 0) { const bf16* p = QKV + (tok0 + (size_t)j * dil + res) * QKVC + h * 64 + ch * 8; kv = *(const u32x4*)(p + 512); vv = *(const u32x4*)(p + 1024); }
            *(LAS u32x4*)(lds + kr * KA_STR + ch * 16) = kv;
            *(LAS u32x4*)(lds + KA_BYTES + kr * VA_STR + ch * 16) = vv;
        }
    }
    const int jq = 256 * n + 32 * wid + i32;
    const size_t qtok = tok0 + (size_t)jq * dil + res;
    bf16x8 qf[4];
    { const bf16* qp = QKV + qtok * QKVC + h * 64 + 8 * hi;
#pragma unroll
      for (int s = 0; s < 4; ++s) qf[s] = *(const bf16x8*)(qp + 16 * s); }
    __syncthreads();
    f32x16 p[5];
    const int ufirst = (n == 0) ? ((wid < 4) ? 4 - wid : 0) : 0;
#pragma unroll
    for (int u = 0; u < 5; ++u) {
        p[u] = (f32x16){};
        if (u >= ufirst) {
            const LAS unsigned char* kb = lds + (32 * (wid + u) + i32) * KA_STR + 16 * hi;
#pragma unroll
            for (int s = 0; s < 4; ++s) { const bf16x8 a = *(const LAS bf16x8*)(kb + 32 * s); p[u] = MFMA32(a, qf[s], p[u]); }
        } else {
#pragma unroll
            for (int r = 0; r < 16; ++r) p[u][r] = -INFINITY;
        }
    }
#pragma unroll
    for (int r = 0; r < 16; ++r) { const int kl = crow(r, hi); if (kl < i32) p[0][r] = -INFINITY; if (kl > i32) p[4][r] = -INFINITY; }
    float mx = fmaxf(fmaxf(fmaxf(max16(p[0]), max16(p[1])), fmaxf(max16(p[2]), max16(p[3]))), max16(p[4]));
    mx = fmaxf(mx, other_half(mx));
    float l = 0.f;
#pragma unroll
    for (int u = 0; u < 5; ++u) {
#pragma unroll
        for (int r = 0; r < 16; ++r) p[u][r] = __builtin_amdgcn_exp2f(p[u][r] - mx);
        l += sum16(p[u]);
    }
    l += __shfl_xor(l, 32);
    f32x16 o[2]; o[0] = (f32x16){}; o[1] = (f32x16){};
    const int lg = lane & 15, gg = (lane >> 4) & 1;
    const LAS unsigned char* vb = lds + KA_BYTES + (4 * hi + (lg >> 2)) * VA_STR + (16 * gg + 4 * (lg & 3)) * 2;
#pragma unroll
    for (int u = 0; u < 5; ++u) {
        if (u >= ufirst) {
#pragma unroll
            for (int s2 = 0; s2 < 2; ++s2) {
                const bf16x8 pf = packp(p[u], 8 * s2);
#pragma unroll
                for (int d = 0; d < 2; ++d) { const bf16x8 a = vfrag(vb + (32 * (wid + u) + 16 * s2) * VA_STR + d * 64, 8 * VA_STR); o[d] = MFMA32(a, pf, o[d]); }
            }
        }
    }
    const float inv = 1.f / l;
    const int pat = (dil == 1) ? 0 : ((dil == 4) ? 1 : 2);
    bf16* op = OAP + (size_t)pat * NTOK * 512 + qtok * 512 + h * 64;
#pragma unroll
    for (int d = 0; d < 2; ++d)
#pragma unroll
        for (int r4 = 0; r4 < 4; ++r4) {
            const int dv = 32 * d + 8 * r4 + 4 * hi;
            u32x2 w; w.x = pkbf(o[d][4 * r4] * inv, o[d][4 * r4 + 1] * inv); w.y = pkbf(o[d][4 * r4 + 2] * inv, o[d][4 * r4 + 3] * inv);
            *(u32x2*)(op + dv) = w;
        }
    if (hi == 0) LSE[(size_t)pat * NTOK * 8 + qtok * 8 + h] = mx + __builtin_amdgcn_logf(l);
    __syncthreads();
}

__device__ __forceinline__ void combine_phase(const bf16* __restrict__ OAP, const float* __restrict__ LSE, bf16* __restrict__ ATT, int gt, int ngt) {
    for (int i = gt; i < NTOK * 64; i += ngt) {
        const int tokh = i >> 3, ch = i & 7; const size_t tok = (size_t)(tokh >> 3); const int h = tokh & 7;
        const float l0 = LSE[tokh], l1 = LSE[(size_t)NTOK * 8 + tokh], l2 = LSE[(size_t)2 * NTOK * 8 + tokh];
        const float m = fmaxf(l0, fmaxf(l1, l2));
        float w0 = __builtin_amdgcn_exp2f(l0 - m), w1 = __builtin_amdgcn_exp2f(l1 - m), w2 = __builtin_amdgcn_exp2f(l2 - m);
        const float is = 1.f / (w0 + w1 + w2); w0 *= is; w1 *= is; w2 *= is;
        const size_t off = tok * 512 + h * 64 + ch * 8;
        const u32x4 a = *(const u32x4*)(OAP + off), bq = *(const u32x4*)(OAP + (size_t)NTOK * 512 + off), cq = *(const u32x4*)(OAP + (size_t)2 * NTOK * 512 + off);
        u32x4 o;
#pragma unroll
        for (int e = 0; e < 4; ++e) o[e] = pkbf(w0 * bflo(a[e]) + w1 * bflo(bq[e]) + w2 * bflo(cq[e]), w0 * bfhi(a[e]) + w1 * bfhi(bq[e]) + w2 * bfhi(cq[e]));
        *(u32x4*)(ATT + tok * DM + h * 64 + ch * 8) = o;
    }
}

constexpr int SC_T = 32, SC_VEC = SC_T * 64 * 4, SC_BUF = 6 * SC_VEC + 256;
constexpr int SC_BON = 2 * SC_BUF + 2 * SC_T * 64 * 4;
constexpr int SC_Y = 2 * SC_BUF;
template <int CTRL> __device__ __forceinline__ float dpp_add(float v) {
    const int m = __builtin_amdgcn_update_dpp(0, __float_as_int(v), CTRL, 0xf, 0xf, true);
    return v + __int_as_float(m);
}
#ifdef DBG_SHFL
__device__ __forceinline__ float red8(float v) { v += __shfl_xor(v, 1); v += __shfl_xor(v, 2); v += __shfl_xor(v, 4); return v; }
#else
__device__ __forceinline__ float red8(float v) { v = dpp_add<0xB1>(v); v = dpp_add<0x4E>(v); v = dpp_add<0x141>(v); return v; }
#endif
__device__ __forceinline__ float red16x2(float v0, float v1, bool odd) {
    const float keep = odd ? v1 : v0, send = odd ? v0 : v1;
    float x = keep + __int_as_float(__builtin_amdgcn_update_dpp(0, __float_as_int(send), 0xB1, 0xf, 0xf, true));
    x = dpp_add<0x4E>(x);
    x = dpp_add<0x124>(x);
    x = dpp_add<0x128>(x);
    return x;
}
__device__ __forceinline__ u32x2 ld8_agent(const void* p) {
    const unsigned long long v = __hip_atomic_load((const unsigned long long*)p, __ATOMIC_RELAXED, __HIP_MEMORY_SCOPE_AGENT);
    return __builtin_bit_cast(u32x2, v);
}
__device__ __forceinline__ unsigned short ld2_agent(const unsigned short* p) {
    const unsigned* q = (const unsigned*)((size_t)p & ~(size_t)3);
    const unsigned w = __hip_atomic_load(q, __ATOMIC_RELAXED, __HIP_MEMORY_SCOPE_AGENT);
    return (unsigned short)(((size_t)p & 2) ? (w >> 16) : (w & 0xffffu));
}
__device__ __forceinline__ float wave_sum_dpp(float v) {
    v = dpp_add<0xB1>(v);
    v = dpp_add<0x4E>(v);
    v = dpp_add<0x124>(v);
    v = dpp_add<0x128>(v);
    v += __int_as_float(__builtin_amdgcn_update_dpp(0, __float_as_int(v), 0x142, 0xA, 0xF, false));
    v += __int_as_float(__builtin_amdgcn_update_dpp(0, __float_as_int(v), 0x143, 0xC, 0xF, false));
    return __int_as_float(__builtin_amdgcn_readlane(__float_as_int(v), 63));
}
struct ScanRegs { u32x2 r, k, v, a, w; };
__device__ __forceinline__ float red8x2(float v0, float v1, bool odd) {
    const float keep = odd ? v1 : v0, send = odd ? v0 : v1;
    float x = keep + __int_as_float(__builtin_amdgcn_update_dpp(0, __float_as_int(send), 0xB1, 0xf, 0xf, true));
    x = dpp_add<0x4E>(x);
    int t = __builtin_amdgcn_update_dpp(0, __float_as_int(x), 0x104, 0xf, 0x5, false);
    t = __builtin_amdgcn_update_dpp(t, __float_as_int(x), 0x114, 0xf, 0xA, false);
    return x + __int_as_float(t);
}
__device__ __forceinline__ float dot8(const f32x4& sa, const f32x4& sb, const f32x4& va, const f32x4& vb) {
    f32x2 acc = (f32x2){sa.x, sa.y} * (f32x2){va.x, va.y};
    acc = __builtin_elementwise_fma((f32x2){sa.z, sa.w}, (f32x2){va.z, va.w}, acc);
    acc = __builtin_elementwise_fma((f32x2){sb.x, sb.y}, (f32x2){vb.x, vb.y}, acc);
    acc = __builtin_elementwise_fma((f32x2){sb.z, sb.w}, (f32x2){vb.z, vb.w}, acc);
    asm volatile("" : "+v"(acc));
    return acc.x + acc.y;
}
__device__ __forceinline__ void scan_unit(const bf16* __restrict__ R, const bf16* __restrict__ Kb, const bf16* __restrict__ Vb, const unsigned short* __restrict__ W16, const bf16* __restrict__ Ab,
                                          const bf16* __restrict__ Gb, const float* k_k, const float* k_a, const float* r_k, const float* ln_w, const float* ln_b, bf16* __restrict__ Z,
                                          int b, int h, LAS unsigned char* lds) {
    int tid = threadIdx.x; asm volatile("" : "+v"(tid)); const int lane = tid & 63, wid = __builtin_amdgcn_readfirstlane(tid >> 6);
    const size_t tok0 = (size_t)b * SEQ;
    constexpr int NC = SEQ / SC_T;
    constexpr int SC_YB = SC_T * 64 * 4;
    if (wid >= 4) {
        const int ht = tid - 256, ptt = ht >> 4, pj0 = 4 * (ht & 15), pcol = h * 64 + pj0, hw = wid - 4;
        const f32x4 kk4 = *(const f32x4*)(k_k + pcol), ka4 = *(const f32x4*)(k_a + pcol), rk4 = *(const f32x4*)(r_k + pcol);
        const int col = h * 64 + lane;
        const float lnw = ln_w[col], lnb = ln_b[col];
        ScanRegs pr, pq;
#define S_LOAD1(P, c, TT) do { const size_t o_ = (tok0 + (size_t)(c) * SC_T + (TT)) * DM + pcol; P.r = ld8_agent(R + o_); P.k = ld8_agent(Kb + o_); P.v = ld8_agent(Vb + o_); P.a = ld8_agent(Ab + o_); P.w = ld8_agent(W16 + o_); } while (0)
#define S_PREP1(P, buf, TT, BIDX) do { \
        LAS unsigned char* b_ = lds + (buf) * SC_BUF; \
        const f32x4 r4 = {bflo(P.r[0]), bfhi(P.r[0]), bflo(P.r[1]), bfhi(P.r[1])}; \
        const f32x4 k4 = {bflo(P.k[0]), bfhi(P.k[0]), bflo(P.k[1]), bfhi(P.k[1])}; \
        const f32x4 v4 = {bflo(P.v[0]), bfhi(P.v[0]), bflo(P.v[1]), bfhi(P.v[1])}; \
        const f32x4 a4 = {bflo(P.a[0]), bfhi(P.a[0]), bflo(P.a[1]), bfhi(P.a[1])}; \
        const unsigned wx_ = P.w[0], wy_ = P.w[1]; \
        const pg8::f16x2 wlo_ = __builtin_bit_cast(pg8::f16x2, wx_); const pg8::f16x2 whi_ = __builtin_bit_cast(pg8::f16x2, wy_); \
        const f32x4 w4 = {__expf((float)wlo_.x), __expf((float)wlo_.y), __expf((float)whi_.x), __expf((float)whi_.y)}; \
        f32x4 kk = k4 * kk4; float ss = (kk.x * kk.x + kk.y * kk.y) + (kk.z * kk.z + kk.w * kk.w); \
        ss += __shfl_xor(ss, 1); ss += __shfl_xor(ss, 2); ss += __shfl_xor(ss, 4); ss += __shfl_xor(ss, 8); \
        kk = kk * fminf(__builtin_amdgcn_rsqf(ss), 1e12f); \
        const f32x4 km = k4 * (1.f + (a4 - 1.f) * ka4); \
        float bo = (r4.x * km.x * rk4.x + r4.y * km.y * rk4.y) + (r4.z * km.z * rk4.z + r4.w * km.w * rk4.w); \
        bo += __shfl_xor(bo, 1); bo += __shfl_xor(bo, 2); bo += __shfl_xor(bo, 4); bo += __shfl_xor(bo, 8); \
        const int eo_ = ((TT) * 64 + pj0) * 4; \
        *(LAS f32x4*)(b_ + 0 * SC_VEC + eo_) = r4; *(LAS f32x4*)(b_ + 1 * SC_VEC + eo_) = w4; *(LAS f32x4*)(b_ + 2 * SC_VEC + eo_) = km; \
        *(LAS f32x4*)(b_ + 3 * SC_VEC + eo_) = -kk; *(LAS f32x4*)(b_ + 4 * SC_VEC + eo_) = kk * a4; *(LAS f32x4*)(b_ + 5 * SC_VEC + eo_) = v4; \
        if ((ht & 15) == 0) *(LAS float*)(lds + SC_BON + (BIDX) * 128 + (TT) * 4) = bo; } while (0)
        S_LOAD1(pr, 0, ptt); S_LOAD1(pq, 0, ptt + 16); S_PREP1(pr, 0, ptt, 0); S_PREP1(pq, 0, ptt + 16, 0);
        __syncthreads();
        for (int c = 0; c <= NC; ++c) {
            if (c + 1 < NC) { S_LOAD1(pr, c + 1, ptt); S_LOAD1(pq, c + 1, ptt + 16); }
            if (c >= 1) {
                const int cp = c - 1;
                const LAS float* ybuf = (const LAS float*)(lds + SC_Y + (cp & 1) * SC_YB);
#pragma unroll
                for (int q = 0; q < SC_T / 4; ++q) {
                    const int tt = hw + 4 * q;
                    const float y = ybuf[tt * 64 + lane];
                    const float mean = wave_sum_dpp(y) * (1.f / 64.f); const float dy = y - mean;
                    const float var = wave_sum_dpp(dy * dy) * (1.f / 64.f);
                    const float yn = dy * __builtin_amdgcn_rsqf(var + 64e-5f) * lnw + lnb;
                    const size_t o_ = (tok0 + (size_t)cp * SC_T + tt) * DM + col;
                    const float bo = *(const LAS float*)(lds + SC_BON + (cp % 3) * 128 + tt * 4), vv = bf2f(ld2_agent(Vb + o_));
                    const float gt = bf2f(ld2_agent(Gb + o_));
                    const float outv = (yn + bo * vv) * gt;
                    Z[o_] = (bf16)(pkbf(outv, outv) & 0xffffu);
                }
            }
            if (c + 1 < NC) { const int bi_ = (c + 1) % 3; S_PREP1(pr, (c + 1) & 1, ptt, bi_); S_PREP1(pq, (c + 1) & 1, ptt + 16, bi_); }
            __syncthreads();
        }
#undef S_LOAD1
#undef S_PREP1
    } else {
        const int sq = lane & 7, si0 = 16 * wid + 2 * (lane >> 3), sj = 8 * sq;
        const bool odd = (sq & 1) != 0;
        f32x4 S0a = {0.f, 0.f, 0.f, 0.f}, S0b = S0a, S1a = S0a, S1b = S0a;
        __syncthreads();
        for (int c = 0; c <= NC; ++c) {
            if (c < NC) {
                const LAS unsigned char* bb = lds + (c & 1) * SC_BUF;
                LAS float* ybuf = (LAS float*)(lds + SC_Y + (c & 1) * SC_YB);
                const LAS unsigned char* vp_ = bb + sj * 4;
                const LAS unsigned char* vv_ = bb + 5 * SC_VEC + si0 * 4;
#define LD8(dstA, dstB, slot, TT) dstA = *(const LAS f32x4*)(vp_ + (slot) * SC_VEC + (TT) * 256); dstB = *(const LAS f32x4*)(vp_ + (slot) * SC_VEC + (TT) * 256 + 16)
                f32x4 rA, rB, wA, wB, kA, kB, aA, aB, bA, bB; f32x2 v2;
                LD8(rA, rB, 0, 0); LD8(wA, wB, 1, 0); LD8(kA, kB, 2, 0); LD8(aA, aB, 3, 0); LD8(bA, bB, 4, 0); v2 = *(const LAS f32x2*)(vv_);
#pragma unroll 2
                for (int tt = 0; tt < SC_T; ++tt) {
                    const int tn = (tt + 1) & (SC_T - 1);
                    f32x4 nrA, nrB, nwA, nwB, nkA, nkB, naA, naB, nbA, nbB;
                    LD8(nrA, nrB, 0, tn); LD8(nwA, nwB, 1, tn); LD8(nkA, nkB, 2, tn); LD8(naA, naB, 3, tn); LD8(nbA, nbB, 4, tn);
                    const f32x2 nv2 = *(const LAS f32x2*)(vv_ + tn * 256);
                    const float sx = red8x2(dot8(S0a, S0b, aA, aB), dot8(S1a, S1b, aA, aB), odd);
                    const float sa0 = __int_as_float(__builtin_amdgcn_update_dpp(0, __float_as_int(sx), 0x00, 0xf, 0xf, true));
                    const float sa1 = __int_as_float(__builtin_amdgcn_update_dpp(0, __float_as_int(sx), 0x55, 0xf, 0xf, true));
                    S0a = S0a * wA + (bA * sa0 + kA * v2.x); S0b = S0b * wB + (bB * sa0 + kB * v2.x);
                    S1a = S1a * wA + (bA * sa1 + kA * v2.y); S1b = S1b * wB + (bB * sa1 + kB * v2.y);
                    const float yx = red8x2(dot8(S0a, S0b, rA, rB), dot8(S1a, S1b, rA, rB), odd);
                    if (sq < 2) ybuf[tt * 64 + si0 + sq] = yx;
                    rA = nrA; rB = nrB; wA = nwA; wB = nwB; kA = nkA; kB = nkB; aA = naA; aB = naB; bA = nbA; bB = nbB; v2 = nv2;
                }
#undef LD8
            }
            __syncthreads();
        }
    }
    __syncthreads();
}

#ifdef DBG_CHECK
__device__ __forceinline__ unsigned hsh(unsigned x) { x ^= x >> 16; x *= 0x7feb352dU; x ^= x >> 15; x *= 0x846ca68bU; x ^= x >> 16; return x; }
__device__ __forceinline__ float dotcol(const bf16* arow, const float* W, int N, int c, int K, int lane) {
    float s = 0.f; for (int k = lane; k < K; k += 64) s += bf2f(arow[k]) * W[(size_t)k * N + c]; return wave_sum(s);
}
#define ERR_ACC(ref, fast) do { const float r_ = (ref), f_ = (fast); d2 += (r_ - f_) * (r_ - f_); r2 += r_ * r_; } while (0)
#define ERR_DONE(stage) do { d2 = wave_sum(d2); r2 = wave_sum(r2); if (lane == 0) CTLp[16 + (stage)] = sqrtf(d2 / fmaxf(r2, 1e-30f)); } while (0)
__device__ __forceinline__ void dbg_check(int ph, const Args* Ap, LAS unsigned char* lds, int lane) {
    asm volatile("" : "+s"(Ap)); const Args& A = *Ap; unsigned char* ws = A.ws; float* CTLp = (float*)(ws + WS_CTL);
    const bf16* HN = (const bf16*)(ws + WS_HN); const bf16* QKV = (const bf16*)(ws + WS_QKV); const bf16* ATT = (const bf16*)(ws + WS_ATT); const bf16* U = (const bf16*)(ws + WS_U);
    const bf16* X6 = (const bf16*)(ws + WS_X6); const bf16* TT = (const bf16*)(ws + WS_T); const bf16* RKV = (const bf16*)(ws + WS_RKV); const bf16* WAG = (const bf16*)(ws + WS_WAG); const bf16* Z = (const bf16*)(ws + WS_Z);
    const float* H = A.out; LAS float* sl = (LAS float*)lds;
    float d2 = 0.f, r2 = 0.f;
    if (ph == 1) {
        for (int smp = 0; smp < 48; ++smp) {
            const int t = hsh(smp) & 65535; int c = hsh(smp + 1000) % 3072; if (smp % 3 == 0) c = (c & ~63) | (hsh(smp + 7) & 15);
            const int sec = c / 512, hc = c & 63; const bf16* ar = HN + (size_t)t * DM;
            float v = dotcol(ar, A.attn_w_in, 3072, c, 1024, lane);
            if (sec != 2 && sec != 5 && hc < 16) { const float vp = dotcol(ar, A.attn_w_in, 3072, c ^ 8, 1024, lane); const float ang = (float)(t & 4095) * powf(500000.f, -(float)(hc & 7) / 8.f);
                v = (hc < 8) ? v * cosf(ang) - vp * sinf(ang) : v * cosf(ang) + vp * sinf(ang); }
            if (sec == 0 || sec == 3) v *= 0.125f * 1.4426950408889634f;
            if (lane == 0) ERR_ACC(v, bf2f(QKV[(size_t)t * QKVC + c]));
        }
        ERR_DONE(1);
    }
    if (ph == 2) {
        const float lam = CTLp[0];
        for (int smp = 0; smp < 7; ++smp) {
            int q = 0; if (smp == 1) q = 63; if (smp == 2) q = 64; if (smp == 3) q = 127; if (smp == 4) q = 128; if (smp == 5) q = 1000; if (smp == 6) q = 4095;
            const int b = hsh(smp + 50) & 15, h = hsh(smp + 60) & 3; const size_t tok0 = (size_t)b * SEQ;
            float mc[2], lc[2];
            for (int c = 0; c < 2; ++c) {
                const bf16* qp = QKV + (tok0 + q) * QKVC + 1536 + h * 128 + c * 64; float m = -INFINITY;
                for (int k = lane; k <= q; k += 64) { const bf16* kp = QKV + (tok0 + k) * QKVC + 2048 + h * 128 + c * 64; float s = 0.f; for (int d = 0; d < 64; ++d) s += bf2f(qp[d]) * bf2f(kp[d]); sl[c * 4096 + k] = s; m = fmaxf(m, s); }
#pragma unroll
                for (int o = 1; o < 64; o <<= 1) m = fmaxf(m, __shfl_xor(m, o));
                float l = 0.f; for (int k = lane; k <= q; k += 64) l += exp2f(sl[c * 4096 + k] - m);
                mc[c] = m; lc[c] = wave_sum(l);
            }
            asm volatile("s_waitcnt lgkmcnt(0)" ::: "memory");
            float o0 = 0.f, o1 = 0.f;
            for (int k = 0; k <= q; ++k) { const float a = exp2f(sl[k] - mc[0]) / lc[0] - lam * exp2f(sl[4096 + k] - mc[1]) / lc[1]; const bf16* vp = QKV + (tok0 + k) * QKVC + 2560 + h * 128; o0 += a * bf2f(vp[lane]); o1 += a * bf2f(vp[64 + lane]); }
            const float ss = wave_sum(o0 * o0 + o1 * o1), rs = 0.8f / sqrtf(ss / 128.f + 1e-5f);
            const bf16* ap = ATT + (tok0 + q) * DM + 512 + h * 128;
            ERR_ACC(o0 * rs * A.diff_subln[lane], bf2f(ap[lane])); ERR_ACC(o1 * rs * A.diff_subln[64 + lane], bf2f(ap[64 + lane]));
        }
        ERR_DONE(2);
    }
    if (ph == 3) {
        for (int smp = 0; smp < 10; ++smp) {
            int t = 0; if (smp == 1) t = 1; if (smp == 2) t = 127; if (smp == 3) t = 128; if (smp == 4) t = 129; if (smp == 5) t = 515; if (smp == 6) t = 2047; if (smp == 7) t = 2048; if (smp == 8) t = 4095; if (smp == 9) t = 3001;
            const int b = hsh(smp + 150) & 15, h = hsh(smp + 160) & 7; const size_t tok0 = (size_t)b * SEQ;
            const bf16* qp = QKV + (tok0 + t) * QKVC + h * 64; float m = -INFINITY;
            for (int e = lane; e < 387; e += 64) { const int pat = e / 129, mm = e % 129, dil = (pat == 0) ? 1 : ((pat == 1) ? 4 : 16), pos = t - mm * dil; float s = -INFINITY;
                if (pos >= 0) { const bf16* kp = QKV + (tok0 + pos) * QKVC + 512 + h * 64; s = 0.f; for (int d = 0; d < 64; ++d) s += bf2f(qp[d]) * bf2f(kp[d]); }
                sl[e] = s; m = fmaxf(m, s); }
#pragma unroll
            for (int o = 1; o < 64; o <<= 1) m = fmaxf(m, __shfl_xor(m, o));
            float l = 0.f; for (int e = lane; e < 387; e += 64) l += exp2f(sl[e] - m);
            l = wave_sum(l);
            asm volatile("s_waitcnt lgkmcnt(0)" ::: "memory");
            float o = 0.f;
            for (int e = 0; e < 387; ++e) { const int pat = e / 129, mm = e % 129, dil = (pat == 0) ? 1 : ((pat == 1) ? 4 : 16), pos = t - mm * dil; if (pos >= 0) o += exp2f(sl[e] - m) / l * bf2f(QKV[(tok0 + pos) * QKVC + 1024 + h * 64 + lane]); }
            ERR_ACC(o, bf2f(ATT[(tok0 + t) * DM + h * 64 + lane]));
        }
        ERR_DONE(3);
    }
    if (ph == 4) {
        for (int smp = 0; smp < 32; ++smp) { const int t = hsh(smp + 300) & 65535, c = hsh(smp + 400) & 1023;
            const float v = A.x[(size_t)t * DM + c] + dotcol(ATT + (size_t)t * DM, A.attn_w_out, 1024, c, 1024, lane); if (lane == 0) ERR_ACC(v, H[(size_t)t * DM + c]); }
        ERR_DONE(4);
    }
    if (ph == 6) {
        for (int smp = 0; smp < 32; ++smp) { const int t = hsh(smp + 500) & 65535, c = hsh(smp + 600) & 4095;
            float v = fmaxf(dotcol(HN + (size_t)t * DM, A.mlp_w1, 4096, c, 1024, lane), 0.f); v *= v; if (lane == 0) ERR_ACC(v, bf2f(U[(size_t)t * DFF + c])); }
        ERR_DONE(6);
    }
    if (ph == 8) {
        for (int smp = 0; smp < 12; ++smp) { int t = hsh(smp + 700) & 65535; if (smp == 0) t = 4096; if (smp == 1) t = 4095; if (smp == 2) t = 32; const int slot = smp % 6, mi = (slot == 1) ? 2 : ((slot == 2) ? 3 : ((slot == 3) ? 1 : slot));
            float s0 = 0.f, s1 = 0.f; const bool hp = (t & 4095) != 0;
            for (int k = lane; k < 1024; k += 64) { const float a = H[(size_t)t * DM + k]; s0 += a * a; if (hp) { const float p = H[(size_t)(t - 1) * DM + k]; s1 += p * p; } }
            const float r0 = 1.f / sqrtf(wave_sum(s0) / 1024.f + 1e-5f), r1 = 1.f / sqrtf(wave_sum(s1) / 1024.f + 1e-5f);
            for (int k = lane; k < 1024; k += 64) { const float g = A.norm_mix[DM + k]; const float hn = H[(size_t)t * DM + k] * r0 * g, hpv = hp ? H[(size_t)(t - 1) * DM + k] * r1 * g : 0.f;
                ERR_ACC(hn + (hpv - hn) * A.rwkv_mu[mi * DM + k], bf2f(X6[(size_t)slot * NTOK * DM + (size_t)t * DM + k])); } }
        ERR_DONE(8);
    }
    if (ph == 9) {
        for (int smp = 0; smp < 30; ++smp) { const int t = hsh(smp + 800) & 65535, wh = smp % 3, nn = (wh == 2) ? 160 : 64, c = hsh(smp + 900) % nn;
            const float* W = (wh == 0) ? A.rwkv_w1 : ((wh == 1) ? A.rwkv_a1 : A.rwkv_g1);
            float v = dotcol(X6 + (size_t)(3 + wh) * NTOK * DM + (size_t)t * DM, W, nn, c, 1024, lane); if (wh == 0) v = tanhf(v); if (wh == 2) v = 1.f / (1.f + expf(-v));
            if (lane == 0) ERR_ACC(v, bf2f(TT[(size_t)wh * NTOK * 256 + (size_t)t * 256 + c])); }
        ERR_DONE(9);
    }
    if (ph == 10) {
        for (int smp = 0; smp < 30; ++smp) { const int t = hsh(smp + 1100) & 65535, wh = smp % 3, c = hsh(smp + 1200) & 1023;
            const float* W = (wh == 0) ? A.rwkv_w_r : ((wh == 1) ? A.rwkv_w_k : A.rwkv_w_v);
            const float v = dotcol(X6 + (size_t)wh * NTOK * DM + (size_t)t * DM, W, 1024, c, 1024, lane); if (lane == 0) ERR_ACC(v, bf2f(RKV[(size_t)wh * NTOK * DM + (size_t)t * DM + c])); }
        ERR_DONE(10);
    }
    if (ph == 11) {
        for (int smp = 0; smp < 30; ++smp) { const int t = hsh(smp + 1300) & 65535, wh = smp % 3, kk = (wh == 2) ? 160 : 64, c = hsh(smp + 1400) & 1023;
            const float* W = (wh == 0) ? A.rwkv_w2 : ((wh == 1) ? A.rwkv_a2 : A.rwkv_g2);
            float v = dotcol(TT + (size_t)wh * NTOK * 256 + (size_t)t * 256, W, 1024, c, kk, lane); float f;
            const unsigned short raw = WAG[(size_t)wh * NTOK * DM + (size_t)t * DM + c];
            if (wh == 0) { const float z = A.rwkv_w0[c] + v; const float sp = fmaxf(-z, 0.f) + log1pf(expf(-fabsf(z))); v = -expf(-sp - 0.5f); f = (float)__builtin_bit_cast(_Float16, raw); }
            else if (wh == 1) { v = 1.f / (1.f + expf(-(A.rwkv_a0[c] + v))); f = bf2f(raw); } else f = bf2f(raw);
            if (lane == 0) ERR_ACC(v, f); }
        ERR_DONE(11);
    }
    if (ph == 12) {
        float ed[5] = {0.f, 0.f, 0.f, 0.f, 0.f}, er[5] = {0.f, 0.f, 0.f, 0.f, 0.f};
#pragma unroll
        for (int smp = 0; smp < 3; ++smp) {
            const int b = 0, h = smp; const size_t tok0 = (size_t)b * SEQ; const int col = h * 64 + lane;
            LAS float* sv = sl + 4096;
            for (int i = 0; i < 64; ++i) sl[i * 64 + lane] = 0.f;
            for (int t = 0; t < 40; ++t) {
                const size_t o = (tok0 + t) * DM + col;
                const float r = bf2f(RKV[o]), k = bf2f(RKV[(size_t)NTOK * DM + o]), v = bf2f(RKV[2 * (size_t)NTOK * DM + o]);
                const float w = expf((float)__builtin_bit_cast(_Float16, (unsigned short)WAG[o])), a = bf2f(WAG[(size_t)NTOK * DM + o]);
                float kk = k * A.rwkv_k_k[col]; kk = kk / fmaxf(sqrtf(wave_sum(kk * kk)), 1e-12f);
                const float km = k * (1.f + (a - 1.f) * A.rwkv_k_a[col]);
                float yl = 0.f;
                sv[lane] = v; asm volatile("s_waitcnt lgkmcnt(0)" ::: "memory");
#pragma unroll 1
                for (int i = 0; i < 64; ++i) { float st = sl[i * 64 + lane]; const float sa = wave_sum(st * (-kk)); st = st * w + sa * (kk * a) + sv[i] * km; sl[i * 64 + lane] = st; const float y = wave_sum(st * r); if (lane == i) yl = sa; }
                const float bonus = wave_sum(r * km * A.rwkv_r_k[col]);
                const float f_ = bf2f(Z[o]);
                if (smp == 0) { const float dd = (yl - f_) * (yl - f_), rr = yl * yl; if (t == 1) { ed[0] += 36.f * dd; er[0] += rr; } if (t == 2) { ed[3] += 36.f * dd; er[3] += rr; } if (t < 32) { ed[4] += dd; er[4] += rr; } }
                if (smp == 1) { ed[1] += (1.f - w - f_) * (1.f - w - f_); er[1] += (1.f - w) * (1.f - w); }
                if (smp == 2) { ed[2] += (kk * a - f_) * (kk * a - f_); er[2] += kk * a * kk * a; }
            }
        }
#pragma unroll
        for (int q = 0; q < 5; ++q) { d2 = ed[q]; r2 = er[q]; ERR_DONE(12 + q); }
    }
    if (ph == 13) {
    }
}
#endif
#define AS4 __attribute__((address_space(4)))
__device__ __forceinline__ const unsigned char AS4* kargs() { const unsigned char AS4* p = (const unsigned char AS4*)__builtin_amdgcn_kernarg_segment_ptr(); asm volatile("" : "+s"(p)); return p; }
#define KA(member) (*(decltype(Args::member) const AS4*)(kargs() + offsetof(Args, member)))
#define WSB(off) ((bf16*)(KA(ws) + (off)))
#define P_W_IN WSB(WS_WIN)
#define P_W_OUT WSB(WS_WOUT)
#define P_W1_0 WSB(WS_W1_0)
#define P_W2_0 WSB(WS_W2_0)
#define P_W1_1 WSB(WS_W1_1)
#define P_W2_1 WSB(WS_W2_1)
#define P_WR WSB(WS_WR)
#define P_WK WSB(WS_WK)
#define P_WV WSB(WS_WV)
#define P_WO WSB(WS_WO)
#define P_LW1 WSB(WS_LW1)
#define P_LA1 WSB(WS_LA1)
#define P_LG1 WSB(WS_LG1)
#define P_LW2 WSB(WS_LW2)
#define P_LA2 WSB(WS_LA2)
#define P_LG2 WSB(WS_LG2)
#define P_HN WSB(WS_HN)
#define P_QKV WSB(WS_QKV)
#define P_ATT WSB(WS_ATT)
#define P_OAP WSB(WS_OAP)
#define P_U WSB(WS_U)
#define P_X6 WSB(WS_X6)
#define P_TT WSB(WS_T)
#define P_RKV WSB(WS_RKV)
#define P_WAG WSB(WS_WAG)
#define P_Z WSB(WS_Z)
#define P_ROPE ((float*)(KA(ws) + WS_ROPE))
#define P_CTL ((float*)(KA(ws) + WS_CTL))
#define P_LSE ((float*)(KA(ws) + WS_LSE))
#define P_H (KA(out))
__global__ void __launch_bounds__(NTHR, 2) hybrid_fwd(Args A_unused) {
    extern __shared__ __attribute__((aligned(16))) unsigned char lds_raw[];
    LAS unsigned char* lds = (LAS unsigned char*)lds_raw;
    cg::grid_group grid = cg::this_grid();
    { int t0_ = threadIdx.x; asm volatile("" : "+v"(t0_)); if (t0_ < 2) ((LAS unsigned*)(lds + LDS_BARST))[t0_] = 0u; }
    __syncthreads();
    (void)xcd_barrier_post((unsigned*)(KA(ws) + WS_BAR), (volatile LAS unsigned*)(lds + LDS_BARST));
    const int G = gridDim.x, bx = blockIdx.x, ngw = G * NWAVES, ngt = G * NTHR;
#define TIDV int tid = threadIdx.x; asm volatile("" : "+v"(tid)); const int lane = tid & 63, wave = __builtin_amdgcn_readfirstlane(tid >> 6), gw = bx * NWAVES + wave, gt = bx * NTHR + tid; (void)lane; (void)gw; (void)gt;
    constexpr int lo = 0, hi = 18;
    int ph = 0;
#define PHASE_BEGIN if (ph >= lo && ph < hi) { TIDV
#ifdef DBG_CHECK
#define PHASE_END   } grid.sync(); { int t2_ = threadIdx.x; asm volatile("" : "+v"(t2_)); if (bx == 0 && t2_ < 64) dbg_check(ph, (const Args*)(const void*)__builtin_amdgcn_kernarg_segment_ptr(), lds, t2_); } grid.sync(); ++ph;
#else
#define PHASE_END   if (ph + 1 < hi) { if (ph == 0) grid.sync(); else { XcdBarrier xb_; xb_.bar = (unsigned*)(KA(ws) + WS_BAR); xb_.x = xb_xcc_id(); xb_.st = (volatile LAS unsigned*)(lds + LDS_BARST); xcd_barrier(xb_); } } } ++ph;
#endif
#define GEMM(EPI, Aptr, Bptr, N_, K_, ...) do { pg8::Gemm g_{(const pg8::bf16_t*)(Aptr), (const pg8::bf16_t*)(Bptr), NTOK, (N_), (K_)}; pg8::StaticOrder S_; S_.init(NTOK, (N_), G, bx); \
        EPI E_{__VA_ARGS__}; pg8::gemm_phase<EPI, pg8::StaticOrder, true, true>(lds, g_, S_, E_); } while (0)

    PHASE_BEGIN
    {
        LAS float* scr = (LAS float*)(lds + wave * 8192);
        int it0 = gw;
#define TJOB(W, K_, N_, WT, PITCH) { const int ni_ = ((K_) / 32) * ((N_) / 32); for (; it0 < ni_; it0 += ngw) transpose_item((W), (N_), (WT), (PITCH), scr, it0, lane); it0 -= ni_; }
        TJOB(KA(attn_w_in), 1024, 3072, P_W_IN, 1024)
        TJOB(KA(attn_w_out), 1024, 1024, P_W_OUT, 1024)
        TJOB(KA(mlp_w1), 1024, 4096, P_W1_0, 1024)
        TJOB(KA(mlp_w1) + (size_t)1024 * 4096, 1024, 4096, P_W1_1, 1024)
        TJOB(KA(mlp_w2), 4096, 1024, P_W2_0, 4096)
        TJOB(KA(mlp_w2) + (size_t)4096 * 1024, 4096, 1024, P_W2_1, 4096)
        TJOB(KA(rwkv_w_r), 1024, 1024, P_WR, 1024)
        TJOB(KA(rwkv_w_k), 1024, 1024, P_WK, 1024)
        TJOB(KA(rwkv_w_v), 1024, 1024, P_WV, 1024)
        TJOB(KA(rwkv_w_o), 1024, 1024, P_WO, 1024)
        TJOB(KA(rwkv_w1), 1024, 64, P_LW1, 1024)
        TJOB(KA(rwkv_a1), 1024, 64, P_LA1, 1024)
        TJOB(KA(rwkv_g1), 1024, 160, P_LG1, 1024)
        TJOB(KA(rwkv_w2), 64, 1024, P_LW2, 256)
        TJOB(KA(rwkv_a2), 64, 1024, P_LA2, 256)
        TJOB(KA(rwkv_g2), 160, 1024, P_LG2, 256)
#undef TJOB
        zero_region(P_LW1, 1024, 64, 256, 0, 1024, gt, ngt); zero_region(P_LA1, 1024, 64, 256, 0, 1024, gt, ngt); zero_region(P_LG1, 1024, 160, 256, 0, 1024, gt, ngt);
        zero_region(P_LW2, 256, 0, 1024, 64, 256, gt, ngt); zero_region(P_LA2, 256, 0, 1024, 64, 256, gt, ngt); zero_region(P_LG2, 256, 0, 1024, 160, 256, gt, ngt);
        for (int i = gt; i < 4096 * 8; i += ngt) {
            const int pos = i >> 3, f = i & 7;
            const float invf = (float)exp(-(double)f * 0.125 * log(500000.0));
            const float ang = (float)pos * invf;
            P_ROPE[pos * 16 + f] = (float)cos((double)ang); P_ROPE[pos * 16 + 8 + f] = (float)sin((double)ang);
        }
        if (bx == 0 && wave == 0) {
            const float* lp = KA(diff_lambda);
            const float s01 = wave_sum(lp[lane] * lp[64 + lane]), s23 = wave_sum(lp[128 + lane] * lp[192 + lane]);
            if (lane == 0) P_CTL[0] = expf(s01) - expf(s23) + 0.2f;
        }
        rms_phase_bf16(KA(x), KA(norm_mix), P_HN, gw, ngw, lane);
    }
    PHASE_END
    PHASE_BEGIN
    GEMM(pg8::Epi16<pg8::M_QKV>, P_HN, P_W_IN, QKVC, 1024, P_QKV, QKVC, P_ROPE);
    PHASE_END
    PHASE_BEGIN
    {
        const float lam = P_CTL[0];
        for (int rep_ = 0; rep_ < REP_ATTN; ++rep_)
        for (int u = bx; u < 2048; u += G) {
            const int i = u >> 8, cidx = u & 255, bh = cidx >> 2, s = (cidx & 3) * 4 + (i >> 1), qb = (i & 1) ? 31 - s : s;
            diffattn_unit(P_QKV, P_ATT, KA(diff_subln), lam, bh >> 2, bh & 3, qb, lds);
        }
        for (int rep_ = 0; rep_ < REP_ATTNA; ++rep_)
        for (int v = bx; v < 6144; v += G) {
            const int bh = v / 48, r48 = v - bh * 48, pat = r48 >> 4, q16 = r48 & 15;
            const int dil = (pat == 0) ? 1 : ((pat == 1) ? 4 : 16);
            const int nper = 16 / dil;
            const int res = q16 / nper, n = q16 - res * nper;
            dilattn_unit(P_QKV, P_OAP, P_LSE, bh >> 3, bh & 7, dil, res, n, lds);
        }
    }
    PHASE_END
    PHASE_BEGIN
    combine_phase(P_OAP, P_LSE, P_ATT, gt, ngt);
    PHASE_END
    PHASE_BEGIN
    GEMM(pg8::EpiRes, P_ATT, P_W_OUT, 1024, 1024, KA(x), P_H, DM);
    PHASE_END
    PHASE_BEGIN
    for (int rep_ = 0; rep_ < REP_RMS; ++rep_)
    rms_phase_bf16(P_H, KA(norm_mlp), P_HN, gw, ngw, lane);
    PHASE_END
    PHASE_BEGIN
    for (int rep_ = 0; rep_ < REP_UP; ++rep_)
    GEMM(pg8::Epi16<pg8::M_RELU2>, P_HN, P_W1_0, DFF, 1024, P_U, DFF, nullptr);
    PHASE_END
    PHASE_BEGIN
    GEMM(pg8::EpiRes, P_U, P_W2_0, 1024, DFF, P_H, P_H, DM);
    PHASE_END
    PHASE_BEGIN
    for (int rep_ = 0; rep_ < REP_XMIX; ++rep_)
    xmix_phase(P_H, KA(norm_mix) + DM, KA(rwkv_mu), P_X6, gw, ngw, lane);
    PHASE_END
    PHASE_BEGIN
    for (int rep_ = 0; rep_ < REP_LORA; ++rep_) {
    GEMM(pg8::Epi16<pg8::M_TANH>, P_X6 + 3 * (size_t)NTOK * DM, P_LW1, 256, 1024, P_TT, 256, nullptr);
    GEMM(pg8::Epi16<pg8::M_PLAIN>, P_X6 + 4 * (size_t)NTOK * DM, P_LA1, 256, 1024, P_TT + (size_t)NTOK * 256, 256, nullptr);
    GEMM(pg8::Epi16<pg8::M_SIGMOID>, P_X6 + 5 * (size_t)NTOK * DM, P_LG1, 256, 1024, P_TT + (size_t)2 * NTOK * 256, 256, nullptr); }
    PHASE_END
    PHASE_BEGIN
    GEMM(pg8::Epi16<pg8::M_PLAIN>, P_X6, P_WR, 1024, 1024, P_RKV, DM, nullptr);
    GEMM(pg8::Epi16<pg8::M_PLAIN>, P_X6 + (size_t)NTOK * DM, P_WK, 1024, 1024, P_RKV + (size_t)NTOK * DM, DM, nullptr);
    GEMM(pg8::Epi16<pg8::M_PLAIN>, P_X6 + 2 * (size_t)NTOK * DM, P_WV, 1024, 1024, P_RKV + 2 * (size_t)NTOK * DM, DM, nullptr);
    PHASE_END
    PHASE_BEGIN
    for (int rep_ = 0; rep_ < REP_LORA; ++rep_) {
    GEMM(pg8::Epi16<pg8::M_WLOG>, P_TT, P_LW2, 1024, 256, P_WAG, DM, KA(rwkv_w0));
    GEMM(pg8::Epi16<pg8::M_ASIG>, P_TT + (size_t)NTOK * 256, P_LA2, 1024, 256, P_WAG + (size_t)NTOK * DM, DM, KA(rwkv_a0));
    GEMM(pg8::Epi16<pg8::M_PLAIN>, P_TT + (size_t)2 * NTOK * 256, P_LG2, 1024, 256, P_WAG + 2 * (size_t)NTOK * DM, DM, nullptr); }
    PHASE_END
    PHASE_BEGIN
    for (int rep_ = 0; rep_ < REP_SCAN; ++rep_)
    for (int u = bx; u < 256; u += G)
        scan_unit(P_RKV, P_RKV + (size_t)NTOK * DM, P_RKV + 2 * (size_t)NTOK * DM, (const unsigned short*)P_WAG, P_WAG + (size_t)NTOK * DM, P_WAG + 2 * (size_t)NTOK * DM,
                  KA(rwkv_k_k), KA(rwkv_k_a), KA(rwkv_r_k), KA(rwkv_ln_w), KA(rwkv_ln_b), P_Z, u >> 4, u & 15, lds);
    PHASE_END
    PHASE_BEGIN
    GEMM(pg8::EpiRes, P_Z, P_WO, 1024, 1024, P_H, P_H, DM);
    PHASE_END
    PHASE_BEGIN
    rms_phase_bf16(P_H, KA(norm_mlp) + DM, P_HN, gw, ngw, lane);
    PHASE_END
    PHASE_BEGIN
    GEMM(pg8::Epi16<pg8::M_RELU2>, P_HN, P_W1_1, DFF, 1024, P_U, DFF, nullptr);
    PHASE_END
    PHASE_BEGIN
    GEMM(pg8::EpiRes, P_U, P_W2_1, 1024, DFF, P_H, P_H, DM);
    PHASE_END
    PHASE_BEGIN
    rms_phase_f32(P_H, KA(norm_final), P_H, gw, ngw, lane);
    PHASE_END
#ifdef DBG_CHECK
    { TIDV
      const float* CTLp = P_CTL; int bad = 0; float ev = 0.f;
      for (int k = 1; k < 20; ++k) { const float e = CTLp[16 + k]; if (bad == 0 && !(e < 0.03f)) { bad = k; ev = (e == e) ? e : 9.99f; } }
      if (bad) { float* o = P_H; const float c = sqrtf(10.f * (float)bad); for (size_t i = gt; i < (size_t)NTOK * DM; i += ngt) o[i] = c; if (gt == 0) o[0] = 1000.f * ev; } }
#endif
}
constexpr int N_PHASES = 18;

extern "C" void kernel_launch(void* const* d_in, const int* in_sizes, int n_in, void* d_out, int out_size, void* d_ws, size_t ws_size, hipStream_t stream) {
    static int grid = 0;
    if (grid == 0) {
        if (n_in != 28 || in_sizes[0] != NTOK * DM || out_size != NTOK * DM || ws_size < WS_END) { fprintf(stderr, "kernel_launch: unexpected shapes (n_in %d, ws %zu)\n", n_in, ws_size); grid = -1; return; }
        int dev = 0, cus = 0, per_cu = 0;
        hipGetDevice(&dev); hipDeviceGetAttribute(&cus, hipDeviceAttributeMultiprocessorCount, dev);
        if (hipFuncSetAttribute((const void*)hybrid_fwd, hipFuncAttributeMaxDynamicSharedMemorySize, LDS_BYTES) != hipSuccess) { fprintf(stderr, "kernel_launch: hipFuncSetAttribute failed\n"); grid = -1; return; }
        hipOccupancyMaxActiveBlocksPerMultiprocessor(&per_cu, (const void*)hybrid_fwd, NTHR, LDS_BYTES);
        (void)hipGetLastError();
        if (per_cu < 1) per_cu = 1;
        grid = cus * per_cu;
        fprintf(stderr, "kernel_launch: %d CUs x %d -> grid %d\n", cus, per_cu, grid);
    }
    if (grid < 0) return;
    if (hipMemsetAsync(d_ws, 0, CTL_ZERO_BYTES, stream) != hipSuccess) { fprintf(stderr, "kernel_launch: hipMemsetAsync failed\n"); return; }
    Args a{};
    const float** fp = (const float**)&a;
    for (int i = 0; i < 28; ++i) fp[i] = (const float*)d_in[i];
    a.out = (float*)d_out; a.ws = (unsigned char*)d_ws; a.ph_lo = 0; a.ph_hi = N_PHASES;
    void* args[] = {&a};
    hipError_t e = hipLaunchCooperativeKernel((const void*)hybrid_fwd, dim3(grid), dim3(NTHR), args, LDS_BYTES, stream);
    if (e != hipSuccess) fprintf(stderr, "cooperative launch failed: %s (grid %d)\n", hipGetErrorString(e), grid);
}
```

```cpp
#include <hip/hip_runtime.h>
#include <hip/hip_cooperative_groups.h>
#include <cstdio>
#include <cstdint>
namespace cg = cooperative_groups;
namespace pg8 {
#define PG8_LAS __attribute__((address_space(3)))
typedef unsigned short bf16_t;
typedef short bf16x8 __attribute__((ext_vector_type(8)));
typedef float f32x4 __attribute__((ext_vector_type(4)));
typedef unsigned u32x4 __attribute__((ext_vector_type(4)));
constexpr int BM = 256, BK = 64, HALF = 128, HTB = HALF * BK * 2  , STAGE_BYTES = 8 * HTB, NXCD = 8, WGM = 8;

__host__ __device__ __forceinline__ int lds_byte(int r, int c) { const int st = (r >> 4) * 2 + (c >> 5), rr = r & 15, cc = c & 31, ob = rr * 64 + cc * 2; return st * 1024 + (ob ^ (((ob >> 9) & 1) << 5)); }
__host__ __device__ __forceinline__ void stage_rc(int b, int& R, int& C) { const int st = b / 1024, sb = b % 1024, swz = sb ^ (((sb >> 9) & 1) << 5); R = (st >> 1) * 16 + swz / 64; C = (st & 1) * 32 + (swz % 64) / 2; }
__host__ __device__ __forceinline__ int perm32(int rho) { const int n = rho >> 4, i = rho & 15; return 8 * (i >> 2) + 4 * n + (i & 3); }

struct Unit { int pm, pn; };
struct Gemm { const bf16_t* A; const bf16_t* Bt; int M, N, K; };

struct StaticOrder {
    int nM, nN, nwg, G, c;
    __host__ __device__ void init(int M, int N, int G_, int c_) { nM = M / BM; nN = N / BM; nwg = nM * nN; G = G_; c = c_; }
    __host__ __device__ bool next(int i, Unit& u) const {
        const long L = (long)i * G + c; if (L >= nwg) return false;
        int wgid = (int)L; { const int q = nwg / NXCD, r = nwg % NXCD, xcd = wgid % NXCD, off = wgid / NXCD; wgid = (xcd < r ? xcd * (q + 1) : r * (q + 1) + (xcd - r) * q) + off; }
        const int nig = WGM * nN, gid = wgid / nig, fm = gid * WGM, gsz = (nM - fm) < WGM ? (nM - fm) : WGM;
        u.pm = fm + ((wgid % nig) % gsz); u.pn = (wgid % nig) / gsz; return true;
    }
    __device__ __forceinline__ void a_ready(const Unit&) const {}
    __device__ __forceinline__ void done(const Unit&) const {}
};

__device__ __forceinline__ unsigned cvt_pk_bf16(float lo, float hi) { unsigned r; asm volatile("v_cvt_pk_bf16_f32 %0, %1, %2" : "=v"(r) : "v"(lo), "v"(hi)); return r; }
typedef float f32x2 __attribute__((ext_vector_type(2)));
typedef unsigned u32x4 __attribute__((ext_vector_type(4)));
typedef _Float16 f16x2 __attribute__((ext_vector_type(2)));
__device__ __forceinline__ unsigned cvt_pk_f16(float lo, float hi) { f32x2 v = {lo, hi}; f16x2 h = __builtin_convertvector(v, f16x2); return __builtin_bit_cast(unsigned, h); }
enum { M_PLAIN = 0, M_RELU2 = 1, M_TANH = 2, M_SIGMOID = 3, M_QKV = 4, M_ASIG = 5, M_WLOG = 6 };
template <int MODE> struct Epi16 {
    static constexpr bool PERM = true, AFTER_DRAIN = false;
    bf16_t* O; int ldc; const float* vec;
    __device__ __forceinline__ void operator()(const f32x4 (&acc)[2][2][4][2], const Unit& u, int wr, int wc, int fr, int fq) const {
        const int row0 = u.pm * BM + wr * 64 + fr;
        const int col0 = u.pn * BM + wc * 32 + 8 * fq;
        const int sec = u.pn >> 1;
        const bool rope = (MODE == M_QKV) && (sec != 2) && (sec != 5);
        const bool rot_wave = rope && ((wc & 1) == 0);
        const float qs = (MODE == M_QKV && (sec == 0 || sec == 3)) ? (0.125f * 1.4426950408889634f) : 1.0f;
        f32x4 bias_[2][2];
        if (MODE == M_ASIG || MODE == M_WLOG) {
#pragma unroll
            for (int bj = 0; bj < 2; ++bj) { bias_[bj][0] = *(const f32x4*)(vec + col0 + bj * HALF); bias_[bj][1] = *(const f32x4*)(vec + col0 + bj * HALF + 4); }
        }
#pragma unroll
        for (int ai = 0; ai < 2; ++ai) {
            f32x4 tab[4][4];
            if (MODE == M_QKV) { if (rot_wave) {
#pragma unroll
                for (int m = 0; m < 4; ++m) { const float* t = vec + (size_t)((row0 + ai * HALF + m * 16) & 4095) * 16;
#pragma unroll
                    for (int q = 0; q < 4; ++q) tab[m][q] = *(const f32x4*)(t + 4 * q); } } }
#pragma unroll
            for (int m = 0; m < 4; ++m) {
                const int row = row0 + ai * HALF + m * 16;
                bf16_t* rowp = O + (size_t)row * ldc + col0;
                f32x4 cs0 = {1.f, 1.f, 1.f, 1.f}, cs1 = cs0, sn0 = {0.f, 0.f, 0.f, 0.f}, sn1 = sn0;
                if (MODE == M_QKV) { if (rot_wave) { cs0 = tab[m][0]; cs1 = tab[m][1]; sn0 = tab[m][2]; sn1 = tab[m][3]; } }
#pragma unroll
                for (int bj = 0; bj < 2; ++bj) {
                    f32x4 v0 = acc[ai][bj][m][0], v1 = acc[ai][bj][m][1];
                    if (MODE == M_QKV) {
                        if (rot_wave) {
                            f32x4 p0, p1;
#pragma unroll
                            for (int e = 0; e < 4; ++e) { p0[e] = __shfl_xor(v0[e], 16); p1[e] = __shfl_xor(v1[e], 16); }
                            if (fq < 2) { const float sg = (fq == 0) ? -1.f : 1.f; v0 = v0 * cs0 + (p0 * sn0) * sg; v1 = v1 * cs1 + (p1 * sn1) * sg; }
                        }
                        v0 = v0 * qs; v1 = v1 * qs;
                    }
                    if (MODE == M_RELU2) {
#pragma unroll
                        for (int e = 0; e < 4; ++e) { const float a = fmaxf(v0[e], 0.f), b = fmaxf(v1[e], 0.f); v0[e] = a * a; v1[e] = b * b; }
                    }
                    if (MODE == M_TANH) {
#pragma unroll
                        for (int e = 0; e < 4; ++e) { v0[e] = 1.f - 2.f * __builtin_amdgcn_rcpf(1.f + __builtin_amdgcn_exp2f(fminf(v0[e] * 2.885390081777927f, 60.f))); v1[e] = 1.f - 2.f * __builtin_amdgcn_rcpf(1.f + __builtin_amdgcn_exp2f(fminf(v1[e] * 2.885390081777927f, 60.f))); }
                    }
                    if (MODE == M_SIGMOID) {
#pragma unroll
                        for (int e = 0; e < 4; ++e) { v0[e] = 1.f / (1.f + __expf(-v0[e])); v1[e] = 1.f / (1.f + __expf(-v1[e])); }
                    }
                    if (MODE == M_ASIG) {
                        const f32x4 b0 = bias_[bj][0], b1 = bias_[bj][1];
#pragma unroll
                        for (int e = 0; e < 4; ++e) { v0[e] = 1.f / (1.f + __expf(-(v0[e] + b0[e]))); v1[e] = 1.f / (1.f + __expf(-(v1[e] + b1[e]))); }
                    }
                    u32x4 w;
                    if (MODE == M_WLOG) {
                        const f32x4 b0 = bias_[bj][0], b1 = bias_[bj][1];
#pragma unroll
                        for (int e = 0; e < 4; ++e) {
                            const float x0 = -(v0[e] + b0[e]), x1 = -(v1[e] + b1[e]);
                            const float s0 = fmaxf(x0, 0.f) + 0.6931471805599453f * __builtin_amdgcn_logf(1.f + __builtin_amdgcn_exp2f(-1.4426950408889634f * fabsf(x0)));
                            const float s1 = fmaxf(x1, 0.f) + 0.6931471805599453f * __builtin_amdgcn_logf(1.f + __builtin_amdgcn_exp2f(-1.4426950408889634f * fabsf(x1)));
                            v0[e] = -__builtin_amdgcn_exp2f(-1.4426950408889634f * (s0 + 0.5f)); v1[e] = -__builtin_amdgcn_exp2f(-1.4426950408889634f * (s1 + 0.5f));
                        }
                        w.x = cvt_pk_f16(v0[0], v0[1]); w.y = cvt_pk_f16(v0[2], v0[3]); w.z = cvt_pk_f16(v1[0], v1[1]); w.w = cvt_pk_f16(v1[2], v1[3]);
                    } else {
                        w.x = cvt_pk_bf16(v0[0], v0[1]); w.y = cvt_pk_bf16(v0[2], v0[3]); w.z = cvt_pk_bf16(v1[0], v1[1]); w.w = cvt_pk_bf16(v1[2], v1[3]);
                    }
                    *(u32x4*)(rowp + bj * HALF) = w;
                }
            }
        }
    }
};
struct EpiRes {
    static constexpr bool PERM = false, AFTER_DRAIN = false;
    const float* res; float* out; int ldc;
    __device__ __forceinline__ void operator()(const f32x4 (&acc)[2][2][4][2], const Unit& u, int wr, int wc, int fr, int fq) const {
        const int row0 = u.pm * BM + wr * 64 + fr, col0 = u.pn * BM + wc * 32 + 4 * fq;
#pragma unroll
        for (int ai = 0; ai < 2; ++ai)
#pragma unroll
            for (int m = 0; m < 4; ++m) {
                const size_t off = (size_t)(row0 + ai * HALF + m * 16) * ldc + col0;
#pragma unroll
                for (int bj = 0; bj < 2; ++bj)
#pragma unroll
                    for (int n = 0; n < 2; ++n) { const f32x4 r = *(const f32x4*)(res + off + bj * HALF + n * 16); *(f32x4*)(out + off + bj * HALF + n * 16) = r + acc[ai][bj][m][n]; }
            }
    }
};
template <class Epi, class Sched, bool ALIGN_EPI = false, bool SP2 = false>
__device__ __forceinline__ void gemm_phase(PG8_LAS unsigned char* lds, const Gemm g, const Sched& S, const Epi& E) {
    int tid = threadIdx.x; asm volatile("" : "+v"(tid)); const int wid = __builtin_amdgcn_readfirstlane(tid >> 6), lane = tid & 63, wr = wid >> 2, wc = wid & 3, fr = lane & 15, fq = lane >> 4;
    const int K = g.K, nt = K / BK;
    unsigned voffA[2], voffB[2];
#pragma unroll
    for (int i = 0; i < 2; ++i) { int R, C; stage_rc(tid * 16 + i * 8192, R, C); const int Rb = Epi::PERM ? ((R & ~31) + perm32(R & 31)) : R;
        voffA[i] = (unsigned)(R * K + C) * 2u; voffB[i] = (unsigned)(Rb * K + C) * 2u; }
    const size_t kstep = (size_t)(BK * 2);
    const size_t hstep = (size_t)HALF * K * 2;
    const size_t tstep = 2 * hstep;
    const unsigned ldsw = (unsigned)wid * 1024u;
    const int aoff = lds_byte(wr * 64 + fr, fq * 8), boff = lds_byte(wc * 32 + fr, fq * 8);
#define PG8_SA(b, h) (((b) * 2 + (h)) * HTB)
#define PG8_SB(b, h) ((4 + (b) * 2 + (h)) * HTB)
#define PG8_STAGE(bufoff, gbase, voff) do { _Pragma("unroll") for (int _i = 0; _i < 2; ++_i) \
        __builtin_amdgcn_global_load_lds((const unsigned*)((const char*)(gbase) + (voff)[_i]), (PG8_LAS unsigned*)(lds + (bufoff) + ldsw + _i * 8192), 16, 0, 0); } while (0)
#define PG8_LDA(dst, b, h) do { _Pragma("unroll") for (int m = 0; m < 4; ++m) _Pragma("unroll") for (int k = 0; k < 2; ++k) dst[m][k] = *(const PG8_LAS bf16x8*)(lds + PG8_SA(b, h) + aoff + m * 2048 + k * 1024); } while (0)
#define PG8_LDB(dst, b, h) do { _Pragma("unroll") for (int n = 0; n < 2; ++n) _Pragma("unroll") for (int k = 0; k < 2; ++k) dst[n][k] = *(const PG8_LAS bf16x8*)(lds + PG8_SB(b, h) + boff + n * 2048 + k * 1024); } while (0)
#define PG8_MMA(ai, bj, At, Bt) do { __builtin_amdgcn_s_setprio(1); _Pragma("unroll") for (int m = 0; m < 4; ++m) _Pragma("unroll") for (int n = 0; n < 2; ++n) _Pragma("unroll") for (int k = 0; k < 2; ++k) \
        acc[ai][bj][m][n] = __builtin_amdgcn_mfma_f32_16x16x32_bf16(Bt[n][k], At[m][k], acc[ai][bj][m][n], 0, 0, 0); __builtin_amdgcn_s_setprio(0); } while (0)
#define PG8_WAIT_V(n) asm volatile("s_waitcnt vmcnt(" #n ")" ::: "memory")
#define PG8_WAIT_L(n) asm volatile("s_waitcnt lgkmcnt(" #n ")" ::: "memory")
#define PG8_BAR __builtin_amdgcn_s_barrier()
#define PG8_SCHED __builtin_amdgcn_sched_barrier(0)
    Unit cur, nxt; int ui = 0;
    if (!S.next(0, cur)) return;
    f32x4 acc[2][2][4][2];
#pragma unroll
    for (int a = 0; a < 2; ++a)
#pragma unroll
        for (int b = 0; b < 2; ++b)
#pragma unroll
            for (int m = 0; m < 4; ++m)
#pragma unroll
                for (int n = 0; n < 2; ++n) acc[a][b][m][n] = (f32x4){0.f, 0.f, 0.f, 0.f};
    bf16x8 At[4][2], B0[2][2], B1[2][2];
    const char* cA = (const char*)g.A + (size_t)cur.pm * tstep; const char* cB = (const char*)g.Bt + (size_t)cur.pn * tstep;
    S.a_ready(cur);
    if constexpr (SP2) {
        PG8_STAGE(PG8_SB(0, 0), cB, voffB); PG8_STAGE(PG8_SB(0, 1), cB + hstep, voffB); PG8_STAGE(PG8_SA(0, 0), cA, voffA); PG8_STAGE(PG8_SA(0, 1), cA + hstep, voffA);
        if (wr == 1) PG8_BAR;
        PG8_WAIT_V(2); PG8_BAR;
        PG8_STAGE(PG8_SB(1, 0), cB + kstep, voffB); PG8_STAGE(PG8_SA(1, 0), cA + kstep, voffA); PG8_STAGE(PG8_SB(1, 1), cB + hstep + kstep, voffB);
        PG8_WAIT_V(6); PG8_BAR;
    } else {
        PG8_STAGE(PG8_SB(0, 0), cB, voffB); PG8_STAGE(PG8_SA(0, 0), cA, voffA); PG8_STAGE(PG8_SB(0, 1), cB + hstep, voffB); PG8_STAGE(PG8_SA(0, 1), cA + hstep, voffA);
        if (wr == 1) PG8_BAR;
        PG8_WAIT_V(4); PG8_BAR;
        PG8_STAGE(PG8_SB(1, 0), cB + kstep, voffB); PG8_STAGE(PG8_SA(1, 0), cA + kstep, voffA); PG8_STAGE(PG8_SB(1, 1), cB + hstep + kstep, voffB);
        PG8_WAIT_V(6); PG8_BAR;
    }
    for (;;) {
        const bool has_next = S.next(ui + 1, nxt);
        const char* nA = has_next ? (const char*)g.A + (size_t)nxt.pm * tstep : cA; const char* nB = has_next ? (const char*)g.Bt + (size_t)nxt.pn * tstep : cB;
        for (int t = 0; t < nt; t += 2) {
            const bool last = (t == nt - 2);
            const char* a1 = cA + (size_t)(t + 1) * kstep;
            const char* a2 = last ? nA : cA + (size_t)(t + 2) * kstep; const char* b2 = last ? nB : cB + (size_t)(t + 2) * kstep;
            const char* a3 = a2 + kstep; const char* b3 = b2 + kstep;
            if (last && has_next) S.a_ready(nxt);
            if constexpr (SP2) {
            PG8_LDB(B0, 0, 0); PG8_LDB(B1, 0, 1); PG8_SCHED; PG8_LDA(At, 0, 0); PG8_STAGE(PG8_SA(1, 1), a1 + hstep, voffA);
            PG8_WAIT_V(8); PG8_WAIT_L(0); PG8_BAR; PG8_MMA(0, 0, At, B0); PG8_MMA(0, 1, At, B1); PG8_BAR; PG8_SCHED;
            PG8_LDA(At, 0, 1); PG8_STAGE(PG8_SB(0, 0), b2, voffB); PG8_STAGE(PG8_SB(0, 1), b2 + hstep, voffB); PG8_STAGE(PG8_SA(0, 0), a2, voffA);
            PG8_WAIT_V(8); PG8_WAIT_L(0); PG8_BAR; PG8_MMA(1, 0, At, B0); PG8_MMA(1, 1, At, B1); PG8_BAR; PG8_SCHED;
            PG8_LDB(B0, 1, 0); PG8_LDB(B1, 1, 1); PG8_SCHED; PG8_LDA(At, 1, 0); PG8_STAGE(PG8_SA(0, 1), a2 + hstep, voffA);
            PG8_WAIT_V(8); PG8_WAIT_L(0); PG8_BAR; PG8_MMA(0, 0, At, B0); PG8_MMA(0, 1, At, B1); PG8_BAR; PG8_SCHED;
            PG8_LDA(At, 1, 1); PG8_STAGE(PG8_SB(1, 0), b3, voffB); PG8_STAGE(PG8_SB(1, 1), b3 + hstep, voffB); PG8_STAGE(PG8_SA(1, 0), a3, voffA);
            PG8_WAIT_V(8); PG8_WAIT_L(0); PG8_BAR; PG8_MMA(1, 0, At, B0); PG8_MMA(1, 1, At, B1); PG8_BAR; PG8_SCHED;
            } else {
            PG8_LDB(B0, 0, 0); PG8_SCHED; PG8_LDA(At, 0, 0); PG8_STAGE(PG8_SA(1, 1), a1 + hstep, voffA);
            PG8_WAIT_L(8); PG8_BAR; PG8_WAIT_L(0); PG8_MMA(0, 0, At, B0); PG8_BAR; PG8_SCHED;
            PG8_LDB(B1, 0, 1); PG8_STAGE(PG8_SB(0, 0), b2, voffB);
            PG8_BAR; PG8_WAIT_L(0); PG8_MMA(0, 1, At, B1); PG8_BAR;
            PG8_LDA(At, 0, 1); PG8_STAGE(PG8_SA(0, 0), a2, voffA);
            PG8_BAR; PG8_WAIT_L(0); PG8_MMA(1, 0, At, B0); PG8_BAR; PG8_SCHED;
            PG8_STAGE(PG8_SB(0, 1), b2 + hstep, voffB);
            PG8_WAIT_V(6); PG8_BAR; PG8_MMA(1, 1, At, B1); PG8_BAR;
            PG8_LDB(B0, 1, 0); PG8_SCHED; PG8_LDA(At, 1, 0); PG8_STAGE(PG8_SA(0, 1), a2 + hstep, voffA);
            PG8_WAIT_L(8); PG8_BAR; PG8_WAIT_L(0); PG8_MMA(0, 0, At, B0); PG8_BAR; PG8_SCHED;
            PG8_LDB(B1, 1, 1); PG8_STAGE(PG8_SB(1, 0), b3, voffB);
            PG8_BAR; PG8_WAIT_L(0); PG8_MMA(0, 1, At, B1); PG8_BAR;
            PG8_LDA(At, 1, 1); PG8_STAGE(PG8_SA(1, 0), a3, voffA);
            PG8_BAR; PG8_WAIT_L(0); PG8_MMA(1, 0, At, B0); PG8_BAR; PG8_SCHED;
            PG8_STAGE(PG8_SB(1, 1), b3 + hstep, voffB);
            PG8_WAIT_V(6); PG8_BAR; PG8_MMA(1, 1, At, B1); PG8_BAR;
            }
        }
        if constexpr (ALIGN_EPI) { if (wr == 0) PG8_BAR; }
        if constexpr (!Epi::AFTER_DRAIN) { E(acc, cur, wr, wc, fr, fq); S.done(cur); }
        if (!has_next) break;
#pragma unroll
        for (int a = 0; a < 2; ++a)
#pragma unroll
            for (int b = 0; b < 2; ++b)
#pragma unroll
                for (int m = 0; m < 4; ++m)
#pragma unroll
                    for (int n = 0; n < 2; ++n) acc[a][b][m][n] = (f32x4){0.f, 0.f, 0.f, 0.f};
        cur = nxt; cA = nA; cB = nB; ++ui;
        if constexpr (ALIGN_EPI) { if (wr == 1) PG8_BAR; }
    }
    PG8_WAIT_V(0);
    if constexpr (!ALIGN_EPI) { if (wr == 0) PG8_BAR; }
    PG8_BAR;
    if constexpr (Epi::AFTER_DRAIN) { E.fused(acc, cur, wr, wc, fr, fq, lds, wid, lane); S.done(cur); }
#undef PG8_SA
#undef PG8_SB
#undef PG8_STAGE
#undef PG8_LDA
#undef PG8_LDB
#undef PG8_MMA
#undef PG8_WAIT_V
#undef PG8_WAIT_L
#undef PG8_BAR
#undef PG8_SCHED
}
}
#define LAS __attribute__((address_space(3)))
typedef unsigned short bf16;
typedef float f32x4 __attribute__((ext_vector_type(4)));
typedef float f32x2 __attribute__((ext_vector_type(2)));
typedef float f32x16 __attribute__((ext_vector_type(16)));
typedef short bf16x8 __attribute__((ext_vector_type(8)));
typedef short s16x4 __attribute__((ext_vector_type(4)));
typedef unsigned u32x4 __attribute__((ext_vector_type(4)));
typedef unsigned u32x2 __attribute__((ext_vector_type(2)));

#ifndef REP_LORA
#define REP_LORA 1
#endif
#ifndef REP_UP
#define REP_UP 1
#endif
#ifndef REP_RMS
#define REP_RMS 1
#endif
#ifndef REP_XMIX
#define REP_XMIX 1
#endif
#ifndef REP_ATTN
#define REP_ATTN 1
#endif
#ifndef REP_ATTNA
#define REP_ATTNA 1
#endif
#ifndef REP_SCAN
#define REP_SCAN 1
#endif
constexpr int NWAVES = 8, NTHR = 512;
constexpr int NTOK = 65536, DM = 1024, SEQ = 4096, NBATCH = 16, DFF = 4096, QKVC = 3072;
constexpr size_t MiB = (size_t)1 << 20;
constexpr size_t WS_CTL = 0;
constexpr size_t WS_WIN = 1 * MiB, WS_WOUT = 7 * MiB, WS_W1_0 = 9 * MiB, WS_W2_0 = 17 * MiB, WS_W1_1 = 25 * MiB, WS_W2_1 = 33 * MiB;
constexpr size_t WS_WR = 41 * MiB, WS_WK = 43 * MiB, WS_WV = 45 * MiB, WS_WO = 47 * MiB;
constexpr size_t WS_LW1 = 49 * MiB, WS_LA1 = WS_LW1 + 512 * 1024, WS_LG1 = 50 * MiB, WS_LW2 = WS_LG1 + 512 * 1024, WS_LA2 = 51 * MiB, WS_LG2 = WS_LA2 + 512 * 1024;
constexpr size_t WS_ROPE = 52 * MiB;
constexpr size_t WS_HN = 65 * MiB;
constexpr size_t WS_QKV = 193 * MiB;
constexpr size_t WS_ATT = 577 * MiB;
constexpr size_t WS_OAP = 705 * MiB;
constexpr size_t WS_LSE = 897 * MiB;
constexpr size_t WS_U = 193 * MiB;
constexpr size_t WS_X6 = 65 * MiB;
constexpr size_t WS_T = 833 * MiB;
constexpr size_t WS_RKV = 449 * MiB;
constexpr size_t WS_WAG = 65 * MiB;
constexpr size_t WS_Z = 833 * MiB;
constexpr size_t WS_END = 961 * MiB;
constexpr size_t ACT = (size_t)NTOK * DM * 2;

constexpr int RING_BYTES = 131072, LDS_BYTES = 147456;
constexpr int LDS_BARST = 147200;
constexpr size_t WS_BAR = 16384;
constexpr size_t CTL_ZERO_BYTES = 65536;
#define XB_TMO      128
#define XB_XCNT(j)  (256  + 64 * (j))
#define XB_XSUB(j)  (1280 + 64 * (j))
#define XB_XGEN(j)  (2304 + 64 * (j))
#define XB_TOP      3328
#define XB_TOPGEN   3392
#define XCD_BAR_WORDS 3456
#define XB_SPIN_CAP (1u << 18)

__device__ __forceinline__ unsigned xb_ld(unsigned* p)              { return __hip_atomic_load(p, __ATOMIC_RELAXED, __HIP_MEMORY_SCOPE_AGENT); }
__device__ __forceinline__ unsigned xb_add(unsigned* p, unsigned v) { return __hip_atomic_fetch_add(p, v, __ATOMIC_RELAXED, __HIP_MEMORY_SCOPE_AGENT); }
__device__ __forceinline__ unsigned xb_xcc_id() { return (unsigned)__builtin_amdgcn_s_getreg((3 << 11) | 20) & 0xFu; }
#define XB_SPIN(cond, bar) do { unsigned _sp = 0; while (cond) { __builtin_amdgcn_s_sleep(1); \
    if ((++_sp & 255u) == 0u) { if (xb_ld(&(bar)[XB_TMO])) break; if (_sp > XB_SPIN_CAP) { atomicAdd(&(bar)[XB_TMO], 1u); break; } } } } while (0)

struct XcdBarrier {
    unsigned* bar; unsigned x;
    volatile LAS unsigned* st;
};

__device__ __forceinline__ XcdBarrier xcd_barrier_post(unsigned* bar, volatile LAS unsigned* st) {
    XcdBarrier b; b.bar = bar; b.x = xb_xcc_id(); b.st = st;
    if (threadIdx.x == 0) (void)xb_add(&bar[XB_XCNT(b.x)], 1u);
    return b;
}
__device__ __forceinline__ void xcd_barrier_complete(unsigned* bar, unsigned x, unsigned& nloc, unsigned& nx) {
    const unsigned G = gridDim.x * gridDim.y * gridDim.z;
    unsigned sum, cnt, mine, sp = 0u;
    for (;;) {
        sum = 0u; cnt = 0u; mine = 0u;
#pragma unroll
        for (unsigned j = 0; j < 16; ++j) { const unsigned c = xb_ld(&bar[XB_XCNT(j)]); sum += c; cnt += (c > 0u) ? 1u : 0u; mine = (j == x) ? c : mine; }
        if (sum == G) break;
        __builtin_amdgcn_s_sleep(1);
        if ((++sp & 255u) == 0u) { if (xb_ld(&bar[XB_TMO])) break; if (sp > XB_SPIN_CAP) { atomicAdd(&bar[XB_TMO], 1u); break; } }
    }
    nloc = mine > 0u ? mine : 1u; nx = cnt > 0u ? cnt : 1u;
}

__device__ __forceinline__ void xcd_barrier(const XcdBarrier& b) {
    asm volatile("s_waitcnt vmcnt(0)" ::: "memory");
    __syncthreads();
    if (threadIdx.x == 0) {
        unsigned* bar = b.bar;
        __builtin_amdgcn_s_waitcnt(0);
        unsigned nloc = b.st[0], nx = b.st[1];
        if (nloc == 0u) { xcd_barrier_complete(bar, b.x, nloc, nx); b.st[0] = nloc; b.st[1] = nx; }
        const unsigned old = xb_add(&bar[XB_XSUB(b.x)], 1u);
        const unsigned gen = old / nloc;
        if (old + 1u == (gen + 1u) * nloc) {
            __builtin_amdgcn_fence(__ATOMIC_RELEASE, "agent");
            asm volatile("s_waitcnt vmcnt(0)" ::: "memory");
            const unsigned og = xb_add(&bar[XB_TOP], 1u);
            const unsigned tg = og / nx;
            if (og + 1u == (tg + 1u) * nx) xb_add(&bar[XB_TOPGEN], 1u);
            else XB_SPIN(xb_ld(&bar[XB_TOPGEN]) == tg, bar);
            __builtin_amdgcn_fence(__ATOMIC_ACQUIRE, "agent");
            xb_add(&bar[XB_XGEN(b.x)], 1u);
            asm volatile("s_waitcnt vmcnt(0)" ::: "memory");
        } else {
            XB_SPIN(xb_ld(&bar[XB_XGEN(b.x)]) == gen, bar);
            __builtin_amdgcn_fence(__ATOMIC_ACQUIRE, "agent");
            asm volatile("s_waitcnt vmcnt(0)" ::: "memory");
        }
    }
    __syncthreads();
}


__device__ __forceinline__ unsigned pkbf(float lo, float hi) { return pg8::cvt_pk_bf16(lo, hi); }
__device__ __forceinline__ float bf2f(unsigned short h) { return __uint_as_float(((unsigned)h) << 16); }
__device__ __forceinline__ float bflo(unsigned w) { return __uint_as_float(w << 16); }
__device__ __forceinline__ float bfhi(unsigned w) { return __uint_as_float(w & 0xffff0000u); }
__device__ __forceinline__ float wave_sum(float v) {
#define WS_DPP_(x, ctrl, rmask, bctl) __int_as_float(__builtin_amdgcn_update_dpp(0, __float_as_int(x), (ctrl), (rmask), 0xF, (bctl)))
    v += WS_DPP_(v, 0xB1, 0xF, true);
    v += WS_DPP_(v, 0x4E, 0xF, true);
    v += WS_DPP_(v, 0x124, 0xF, true);
    v += WS_DPP_(v, 0x128, 0xF, true);
    v += WS_DPP_(v, 0x142, 0xA, false);
    v += WS_DPP_(v, 0x143, 0xC, false);
#undef WS_DPP_
    return __int_as_float(__builtin_amdgcn_readlane(__float_as_int(v), 63));
}

struct Args {
    const float* x; const float* norm_mix; const float* norm_mlp; const float* norm_final;
    const float* attn_w_in; const float* attn_w_out; const float* diff_lambda; const float* diff_subln;
    const float* rwkv_mu; const float* rwkv_w_r; const float* rwkv_w_k; const float* rwkv_w_v; const float* rwkv_w_o;
    const float* rwkv_w0; const float* rwkv_w1; const float* rwkv_w2; const float* rwkv_a0; const float* rwkv_a1; const float* rwkv_a2;
    const float* rwkv_g1; const float* rwkv_g2; const float* rwkv_k_k; const float* rwkv_k_a; const float* rwkv_r_k;
    const float* rwkv_ln_w; const float* rwkv_ln_b; const float* mlp_w1; const float* mlp_w2;
    float* out; unsigned char* ws; int ph_lo, ph_hi;
};

__device__ __forceinline__ void transpose_item(const float* __restrict__ W, int N, bf16* __restrict__ WT, int pitch, LAS float* scr, int item, int lane) {
    const int nblk = N >> 5, kb = item / nblk, nb = item - kb * nblk, k0 = kb * 32, n0 = nb * 32;
#pragma unroll 4
    for (int i = 0; i < 16; ++i) { const int kk = 2 * i + (lane >> 5); scr[kk * 33 + (lane & 31)] = W[(size_t)(k0 + kk) * N + n0 + (lane & 31)]; }
    asm volatile("s_waitcnt lgkmcnt(0)" ::: "memory");
    const int c = lane & 3;
#pragma unroll
    for (int j = 0; j < 2; ++j) { const int n = (lane >> 2) + 16 * j; const LAS float* s = scr + (8 * c) * 33 + n;
        u32x4 o; o.x = pkbf(s[0], s[33]); o.y = pkbf(s[66], s[99]); o.z = pkbf(s[132], s[165]); o.w = pkbf(s[198], s[231]);
        *(u32x4*)(WT + (size_t)(n0 + n) * pitch + k0 + 8 * c) = o; }
    asm volatile("s_waitcnt lgkmcnt(0)" ::: "memory");
}
__device__ __forceinline__ void zero_region(bf16* p, int pitch, int r0, int r1, int c0, int c1, int gt, int ngt) {
    const int cw = (c1 - c0) >> 3, n = (r1 - r0) * cw;
    for (int i = gt; i < n; i += ngt) { const int r = r0 + i / cw, c = c0 + (i % cw) * 8; *(u32x4*)(p + (size_t)r * pitch + c) = (u32x4){0u, 0u, 0u, 0u}; }
}
__device__ __forceinline__ void rms_row_bf16(const float* xrow, const float* gain, bf16* orow, int lane) {
    const f32x4* xr = (const f32x4*)xrow + lane; const f32x4* gr = (const f32x4*)gain + lane;
    f32x4 v[4]; float s = 0.f;
#pragma unroll
    for (int j = 0; j < 4; ++j) { v[j] = xr[64 * j]; s += (v[j].x * v[j].x + v[j].y * v[j].y) + (v[j].z * v[j].z + v[j].w * v[j].w); }
    const float rstd = 1.f / sqrtf(wave_sum(s) * (1.f / 1024.f) + 1e-5f);
    u32x2* o8 = (u32x2*)orow + lane;
#pragma unroll
    for (int j = 0; j < 4; ++j) { const f32x4 g = gr[64 * j]; u32x2 w; w.x = pkbf(v[j].x * rstd * g.x, v[j].y * rstd * g.y); w.y = pkbf(v[j].z * rstd * g.z, v[j].w * rstd * g.w); o8[64 * j] = w; }
}
__device__ __forceinline__ void rms_phase_bf16(const float* __restrict__ src, const float* __restrict__ gain, bf16* __restrict__ dst, int gw, int ngw, int lane) {
    const f32x4* gr = (const f32x4*)gain + lane;
    for (int m = 2 * gw; m < NTOK; m += 2 * ngw) {
        const f32x4* x0 = (const f32x4*)(src + (size_t)m * DM) + lane; const f32x4* x1 = x0 + DM / 4;
        f32x4 v[4], u[4]; float s = 0.f, t = 0.f;
#pragma unroll
        for (int j = 0; j < 4; ++j) { v[j] = x0[64 * j]; u[j] = x1[64 * j]; }
#pragma unroll
        for (int j = 0; j < 4; ++j) { s += (v[j].x * v[j].x + v[j].y * v[j].y) + (v[j].z * v[j].z + v[j].w * v[j].w); t += (u[j].x * u[j].x + u[j].y * u[j].y) + (u[j].z * u[j].z + u[j].w * u[j].w); }
        const float r0 = 1.f / sqrtf(wave_sum(s) * (1.f / 1024.f) + 1e-5f), r1 = 1.f / sqrtf(wave_sum(t) * (1.f / 1024.f) + 1e-5f);
        u32x2* o0 = (u32x2*)(dst + (size_t)m * DM) + lane; u32x2* o1 = o0 + DM / 4;
#pragma unroll
        for (int j = 0; j < 4; ++j) { const f32x4 g = gr[64 * j];
            u32x2 w; w.x = pkbf(v[j].x * r0 * g.x, v[j].y * r0 * g.y); w.y = pkbf(v[j].z * r0 * g.z, v[j].w * r0 * g.w); o0[64 * j] = w;
            u32x2 z; z.x = pkbf(u[j].x * r1 * g.x, u[j].y * r1 * g.y); z.y = pkbf(u[j].z * r1 * g.z, u[j].w * r1 * g.w); o1[64 * j] = z; }
    }
}
__device__ __forceinline__ void rms_phase_f32(const float* src, const float* gain, float* dst, int gw, int ngw, int lane) {
    const f32x4* gr = (const f32x4*)gain + lane;
    for (int m = 2 * gw; m < NTOK; m += 2 * ngw) {
        const f32x4* x0 = (const f32x4*)(src + (size_t)m * DM) + lane; const f32x4* x1 = x0 + DM / 4;
        f32x4 v[4], u[4]; float s = 0.f, t = 0.f;
#pragma unroll
        for (int j = 0; j < 4; ++j) { v[j] = x0[64 * j]; u[j] = x1[64 * j]; }
#pragma unroll
        for (int j = 0; j < 4; ++j) { s += (v[j].x * v[j].x + v[j].y * v[j].y) + (v[j].z * v[j].z + v[j].w * v[j].w); t += (u[j].x * u[j].x + u[j].y * u[j].y) + (u[j].z * u[j].z + u[j].w * u[j].w); }
        const float r0 = 1.f / sqrtf(wave_sum(s) * (1.f / 1024.f) + 1e-5f), r1 = 1.f / sqrtf(wave_sum(t) * (1.f / 1024.f) + 1e-5f);
        f32x4* o0 = (f32x4*)(dst + (size_t)m * DM) + lane; f32x4* o1 = o0 + DM / 4;
#pragma unroll
        for (int j = 0; j < 4; ++j) { const f32x4 g = gr[64 * j]; o0[64 * j] = v[j] * r0 * g; o1[64 * j] = u[j] * r1 * g; }
    }
}

__device__ __forceinline__ void xmix_phase(const float* __restrict__ h, const float* __restrict__ gain, const float* __restrict__ mu, bf16* __restrict__ X6, int gw, int ngw, int lane) {
    f32x4 g4[4], m6[6][4];
#pragma unroll
    for (int j = 0; j < 4; ++j) g4[j] = ((const f32x4*)gain + lane)[64 * j];
#pragma unroll
    for (int i = 0; i < 6; ++i) {
        const int mi = (i == 1) ? 2 : ((i == 2) ? 3 : ((i == 3) ? 1 : i));
#pragma unroll
        for (int j = 0; j < 4; ++j) m6[i][j] = ((const f32x4*)(mu + mi * DM) + lane)[64 * j];
    }
    for (int chunk = gw; chunk < NTOK / 32; chunk += ngw) {
        const int t0 = chunk * 32;
        f32x4 prev[4];
        if ((t0 & (SEQ - 1)) == 0) {
#pragma unroll
            for (int j = 0; j < 4; ++j) prev[j] = (f32x4){0.f, 0.f, 0.f, 0.f};
        } else {
            const f32x4* xr = (const f32x4*)(h + (size_t)(t0 - 1) * DM) + lane; float s = 0.f;
#pragma unroll
            for (int j = 0; j < 4; ++j) { prev[j] = xr[64 * j]; s += (prev[j].x * prev[j].x + prev[j].y * prev[j].y) + (prev[j].z * prev[j].z + prev[j].w * prev[j].w); }
            const float rstd = 1.f / sqrtf(wave_sum(s) * (1.f / 1024.f) + 1e-5f);
#pragma unroll
            for (int j = 0; j < 4; ++j) prev[j] = prev[j] * rstd * g4[j];
        }
        f32x4 nx[4];
        { const f32x4* xr = (const f32x4*)(h + (size_t)t0 * DM) + lane;
#pragma unroll
          for (int j = 0; j < 4; ++j) nx[j] = xr[64 * j]; }
        for (int t = t0; t < t0 + 32; ++t) {
            f32x4 v[4]; float s = 0.f;
#pragma unroll
            for (int j = 0; j < 4; ++j) v[j] = nx[j];
            if (t + 1 < t0 + 32) { const f32x4* xr = (const f32x4*)(h + (size_t)(t + 1) * DM) + lane;
#pragma unroll
              for (int j = 0; j < 4; ++j) nx[j] = xr[64 * j]; }
#pragma unroll
            for (int j = 0; j < 4; ++j) s += (v[j].x * v[j].x + v[j].y * v[j].y) + (v[j].z * v[j].z + v[j].w * v[j].w);
            const float rstd = 1.f / sqrtf(wave_sum(s) * (1.f / 1024.f) + 1e-5f);
#pragma unroll
            for (int j = 0; j < 4; ++j) v[j] = v[j] * rstd * g4[j];
#pragma unroll
            for (int i = 0; i < 6; ++i) {
                u32x2* o8 = (u32x2*)(X6 + (size_t)i * NTOK * DM + (size_t)t * DM) + lane;
#pragma unroll
                for (int j = 0; j < 4; ++j) { const f32x4 xx = v[j] + (prev[j] - v[j]) * m6[i][j]; u32x2 w; w.x = pkbf(xx.x, xx.y); w.y = pkbf(xx.z, xx.w); o8[64 * j] = w; }
            }
#pragma unroll
            for (int j = 0; j < 4; ++j) prev[j] = v[j];
        }
    }
}

__device__ __forceinline__ int crow(int r, int hi) { return (r & 3) + 8 * (r >> 2) + 4 * hi; }
__device__ __forceinline__ s16x4 vtr(const LAS unsigned char* p) {
    typedef short v4i16_t __attribute__((ext_vector_type(4)));
    return __builtin_bit_cast(s16x4, __builtin_amdgcn_ds_read_tr16_b64_v4i16((LAS v4i16_t*)p));
}
__device__ __forceinline__ bf16x8 vfrag(const LAS unsigned char* p, int row8) {
    const s16x4 lo = vtr(p), hi = vtr(p + row8);
    return (bf16x8){lo[0], lo[1], lo[2], lo[3], hi[0], hi[1], hi[2], hi[3]};
}
__device__ __forceinline__ bf16x8 packp(const f32x16& p, int b) {
    u32x4 w; w.x = pkbf(p[b], p[b + 1]); w.y = pkbf(p[b + 2], p[b + 3]); w.z = pkbf(p[b + 4], p[b + 5]); w.w = pkbf(p[b + 6], p[b + 7]);
    return __builtin_bit_cast(bf16x8, w);
}
__device__ __forceinline__ float max16(const f32x16& p) {
    float a = fmaxf(fmaxf(p[0], p[1]), fmaxf(p[2], p[3])), b = fmaxf(fmaxf(p[4], p[5]), fmaxf(p[6], p[7]));
    float c = fmaxf(fmaxf(p[8], p[9]), fmaxf(p[10], p[11])), d = fmaxf(fmaxf(p[12], p[13]), fmaxf(p[14], p[15]));
    return fmaxf(fmaxf(a, b), fmaxf(c, d));
}
__device__ __forceinline__ float sum16(const f32x16& p) {
    return ((p[0] + p[1]) + (p[2] + p[3])) + ((p[4] + p[5]) + (p[6] + p[7])) + ((p[8] + p[9]) + (p[10] + p[11])) + ((p[12] + p[13]) + (p[14] + p[15]));
}
__device__ __forceinline__ float other_half(float v) {
    const unsigned b = __float_as_uint(v);
    auto rr = __builtin_amdgcn_permlane32_swap(b, b, false, false);
    return __uint_as_float(((threadIdx.x & 32) != 0) ? rr[0] : rr[1]);
}
#define MFMA32(a, b, c) __builtin_amdgcn_mfma_f32_32x32x16_bf16((a), (b), (c), 0, 0, 0)

constexpr int KB_STR = 144, VB_STR = 320, KB_BYTES = 64 * KB_STR, VB_BYTES = 64 * VB_STR, BBUF = 2 * KB_BYTES + VB_BYTES;
constexpr int BX_OFF = 2 * BBUF;
__device__ __forceinline__ void diffattn_unit(const bf16* __restrict__ QKV, bf16* __restrict__ ATT, const float* subln, float lam, int b, int h, int qb, LAS unsigned char* lds) {
    int tid = threadIdx.x; asm volatile("" : "+v"(tid)); const int lane = tid & 63, wid = __builtin_amdgcn_readfirstlane(tid >> 6), c = wid >> 2, g = wid & 3, i32 = lane & 31, hi = lane >> 5;
    const size_t tok0 = (size_t)b * SEQ;
    const int qrow = qb * 128 + 32 * g + i32;
    bf16x8 qf[4];
    { const bf16* qp = QKV + (tok0 + qrow) * QKVC + 1536 + h * 128 + c * 64 + 8 * hi;
#pragma unroll
      for (int s = 0; s < 4; ++s) qf[s] = *(const bf16x8*)(qp + 16 * s); }
    const int krow = tid >> 3, kch = tid & 7;
    const bf16* ksrc = QKV + (tok0 + krow) * QKVC + 2048 + h * 128 + kch * 8;
    const int vrow0 = tid >> 4, vch = tid & 15;
    const bf16* vsrc = QKV + (tok0 + vrow0) * QKVC + 2560 + h * 128 + vch * 8;
    const int kdst = krow * KB_STR + kch * 16, vdst = vrow0 * VB_STR + vch * 16;
    const int NT = 2 * qb + 2;
    u32x4 rk0, rk1, rv0, rv1;
#define B_LOAD(t) do { const size_t o_ = (size_t)(t) * 64 * QKVC; rk0 = *(const u32x4*)(ksrc + o_); rk1 = *(const u32x4*)(ksrc + o_ + 64); rv0 = *(const u32x4*)(vsrc + o_); rv1 = *(const u32x4*)(vsrc + o_ + (size_t)32 * QKVC); } while (0)
#define B_STORE(buf) do { LAS unsigned char* b_ = lds + (buf) * BBUF; *(LAS u32x4*)(b_ + kdst) = rk0; *(LAS u32x4*)(b_ + KB_BYTES + kdst) = rk1; *(LAS u32x4*)(b_ + 2 * KB_BYTES + vdst) = rv0; *(LAS u32x4*)(b_ + 2 * KB_BYTES + vdst + 32 * VB_STR) = rv1; } while (0)
    B_LOAD(0);
    f32x16 o[4];
#pragma unroll
    for (int d = 0; d < 4; ++d) o[d] = (f32x16){};
    float m_ref = 0.f, l_run = 0.f;
    const int qmin = qb * 128 + 32 * g;
    const int lg = lane & 15, gg = (lane >> 4) & 1;
    const int voff = (4 * hi + (lg >> 2)) * VB_STR + (16 * gg + 4 * (lg & 3)) * 2;
    for (int t = 0; t < NT; ++t) {
        B_STORE(t & 1);
        __syncthreads();
        if (t + 1 < NT) B_LOAD(t + 1);
        const int k0 = 64 * t;
        if (k0 <= qmin + 31) {
            const LAS unsigned char* kb = lds + (t & 1) * BBUF + c * KB_BYTES;
            const LAS unsigned char* vb = lds + (t & 1) * BBUF + 2 * KB_BYTES + voff;
            f32x16 p0 = (f32x16){}, p1 = (f32x16){};
#pragma unroll
            for (int s = 0; s < 4; ++s) {
                const bf16x8 a0 = *(const LAS bf16x8*)(kb + i32 * KB_STR + 32 * s + 16 * hi);
                const bf16x8 a1 = *(const LAS bf16x8*)(kb + (32 + i32) * KB_STR + 32 * s + 16 * hi);
                p0 = MFMA32(a0, qf[s], p0); p1 = MFMA32(a1, qf[s], p1);
            }
            if (k0 + 63 > qmin) {
#pragma unroll
                for (int r = 0; r < 16; ++r) { const int kv = k0 + crow(r, hi); if (kv > qrow) p0[r] = -INFINITY; if (kv + 32 > qrow) p1[r] = -INFINITY; }
            }
            float mx = fmaxf(max16(p0), max16(p1));
            mx = fmaxf(mx, other_half(mx));
            if (t == 0) m_ref = mx;
            else if (__any(mx - m_ref > 8.f)) {
                const float dl = fmaxf(mx - m_ref, 0.f);
                m_ref += dl;
                const float alpha = __builtin_amdgcn_exp2f(-dl);
                l_run *= alpha;
#pragma unroll
                for (int d = 0; d < 4; ++d) o[d] = o[d] * alpha;
            }
#pragma unroll
            for (int r = 0; r < 16; ++r) { p0[r] = __builtin_amdgcn_exp2f(p0[r] - m_ref); p1[r] = __builtin_amdgcn_exp2f(p1[r] - m_ref); }
            l_run += sum16(p0) + sum16(p1);
#pragma unroll
            for (int s4 = 0; s4 < 4; ++s4) {
                const bf16x8 pfs = packp((s4 < 2) ? p0 : p1, 8 * (s4 & 1));
#pragma unroll
                for (int d = 0; d < 4; ++d) { const bf16x8 a = vfrag(vb + s4 * 16 * VB_STR + d * 64, 8 * VB_STR); o[d] = MFMA32(a, pfs, o[d]); }
                __builtin_amdgcn_sched_barrier(0);
            }
        }
    }
#undef B_LOAD
#undef B_STORE
    __syncthreads();
    float l_tot = l_run + __shfl_xor(l_run, 32);
    const float inv = 1.f / l_tot;
    LAS float* X = (LAS float*)(lds + BX_OFF) + g * 4096;
    if (c == 1) {
        const float sc = inv * lam;
#pragma unroll
        for (int d = 0; d < 4; ++d)
#pragma unroll
            for (int r = 0; r < 16; ++r) X[(32 * d + crow(r, hi)) * 32 + i32] = o[d][r] * sc;
    }
    __syncthreads();
    if (c == 0) {
        float ss = 0.f;
#pragma unroll
        for (int d = 0; d < 4; ++d)
#pragma unroll
            for (int r = 0; r < 16; ++r) { const float v = o[d][r] * inv - X[(32 * d + crow(r, hi)) * 32 + i32]; o[d][r] = v; ss += v * v; }
        ss += __shfl_xor(ss, 32);
        const float rs = (1.f / sqrtf(ss * (1.f / 128.f) + 1e-5f)) * 0.8f;
        bf16* op = ATT + (tok0 + qrow) * DM + 512 + h * 128;
#pragma unroll
        for (int d = 0; d < 4; ++d)
#pragma unroll
            for (int r4 = 0; r4 < 4; ++r4) {
                const int dv = 32 * d + 8 * r4 + 4 * hi; const f32x4 gn = *(const f32x4*)(subln + dv);
                u32x2 w; w.x = pkbf(o[d][4 * r4] * rs * gn.x, o[d][4 * r4 + 1] * rs * gn.y); w.y = pkbf(o[d][4 * r4 + 2] * rs * gn.z, o[d][4 * r4 + 3] * rs * gn.w);
                *(u32x2*)(op + dv) = w;
            }
    }
    __syncthreads();
}

constexpr int KA_STR = 144, VA_STR = 192, KA_BYTES = 384 * KA_STR, VA_BYTES = 384 * VA_STR;
__device__ __forceinline__ void dilattn_unit(const bf16* __restrict__ QKV, bf16* __restrict__ OAP, float* __restrict__ LSE, int b, int h, int dil, int res, int n, LAS unsigned char* lds) {
    int tid = threadIdx.x; asm volatile("" : "+v"(tid)); const int lane = tid & 63, wid = __builtin_amdgcn_readfirstlane(tid >> 6), i32 = lane & 31, hi = lane >> 5;
    const size_t tok0 = (size_t)b * SEQ;
    {
#pragma unroll
        for (int i = 0; i < 6; ++i) {
            const int e = tid + 512 * i, kr = e >> 3, ch = e & 7, j = 256 * n - 128 + kr;
            u32x4 kv = (u32x4){0u, 0u, 0u, 0u}, vv = kv;
            if (j >= 0) { const bf16* p = QKV + (tok0 + (size_t)j * dil + res) * QKVC + h * 64 + ch * 8; kv = *(const u32x4*)(p + 512); vv = *(const u32x4*)(p + 1024); }
            *(LAS u32x4*)(lds + kr * KA_STR + ch * 16) = kv;
            *(LAS u32x4*)(lds + KA_BYTES + kr * VA_STR + ch * 16) = vv;
        }
    }
    const int jq = 256 * n + 32 * wid + i32;
    const size_t qtok = tok0 + (size_t)jq * dil + res;
    bf16x8 qf[4];
    { const bf16* qp = QKV + qtok * QKVC + h * 64 + 8 * hi;
#pragma unroll
      for (int s = 0; s < 4; ++s) qf[s] = *(const bf16x8*)(qp + 16 * s); }
    __syncthreads();
    f32x16 p[5];
    const int ufirst = (n == 0) ? ((wid < 4) ? 4 - wid : 0) : 0;
#pragma unroll
    for (int u = 0; u < 5; ++u) {
        p[u] = (f32x16){};
        if (u >= ufirst) {
            const LAS unsigned char* kb = lds + (32 * (wid + u) + i32) * KA_STR + 16 * hi;
#pragma unroll
            for (int s = 0; s < 4; ++s) { const bf16x8 a = *(const LAS bf16x8*)(kb + 32 * s); p[u] = MFMA32(a, qf[s], p[u]); }
        } else {
#pragma unroll
            for (int r = 0; r < 16; ++r) p[u][r] = -INFINITY;
        }
    }
#pragma unroll
    for (int r = 0; r < 16; ++r) { const int kl = crow(r, hi); if (kl < i32) p[0][r] = -INFINITY; if (kl > i32) p[4][r] = -INFINITY; }
    float mx = fmaxf(fmaxf(fmaxf(max16(p[0]), max16(p[1])), fmaxf(max16(p[2]), max16(p[3]))), max16(p[4]));
    mx = fmaxf(mx, other_half(mx));
    float l = 0.f;
#pragma unroll
    for (int u = 0; u < 5; ++u) {
#pragma unroll
        for (int r = 0; r < 16; ++r) p[u][r] = __builtin_amdgcn_exp2f(p[u][r] - mx);
        l += sum16(p[u]);
    }
    l += __shfl_xor(l, 32);
    f32x16 o[2]; o[0] = (f32x16){}; o[1] = (f32x16){};
    const int lg = lane & 15, gg = (lane >> 4) & 1;
    const LAS unsigned char* vb = lds + KA_BYTES + (4 * hi + (lg >> 2)) * VA_STR + (16 * gg + 4 * (lg & 3)) * 2;
#pragma unroll
    for (int u = 0; u < 5; ++u) {
        if (u >= ufirst) {
#pragma unroll
            for (int s2 = 0; s2 < 2; ++s2) {
                const bf16x8 pf = packp(p[u], 8 * s2);
#pragma unroll
                for (int d = 0; d < 2; ++d) { const bf16x8 a = vfrag(vb + (32 * (wid + u) + 16 * s2) * VA_STR + d * 64, 8 * VA_STR); o[d] = MFMA32(a, pf, o[d]); }
            }
        }
    }
    const float inv = 1.f / l;
    const int pat = (dil == 1) ? 0 : ((dil == 4) ? 1 : 2);
    bf16* op = OAP + (size_t)pat * NTOK * 512 + qtok * 512 + h * 64;
#pragma unroll
    for (int d = 0; d < 2; ++d)
#pragma unroll
        for (int r4 = 0; r4 < 4; ++r4) {
            const int dv = 32 * d + 8 * r4 + 4 * hi;
            u32x2 w; w.x = pkbf(o[d][4 * r4] * inv, o[d][4 * r4 + 1] * inv); w.y = pkbf(o[d][4 * r4 + 2] * inv, o[d][4 * r4 + 3] * inv);
            *(u32x2*)(op + dv) = w;
        }
    if (hi == 0) LSE[(size_t)pat * NTOK * 8 + qtok * 8 + h] = mx + __builtin_amdgcn_logf(l);
    __syncthreads();
}

__device__ __forceinline__ void combine_phase(const bf16* __restrict__ OAP, const float* __restrict__ LSE, bf16* __restrict__ ATT, int gt, int ngt) {
    for (int i = gt; i < NTOK * 64; i += ngt) {
        const int tokh = i >> 3, ch = i & 7; const size_t tok = (size_t)(tokh >> 3); const int h = tokh & 7;
        const float l0 = LSE[tokh], l1 = LSE[(size_t)NTOK * 8 + tokh], l2 = LSE[(size_t)2 * NTOK * 8 + tokh];
        const float m = fmaxf(l0, fmaxf(l1, l2));
        float w0 = __builtin_amdgcn_exp2f(l0 - m), w1 = __builtin_amdgcn_exp2f(l1 - m), w2 = __builtin_amdgcn_exp2f(l2 - m);
        const float is = 1.f / (w0 + w1 + w2); w0 *= is; w1 *= is; w2 *= is;
        const size_t off = tok * 512 + h * 64 + ch * 8;
        const u32x4 a = *(const u32x4*)(OAP + off), bq = *(const u32x4*)(OAP + (size_t)NTOK * 512 + off), cq = *(const u32x4*)(OAP + (size_t)2 * NTOK * 512 + off);
        u32x4 o;
#pragma unroll
        for (int e = 0; e < 4; ++e) o[e] = pkbf(w0 * bflo(a[e]) + w1 * bflo(bq[e]) + w2 * bflo(cq[e]), w0 * bfhi(a[e]) + w1 * bfhi(bq[e]) + w2 * bfhi(cq[e]));
        *(u32x4*)(ATT + tok * DM + h * 64 + ch * 8) = o;
    }
}

constexpr int SC_T = 32, SC_VEC = SC_T * 64 * 4, SC_BUF = 6 * SC_VEC + 256;
constexpr int SC_BON = 2 * SC_BUF + 2 * SC_T * 64 * 4;
constexpr int SC_Y = 2 * SC_BUF;
template <int CTRL> __device__ __forceinline__ float dpp_add(float v) {
    const int m = __builtin_amdgcn_update_dpp(0, __float_as_int(v), CTRL, 0xf, 0xf, true);
    return v + __int_as_float(m);
}
#ifdef DBG_SHFL
__device__ __forceinline__ float red8(float v) { v += __shfl_xor(v, 1); v += __shfl_xor(v, 2); v += __shfl_xor(v, 4); return v; }
#else
__device__ __forceinline__ float red8(float v) { v = dpp_add<0xB1>(v); v = dpp_add<0x4E>(v); v = dpp_add<0x141>(v); return v; }
#endif
__device__ __forceinline__ float red16x2(float v0, float v1, bool odd) {
    const float keep = odd ? v1 : v0, send = odd ? v0 : v1;
    float x = keep + __int_as_float(__builtin_amdgcn_update_dpp(0, __float_as_int(send), 0xB1, 0xf, 0xf, true));
    x = dpp_add<0x4E>(x);
    x = dpp_add<0x124>(x);
    x = dpp_add<0x128>(x);
    return x;
}
__device__ __forceinline__ u32x2 ld8_agent(const void* p) {
    const unsigned long long v = __hip_atomic_load((const unsigned long long*)p, __ATOMIC_RELAXED, __HIP_MEMORY_SCOPE_AGENT);
    return __builtin_bit_cast(u32x2, v);
}
__device__ __forceinline__ unsigned short ld2_agent(const unsigned short* p) {
    const unsigned* q = (const unsigned*)((size_t)p & ~(size_t)3);
    const unsigned w = __hip_atomic_load(q, __ATOMIC_RELAXED, __HIP_MEMORY_SCOPE_AGENT);
    return (unsigned short)(((size_t)p & 2) ? (w >> 16) : (w & 0xffffu));
}
__device__ __forceinline__ float wave_sum_dpp(float v) {
    v = dpp_add<0xB1>(v);
    v = dpp_add<0x4E>(v);
    v = dpp_add<0x124>(v);
    v = dpp_add<0x128>(v);
    v += __int_as_float(__builtin_amdgcn_update_dpp(0, __float_as_int(v), 0x142, 0xA, 0xF, false));
    v += __int_as_float(__builtin_amdgcn_update_dpp(0, __float_as_int(v), 0x143, 0xC, 0xF, false));
    return __int_as_float(__builtin_amdgcn_readlane(__float_as_int(v), 63));
}
struct ScanRegs { u32x2 r, k, v, a, w; };
__device__ __forceinline__ float red8x2(float v0, float v1, bool odd) {
    const float keep = odd ? v1 : v0, send = odd ? v0 : v1;
    float x = keep + __int_as_float(__builtin_amdgcn_update_dpp(0, __float_as_int(send), 0xB1, 0xf, 0xf, true));
    x = dpp_add<0x4E>(x);
    int t = __builtin_amdgcn_update_dpp(0, __float_as_int(x), 0x104, 0xf, 0x5, false);
    t = __builtin_amdgcn_update_dpp(t, __float_as_int(x), 0x114, 0xf, 0xA, false);
    return x + __int_as_float(t);
}
__device__ __forceinline__ float dot8(const f32x4& sa, const f32x4& sb, const f32x4& va, const f32x4& vb) {
    f32x2 acc = (f32x2){sa.x, sa.y} * (f32x2){va.x, va.y};
    acc = __builtin_elementwise_fma((f32x2){sa.z, sa.w}, (f32x2){va.z, va.w}, acc);
    acc = __builtin_elementwise_fma((f32x2){sb.x, sb.y}, (f32x2){vb.x, vb.y}, acc);
    acc = __builtin_elementwise_fma((f32x2){sb.z, sb.w}, (f32x2){vb.z, vb.w}, acc);
    asm volatile("" : "+v"(acc));
    return acc.x + acc.y;
}
__device__ __forceinline__ void scan_unit(const bf16* __restrict__ R, const bf16* __restrict__ Kb, const bf16* __restrict__ Vb, const unsigned short* __restrict__ W16, const bf16* __restrict__ Ab,
                                          const bf16* __restrict__ Gb, const float* k_k, const float* k_a, const float* r_k, const float* ln_w, const float* ln_b, bf16* __restrict__ Z,
                                          int b, int h, LAS unsigned char* lds) {
    int tid = threadIdx.x; asm volatile("" : "+v"(tid)); const int lane = tid & 63, wid = __builtin_amdgcn_readfirstlane(tid >> 6);
    const size_t tok0 = (size_t)b * SEQ;
    constexpr int NC = SEQ / SC_T;
    constexpr int SC_YB = SC_T * 64 * 4;
    if (wid >= 4) {
        const int ht = tid - 256, ptt = ht >> 4, pj0 = 4 * (ht & 15), pcol = h * 64 + pj0, hw = wid - 4;
        const f32x4 kk4 = *(const f32x4*)(k_k + pcol), ka4 = *(const f32x4*)(k_a + pcol), rk4 = *(const f32x4*)(r_k + pcol);
        const int col = h * 64 + lane;
        const float lnw = ln_w[col], lnb = ln_b[col];
        ScanRegs pr, pq;
#define S_LOAD1(P, c, TT) do { const size_t o_ = (tok0 + (size_t)(c) * SC_T + (TT)) * DM + pcol; P.r = ld8_agent(R + o_); P.k = ld8_agent(Kb + o_); P.v = ld8_agent(Vb + o_); P.a = ld8_agent(Ab + o_); P.w = ld8_agent(W16 + o_); } while (0)
#define S_PREP1(P, buf, TT, BIDX) do { \
        LAS unsigned char* b_ = lds + (buf) * SC_BUF; \
        const f32x4 r4 = {bflo(P.r[0]), bfhi(P.r[0]), bflo(P.r[1]), bfhi(P.r[1])}; \
        const f32x4 k4 = {bflo(P.k[0]), bfhi(P.k[0]), bflo(P.k[1]), bfhi(P.k[1])}; \
        const f32x4 v4 = {bflo(P.v[0]), bfhi(P.v[0]), bflo(P.v[1]), bfhi(P.v[1])}; \
        const f32x4 a4 = {bflo(P.a[0]), bfhi(P.a[0]), bflo(P.a[1]), bfhi(P.a[1])}; \
        const unsigned wx_ = P.w[0], wy_ = P.w[1]; \
        const pg8::f16x2 wlo_ = __builtin_bit_cast(pg8::f16x2, wx_); const pg8::f16x2 whi_ = __builtin_bit_cast(pg8::f16x2, wy_); \
        const f32x4 w4 = {__expf((float)wlo_.x), __expf((float)wlo_.y), __expf((float)whi_.x), __expf((float)whi_.y)}; \
        f32x4 kk = k4 * kk4; float ss = (kk.x * kk.x + kk.y * kk.y) + (kk.z * kk.z + kk.w * kk.w); \
        ss += __shfl_xor(ss, 1); ss += __shfl_xor(ss, 2); ss += __shfl_xor(ss, 4); ss += __shfl_xor(ss, 8); \
        kk = kk * fminf(__builtin_amdgcn_rsqf(ss), 1e12f); \
        const f32x4 km = k4 * (1.f + (a4 - 1.f) * ka4); \
        float bo = (r4.x * km.x * rk4.x + r4.y * km.y * rk4.y) + (r4.z * km.z * rk4.z + r4.w * km.w * rk4.w); \
        bo += __shfl_xor(bo, 1); bo += __shfl_xor(bo, 2); bo += __shfl_xor(bo, 4); bo += __shfl_xor(bo, 8); \
        const int eo_ = ((TT) * 64 + pj0) * 4; \
        *(LAS f32x4*)(b_ + 0 * SC_VEC + eo_) = r4; *(LAS f32x4*)(b_ + 1 * SC_VEC + eo_) = w4; *(LAS f32x4*)(b_ + 2 * SC_VEC + eo_) = km; \
        *(LAS f32x4*)(b_ + 3 * SC_VEC + eo_) = -kk; *(LAS f32x4*)(b_ + 4 * SC_VEC + eo_) = kk * a4; *(LAS f32x4*)(b_ + 5 * SC_VEC + eo_) = v4; \
        if ((ht & 15) == 0) *(LAS float*)(lds + SC_BON + (BIDX) * 128 + (TT) * 4) = bo; } while (0)
        S_LOAD1(pr, 0, ptt); S_LOAD1(pq, 0, ptt + 16); S_PREP1(pr, 0, ptt, 0); S_PREP1(pq, 0, ptt + 16, 0);
        __syncthreads();
        for (int c = 0; c <= NC; ++c) {
            if (c + 1 < NC) { S_LOAD1(pr, c + 1, ptt); S_LOAD1(pq, c + 1, ptt + 16); }
            if (c >= 1) {
                const int cp = c - 1;
                const LAS float* ybuf = (const LAS float*)(lds + SC_Y + (cp & 1) * SC_YB);
#pragma unroll
                for (int q = 0; q < SC_T / 4; ++q) {
                    const int tt = hw + 4 * q;
                    const float y = ybuf[tt * 64 + lane];
                    const float mean = wave_sum_dpp(y) * (1.f / 64.f); const float dy = y - mean;
                    const float var = wave_sum_dpp(dy * dy) * (1.f / 64.f);
                    const float yn = dy * __builtin_amdgcn_rsqf(var + 64e-5f) * lnw + lnb;
                    const size_t o_ = (tok0 + (size_t)cp * SC_T + tt) * DM + col;
                    const float bo = *(const LAS float*)(lds + SC_BON + (cp % 3) * 128 + tt * 4), vv = bf2f(ld2_agent(Vb + o_));
                    const float gt = bf2f(ld2_agent(Gb + o_));
                    const float outv = (yn + bo * vv) * gt;
                    Z[o_] = (bf16)(pkbf(outv, outv) & 0xffffu);
                }
            }
            if (c + 1 < NC) { const int bi_ = (c + 1) % 3; S_PREP1(pr, (c + 1) & 1, ptt, bi_); S_PREP1(pq, (c + 1) & 1, ptt + 16, bi_); }
            __syncthreads();
        }
#undef S_LOAD1
#undef S_PREP1
    } else {
        const int sq = lane & 7, si0 = 16 * wid + 2 * (lane >> 3), sj = 8 * sq;
        const bool odd = (sq & 1) != 0;
        f32x4 S0a = {0.f, 0.f, 0.f, 0.f}, S0b = S0a, S1a = S0a, S1b = S0a;
        __syncthreads();
        for (int c = 0; c <= NC; ++c) {
            if (c < NC) {
                const LAS unsigned char* bb = lds + (c & 1) * SC_BUF;
                LAS float* ybuf = (LAS float*)(lds + SC_Y + (c & 1) * SC_YB);
                const LAS unsigned char* vp_ = bb + sj * 4;
                const LAS unsigned char* vv_ = bb + 5 * SC_VEC + si0 * 4;
#define LD8(dstA, dstB, slot, TT) dstA = *(const LAS f32x4*)(vp_ + (slot) * SC_VEC + (TT) * 256); dstB = *(const LAS f32x4*)(vp_ + (slot) * SC_VEC + (TT) * 256 + 16)
                f32x4 rA, rB, wA, wB, kA, kB, aA, aB, bA, bB; f32x2 v2;
                LD8(rA, rB, 0, 0); LD8(wA, wB, 1, 0); LD8(kA, kB, 2, 0); LD8(aA, aB, 3, 0); LD8(bA, bB, 4, 0); v2 = *(const LAS f32x2*)(vv_);
#pragma unroll 2
                for (int tt = 0; tt < SC_T; ++tt) {
                    const int tn = (tt + 1) & (SC_T - 1);
                    f32x4 nrA, nrB, nwA, nwB, nkA, nkB, naA, naB, nbA, nbB;
                    LD8(nrA, nrB, 0, tn); LD8(nwA, nwB, 1, tn); LD8(nkA, nkB, 2, tn); LD8(naA, naB, 3, tn); LD8(nbA, nbB, 4, tn);
                    const f32x2 nv2 = *(const LAS f32x2*)(vv_ + tn * 256);
                    const float sx = red8x2(dot8(S0a, S0b, aA, aB), dot8(S1a, S1b, aA, aB), odd);
                    const float sa0 = __int_as_float(__builtin_amdgcn_update_dpp(0, __float_as_int(sx), 0x00, 0xf, 0xf, true));
                    const float sa1 = __int_as_float(__builtin_amdgcn_update_dpp(0, __float_as_int(sx), 0x55, 0xf, 0xf, true));
                    S0a = S0a * wA + (bA * sa0 + kA * v2.x); S0b = S0b * wB + (bB * sa0 + kB * v2.x);
                    S1a = S1a * wA + (bA * sa1 + kA * v2.y); S1b = S1b * wB + (bB * sa1 + kB * v2.y);
                    const float yx = red8x2(dot8(S0a, S0b, rA, rB), dot8(S1a, S1b, rA, rB), odd);
                    if (sq < 2) ybuf[tt * 64 + si0 + sq] = yx;
                    rA = nrA; rB = nrB; wA = nwA; wB = nwB; kA = nkA; kB = nkB; aA = naA; aB = naB; bA = nbA; bB = nbB; v2 = nv2;
                }
#undef LD8
            }
            __syncthreads();
        }
    }
    __syncthreads();
}

#ifdef DBG_CHECK
__device__ __forceinline__ unsigned hsh(unsigned x) { x ^= x >> 16; x *= 0x7feb352dU; x ^= x >> 15; x *= 0x846ca68bU; x ^= x >> 16; return x; }
__device__ __forceinline__ float dotcol(const bf16* arow, const float* W, int N, int c, int K, int lane) {
    float s = 0.f; for (int k = lane; k < K; k += 64) s += bf2f(arow[k]) * W[(size_t)k * N + c]; return wave_sum(s);
}
#define ERR_ACC(ref, fast) do { const float r_ = (ref), f_ = (fast); d2 += (r_ - f_) * (r_ - f_); r2 += r_ * r_; } while (0)
#define ERR_DONE(stage) do { d2 = wave_sum(d2); r2 = wave_sum(r2); if (lane == 0) CTLp[16 + (stage)] = sqrtf(d2 / fmaxf(r2, 1e-30f)); } while (0)
__device__ __forceinline__ void dbg_check(int ph, const Args* Ap, LAS unsigned char* lds, int lane) {
    asm volatile("" : "+s"(Ap)); const Args& A = *Ap; unsigned char* ws = A.ws; float* CTLp = (float*)(ws + WS_CTL);
    const bf16* HN = (const bf16*)(ws + WS_HN); const bf16* QKV = (const bf16*)(ws + WS_QKV); const bf16* ATT = (const bf16*)(ws + WS_ATT); const bf16* U = (const bf16*)(ws + WS_U);
    const bf16* X6 = (const bf16*)(ws + WS_X6); const bf16* TT = (const bf16*)(ws + WS_T); const bf16* RKV = (const bf16*)(ws + WS_RKV); const bf16* WAG = (const bf16*)(ws + WS_WAG); const bf16* Z = (const bf16*)(ws + WS_Z);
    const float* H = A.out; LAS float* sl = (LAS float*)lds;
    float d2 = 0.f, r2 = 0.f;
    if (ph == 1) {
        for (int smp = 0; smp < 48; ++smp) {
            const int t = hsh(smp) & 65535; int c = hsh(smp + 1000) % 3072; if (smp % 3 == 0) c = (c & ~63) | (hsh(smp + 7) & 15);
            const int sec = c / 512, hc = c & 63; const bf16* ar = HN + (size_t)t * DM;
            float v = dotcol(ar, A.attn_w_in, 3072, c, 1024, lane);
            if (sec != 2 && sec != 5 && hc < 16) { const float vp = dotcol(ar, A.attn_w_in, 3072, c ^ 8, 1024, lane); const float ang = (float)(t & 4095) * powf(500000.f, -(float)(hc & 7) / 8.f);
                v = (hc < 8) ? v * cosf(ang) - vp * sinf(ang) : v * cosf(ang) + vp * sinf(ang); }
            if (sec == 0 || sec == 3) v *= 0.125f * 1.4426950408889634f;
            if (lane == 0) ERR_ACC(v, bf2f(QKV[(size_t)t * QKVC + c]));
        }
        ERR_DONE(1);
    }
    if (ph == 2) {
        const float lam = CTLp[0];
        for (int smp = 0; smp < 7; ++smp) {
            int q = 0; if (smp == 1) q = 63; if (smp == 2) q = 64; if (smp == 3) q = 127; if (smp == 4) q = 128; if (smp == 5) q = 1000; if (smp == 6) q = 4095;
            const int b = hsh(smp + 50) & 15, h = hsh(smp + 60) & 3; const size_t tok0 = (size_t)b * SEQ;
            float mc[2], lc[2];
            for (int c = 0; c < 2; ++c) {
                const bf16* qp = QKV + (tok0 + q) * QKVC + 1536 + h * 128 + c * 64; float m = -INFINITY;
                for (int k = lane; k <= q; k += 64) { const bf16* kp = QKV + (tok0 + k) * QKVC + 2048 + h * 128 + c * 64; float s = 0.f; for (int d = 0; d < 64; ++d) s += bf2f(qp[d]) * bf2f(kp[d]); sl[c * 4096 + k] = s; m = fmaxf(m, s); }
#pragma unroll
                for (int o = 1; o < 64; o <<= 1) m = fmaxf(m, __shfl_xor(m, o));
                float l = 0.f; for (int k = lane; k <= q; k += 64) l += exp2f(sl[c * 4096 + k] - m);
                mc[c] = m; lc[c] = wave_sum(l);
            }
            asm volatile("s_waitcnt lgkmcnt(0)" ::: "memory");
            float o0 = 0.f, o1 = 0.f;
            for (int k = 0; k <= q; ++k) { const float a = exp2f(sl[k] - mc[0]) / lc[0] - lam * exp2f(sl[4096 + k] - mc[1]) / lc[1]; const bf16* vp = QKV + (tok0 + k) * QKVC + 2560 + h * 128; o0 += a * bf2f(vp[lane]); o1 += a * bf2f(vp[64 + lane]); }
            const float ss = wave_sum(o0 * o0 + o1 * o1), rs = 0.8f / sqrtf(ss / 128.f + 1e-5f);
            const bf16* ap = ATT + (tok0 + q) * DM + 512 + h * 128;
            ERR_ACC(o0 * rs * A.diff_subln[lane], bf2f(ap[lane])); ERR_ACC(o1 * rs * A.diff_subln[64 + lane], bf2f(ap[64 + lane]));
        }
        ERR_DONE(2);
    }
    if (ph == 3) {
        for (int smp = 0; smp < 10; ++smp) {
            int t = 0; if (smp == 1) t = 1; if (smp == 2) t = 127; if (smp == 3) t = 128; if (smp == 4) t = 129; if (smp == 5) t = 515; if (smp == 6) t = 2047; if (smp == 7) t = 2048; if (smp == 8) t = 4095; if (smp == 9) t = 3001;
            const int b = hsh(smp + 150) & 15, h = hsh(smp + 160) & 7; const size_t tok0 = (size_t)b * SEQ;
            const bf16* qp = QKV + (tok0 + t) * QKVC + h * 64; float m = -INFINITY;
            for (int e = lane; e < 387; e += 64) { const int pat = e / 129, mm = e % 129, dil = (pat == 0) ? 1 : ((pat == 1) ? 4 : 16), pos = t - mm * dil; float s = -INFINITY;
                if (pos >= 0) { const bf16* kp = QKV + (tok0 + pos) * QKVC + 512 + h * 64; s = 0.f; for (int d = 0; d < 64; ++d) s += bf2f(qp[d]) * bf2f(kp[d]); }
                sl[e] = s; m = fmaxf(m, s); }
#pragma unroll
            for (int o = 1; o < 64; o <<= 1) m = fmaxf(m, __shfl_xor(m, o));
            float l = 0.f; for (int e = lane; e < 387; e += 64) l += exp2f(sl[e] - m);
            l = wave_sum(l);
            asm volatile("s_waitcnt lgkmcnt(0)" ::: "memory");
            float o = 0.f;
            for (int e = 0; e < 387; ++e) { const int pat = e / 129, mm = e % 129, dil = (pat == 0) ? 1 : ((pat == 1) ? 4 : 16), pos = t - mm * dil; if (pos >= 0) o += exp2f(sl[e] - m) / l * bf2f(QKV[(tok0 + pos) * QKVC + 1024 + h * 64 + lane]); }
            ERR_ACC(o, bf2f(ATT[(tok0 + t) * DM + h * 64 + lane]));
        }
        ERR_DONE(3);
    }
    if (ph == 4) {
        for (int smp = 0; smp < 32; ++smp) { const int t = hsh(smp + 300) & 65535, c = hsh(smp + 400) & 1023;
            const float v = A.x[(size_t)t * DM + c] + dotcol(ATT + (size_t)t * DM, A.attn_w_out, 1024, c, 1024, lane); if (lane == 0) ERR_ACC(v, H[(size_t)t * DM + c]); }
        ERR_DONE(4);
    }
    if (ph == 6) {
        for (int smp = 0; smp < 32; ++smp) { const int t = hsh(smp + 500) & 65535, c = hsh(smp + 600) & 4095;
            float v = fmaxf(dotcol(HN + (size_t)t * DM, A.mlp_w1, 4096, c, 1024, lane), 0.f); v *= v; if (lane == 0) ERR_ACC(v, bf2f(U[(size_t)t * DFF + c])); }
        ERR_DONE(6);
    }
    if (ph == 8) {
        for (int smp = 0; smp < 12; ++smp) { int t = hsh(smp + 700) & 65535; if (smp == 0) t = 4096; if (smp == 1) t = 4095; if (smp == 2) t = 32; const int slot = smp % 6, mi = (slot == 1) ? 2 : ((slot == 2) ? 3 : ((slot == 3) ? 1 : slot));
            float s0 = 0.f, s1 = 0.f; const bool hp = (t & 4095) != 0;
            for (int k = lane; k < 1024; k += 64) { const float a = H[(size_t)t * DM + k]; s0 += a * a; if (hp) { const float p = H[(size_t)(t - 1) * DM + k]; s1 += p * p; } }
            const float r0 = 1.f / sqrtf(wave_sum(s0) / 1024.f + 1e-5f), r1 = 1.f / sqrtf(wave_sum(s1) / 1024.f + 1e-5f);
            for (int k = lane; k < 1024; k += 64) { const float g = A.norm_mix[DM + k]; const float hn = H[(size_t)t * DM + k] * r0 * g, hpv = hp ? H[(size_t)(t - 1) * DM + k] * r1 * g : 0.f;
                ERR_ACC(hn + (hpv - hn) * A.rwkv_mu[mi * DM + k], bf2f(X6[(size_t)slot * NTOK * DM + (size_t)t * DM + k])); } }
        ERR_DONE(8);
    }
    if (ph == 9) {
        for (int smp = 0; smp < 30; ++smp) { const int t = hsh(smp + 800) & 65535, wh = smp % 3, nn = (wh == 2) ? 160 : 64, c = hsh(smp + 900) % nn;
            const float* W = (wh == 0) ? A.rwkv_w1 : ((wh == 1) ? A.rwkv_a1 : A.rwkv_g1);
            float v = dotcol(X6 + (size_t)(3 + wh) * NTOK * DM + (size_t)t * DM, W, nn, c, 1024, lane); if (wh == 0) v = tanhf(v); if (wh == 2) v = 1.f / (1.f + expf(-v));
            if (lane == 0) ERR_ACC(v, bf2f(TT[(size_t)wh * NTOK * 256 + (size_t)t * 256 + c])); }
        ERR_DONE(9);
    }
    if (ph == 10) {
        for (int smp = 0; smp < 30; ++smp) { const int t = hsh(smp + 1100) & 65535, wh = smp % 3, c = hsh(smp + 1200) & 1023;
            const float* W = (wh == 0) ? A.rwkv_w_r : ((wh == 1) ? A.rwkv_w_k : A.rwkv_w_v);
            const float v = dotcol(X6 + (size_t)wh * NTOK * DM + (size_t)t * DM, W, 1024, c, 1024, lane); if (lane == 0) ERR_ACC(v, bf2f(RKV[(size_t)wh * NTOK * DM + (size_t)t * DM + c])); }
        ERR_DONE(10);
    }
    if (ph == 11) {
        for (int smp = 0; smp < 30; ++smp) { const int t = hsh(smp + 1300) & 65535, wh = smp % 3, kk = (wh == 2) ? 160 : 64, c = hsh(smp + 1400) & 1023;
            const float* W = (wh == 0) ? A.rwkv_w2 : ((wh == 1) ? A.rwkv_a2 : A.rwkv_g2);
            float v = dotcol(TT + (size_t)wh * NTOK * 256 + (size_t)t * 256, W, 1024, c, kk, lane); float f;
            const unsigned short raw = WAG[(size_t)wh * NTOK * DM + (size_t)t * DM + c];
            if (wh == 0) { const float z = A.rwkv_w0[c] + v; const float sp = fmaxf(-z, 0.f) + log1pf(expf(-fabsf(z))); v = -expf(-sp - 0.5f); f = (float)__builtin_bit_cast(_Float16, raw); }
            else if (wh == 1) { v = 1.f / (1.f + expf(-(A.rwkv_a0[c] + v))); f = bf2f(raw); } else f = bf2f(raw);
            if (lane == 0) ERR_ACC(v, f); }
        ERR_DONE(11);
    }
    if (ph == 12) {
        float ed[5] = {0.f, 0.f, 0.f, 0.f, 0.f}, er[5] = {0.f, 0.f, 0.f, 0.f, 0.f};
#pragma unroll
        for (int smp = 0; smp < 3; ++smp) {
            const int b = 0, h = smp; const size_t tok0 = (size_t)b * SEQ; const int col = h * 64 + lane;
            LAS float* sv = sl + 4096;
            for (int i = 0; i < 64; ++i) sl[i * 64 + lane] = 0.f;
            for (int t = 0; t < 40; ++t) {
                const size_t o = (tok0 + t) * DM + col;
                const float r = bf2f(RKV[o]), k = bf2f(RKV[(size_t)NTOK * DM + o]), v = bf2f(RKV[2 * (size_t)NTOK * DM + o]);
                const float w = expf((float)__builtin_bit_cast(_Float16, (unsigned short)WAG[o])), a = bf2f(WAG[(size_t)NTOK * DM + o]);
                float kk = k * A.rwkv_k_k[col]; kk = kk / fmaxf(sqrtf(wave_sum(kk * kk)), 1e-12f);
                const float km = k * (1.f + (a - 1.f) * A.rwkv_k_a[col]);
                float yl = 0.f;
                sv[lane] = v; asm volatile("s_waitcnt lgkmcnt(0)" ::: "memory");
#pragma unroll 1
                for (int i = 0; i < 64; ++i) { float st = sl[i * 64 + lane]; const float sa = wave_sum(st * (-kk)); st = st * w + sa * (kk * a) + sv[i] * km; sl[i * 64 + lane] = st; const float y = wave_sum(st * r); if (lane == i) yl = sa; }
                const float bonus = wave_sum(r * km * A.rwkv_r_k[col]);
                const float f_ = bf2f(Z[o]);
                if (smp == 0) { const float dd = (yl - f_) * (yl - f_), rr = yl * yl; if (t == 1) { ed[0] += 36.f * dd; er[0] += rr; } if (t == 2) { ed[3] += 36.f * dd; er[3] += rr; } if (t < 32) { ed[4] += dd; er[4] += rr; } }
                if (smp == 1) { ed[1] += (1.f - w - f_) * (1.f - w - f_); er[1] += (1.f - w) * (1.f - w); }
                if (smp == 2) { ed[2] += (kk * a - f_) * (kk * a - f_); er[2] += kk * a * kk * a; }
            }
        }
#pragma unroll
        for (int q = 0; q < 5; ++q) { d2 = ed[q]; r2 = er[q]; ERR_DONE(12 + q); }
    }
    if (ph == 13) {
    }
}
#endif
#define AS4 __attribute__((address_space(4)))
__device__ __forceinline__ const unsigned char AS4* kargs() { const unsigned char AS4* p = (const unsigned char AS4*)__builtin_amdgcn_kernarg_segment_ptr(); asm volatile("" : "+s"(p)); return p; }
#define KA(member) (*(decltype(Args::member) const AS4*)(kargs() + offsetof(Args, member)))
#define WSB(off) ((bf16*)(KA(ws) + (off)))
#define P_W_IN WSB(WS_WIN)
#define P_W_OUT WSB(WS_WOUT)
#define P_W1_0 WSB(WS_W1_0)
#define P_W2_0 WSB(WS_W2_0)
#define P_W1_1 WSB(WS_W1_1)
#define P_W2_1 WSB(WS_W2_1)
#define P_WR WSB(WS_WR)
#define P_WK WSB(WS_WK)
#define P_WV WSB(WS_WV)
#define P_WO WSB(WS_WO)
#define P_LW1 WSB(WS_LW1)
#define P_LA1 WSB(WS_LA1)
#define P_LG1 WSB(WS_LG1)
#define P_LW2 WSB(WS_LW2)
#define P_LA2 WSB(WS_LA2)
#define P_LG2 WSB(WS_LG2)
#define P_HN WSB(WS_HN)
#define P_QKV WSB(WS_QKV)
#define P_ATT WSB(WS_ATT)
#define P_OAP WSB(WS_OAP)
#define P_U WSB(WS_U)
#define P_X6 WSB(WS_X6)
#define P_TT WSB(WS_T)
#define P_RKV WSB(WS_RKV)
#define P_WAG WSB(WS_WAG)
#define P_Z WSB(WS_Z)
#define P_ROPE ((float*)(KA(ws) + WS_ROPE))
#define P_CTL ((float*)(KA(ws) + WS_CTL))
#define P_LSE ((float*)(KA(ws) + WS_LSE))
#define P_H (KA(out))
__global__ void __launch_bounds__(NTHR, 2) hybrid_fwd(Args A_unused) {
    extern __shared__ __attribute__((aligned(16))) unsigned char lds_raw[];
    LAS unsigned char* lds = (LAS unsigned char*)lds_raw;
    cg::grid_group grid = cg::this_grid();
    { int t0_ = threadIdx.x; asm volatile("" : "+v"(t0_)); if (t0_ < 2) ((LAS unsigned*)(lds + LDS_BARST))[t0_] = 0u; }
    __syncthreads();
    (void)xcd_barrier_post((unsigned*)(KA(ws) + WS_BAR), (volatile LAS unsigned*)(lds + LDS_BARST));
    const int G = gridDim.x, bx = blockIdx.x, ngw = G * NWAVES, ngt = G * NTHR;
#define TIDV int tid = threadIdx.x; asm volatile("" : "+v"(tid)); const int lane = tid & 63, wave = __builtin_amdgcn_readfirstlane(tid >> 6), gw = bx * NWAVES + wave, gt = bx * NTHR + tid; (void)lane; (void)gw; (void)gt;
    constexpr int lo = 0, hi = 18;
    int ph = 0;
#define PHASE_BEGIN if (ph >= lo && ph < hi) { TIDV
#ifdef DBG_CHECK
#define PHASE_END   } grid.sync(); { int t2_ = threadIdx.x; asm volatile("" : "+v"(t2_)); if (bx == 0 && t2_ < 64) dbg_check(ph, (const Args*)(const void*)__builtin_amdgcn_kernarg_segment_ptr(), lds, t2_); } grid.sync(); ++ph;
#else
#define PHASE_END   if (ph + 1 < hi) { if (ph == 0) grid.sync(); else { XcdBarrier xb_; xb_.bar = (unsigned*)(KA(ws) + WS_BAR); xb_.x = xb_xcc_id(); xb_.st = (volatile LAS unsigned*)(lds + LDS_BARST); xcd_barrier(xb_); } } } ++ph;
#endif
#define GEMM(EPI, Aptr, Bptr, N_, K_, ...) do { pg8::Gemm g_{(const pg8::bf16_t*)(Aptr), (const pg8::bf16_t*)(Bptr), NTOK, (N_), (K_)}; pg8::StaticOrder S_; S_.init(NTOK, (N_), G, bx); \
        EPI E_{__VA_ARGS__}; pg8::gemm_phase<EPI, pg8::StaticOrder, true, true>(lds, g_, S_, E_); } while (0)

    PHASE_BEGIN
    {
        LAS float* scr = (LAS float*)(lds + wave * 8192);
        int it0 = gw;
#define TJOB(W, K_, N_, WT, PITCH) { const int ni_ = ((K_) / 32) * ((N_) / 32); for (; it0 < ni_; it0 += ngw) transpose_item((W), (N_), (WT), (PITCH), scr, it0, lane); it0 -= ni_; }
        TJOB(KA(attn_w_in), 1024, 3072, P_W_IN, 1024)
        TJOB(KA(attn_w_out), 1024, 1024, P_W_OUT, 1024)
        TJOB(KA(mlp_w1), 1024, 4096, P_W1_0, 1024)
        TJOB(KA(mlp_w1) + (size_t)1024 * 4096, 1024, 4096, P_W1_1, 1024)
        TJOB(KA(mlp_w2), 4096, 1024, P_W2_0, 4096)
        TJOB(KA(mlp_w2) + (size_t)4096 * 1024, 4096, 1024, P_W2_1, 4096)
        TJOB(KA(rwkv_w_r), 1024, 1024, P_WR, 1024)
        TJOB(KA(rwkv_w_k), 1024, 1024, P_WK, 1024)
        TJOB(KA(rwkv_w_v), 1024, 1024, P_WV, 1024)
        TJOB(KA(rwkv_w_o), 1024, 1024, P_WO, 1024)
        TJOB(KA(rwkv_w1), 1024, 64, P_LW1, 1024)
        TJOB(KA(rwkv_a1), 1024, 64, P_LA1, 1024)
        TJOB(KA(rwkv_g1), 1024, 160, P_LG1, 1024)
        TJOB(KA(rwkv_w2), 64, 1024, P_LW2, 256)
        TJOB(KA(rwkv_a2), 64, 1024, P_LA2, 256)
        TJOB(KA(rwkv_g2), 160, 1024, P_LG2, 256)
#undef TJOB
        zero_region(P_LW1, 1024, 64, 256, 0, 1024, gt, ngt); zero_region(P_LA1, 1024, 64, 256, 0, 1024, gt, ngt); zero_region(P_LG1, 1024, 160, 256, 0, 1024, gt, ngt);
        zero_region(P_LW2, 256, 0, 1024, 64, 256, gt, ngt); zero_region(P_LA2, 256, 0, 1024, 64, 256, gt, ngt); zero_region(P_LG2, 256, 0, 1024, 160, 256, gt, ngt);
        for (int i = gt; i < 4096 * 8; i += ngt) {
            const int pos = i >> 3, f = i & 7;
            const float invf = (float)exp(-(double)f * 0.125 * log(500000.0));
            const float ang = (float)pos * invf;
            P_ROPE[pos * 16 + f] = (float)cos((double)ang); P_ROPE[pos * 16 + 8 + f] = (float)sin((double)ang);
        }
        if (bx == 0 && wave == 0) {
            const float* lp = KA(diff_lambda);
            const float s01 = wave_sum(lp[lane] * lp[64 + lane]), s23 = wave_sum(lp[128 + lane] * lp[192 + lane]);
            if (lane == 0) P_CTL[0] = expf(s01) - expf(s23) + 0.2f;
        }
        rms_phase_bf16(KA(x), KA(norm_mix), P_HN, gw, ngw, lane);
    }
    PHASE_END
    PHASE_BEGIN
    GEMM(pg8::Epi16<pg8::M_QKV>, P_HN, P_W_IN, QKVC, 1024, P_QKV, QKVC, P_ROPE);
    PHASE_END
    PHASE_BEGIN
    {
        const float lam = P_CTL[0];
        for (int rep_ = 0; rep_ < REP_ATTN; ++rep_)
        for (int u = bx; u < 2048; u += G) {
            const int i = u >> 8, cidx = u & 255, bh = cidx >> 2, s = (cidx & 3) * 4 + (i >> 1), qb = (i & 1) ? 31 - s : s;
            diffattn_unit(P_QKV, P_ATT, KA(diff_subln), lam, bh >> 2, bh & 3, qb, lds);
        }
        for (int rep_ = 0; rep_ < REP_ATTNA; ++rep_)
        for (int v = bx; v < 6144; v += G) {
            const int bh = v / 48, r48 = v - bh * 48, pat = r48 >> 4, q16 = r48 & 15;
            const int dil = (pat == 0) ? 1 : ((pat == 1) ? 4 : 16);
            const int nper = 16 / dil;
            const int res = q16 / nper, n = q16 - res * nper;
            dilattn_unit(P_QKV, P_OAP, P_LSE, bh >> 3, bh & 7, dil, res, n, lds);
        }
    }
    PHASE_END
    PHASE_BEGIN
    combine_phase(P_OAP, P_LSE, P_ATT, gt, ngt);
    PHASE_END
    PHASE_BEGIN
    GEMM(pg8::EpiRes, P_ATT, P_W_OUT, 1024, 1024, KA(x), P_H, DM);
    PHASE_END
    PHASE_BEGIN
    for (int rep_ = 0; rep_ < REP_RMS; ++rep_)
    rms_phase_bf16(P_H, KA(norm_mlp), P_HN, gw, ngw, lane);
    PHASE_END
    PHASE_BEGIN
    for (int rep_ = 0; rep_ < REP_UP; ++rep_)
    GEMM(pg8::Epi16<pg8::M_RELU2>, P_HN, P_W1_0, DFF, 1024, P_U, DFF, nullptr);
    PHASE_END
    PHASE_BEGIN
    GEMM(pg8::EpiRes, P_U, P_W2_0, 1024, DFF, P_H, P_H, DM);
    PHASE_END
    PHASE_BEGIN
    for (int rep_ = 0; rep_ < REP_XMIX; ++rep_)
    xmix_phase(P_H, KA(norm_mix) + DM, KA(rwkv_mu), P_X6, gw, ngw, lane);
    PHASE_END
    PHASE_BEGIN
    for (int rep_ = 0; rep_ < REP_LORA; ++rep_) {
    GEMM(pg8::Epi16<pg8::M_TANH>, P_X6 + 3 * (size_t)NTOK * DM, P_LW1, 256, 1024, P_TT, 256, nullptr);
    GEMM(pg8::Epi16<pg8::M_PLAIN>, P_X6 + 4 * (size_t)NTOK * DM, P_LA1, 256, 1024, P_TT + (size_t)NTOK * 256, 256, nullptr);
    GEMM(pg8::Epi16<pg8::M_SIGMOID>, P_X6 + 5 * (size_t)NTOK * DM, P_LG1, 256, 1024, P_TT + (size_t)2 * NTOK * 256, 256, nullptr); }
    PHASE_END
    PHASE_BEGIN
    GEMM(pg8::Epi16<pg8::M_PLAIN>, P_X6, P_WR, 1024, 1024, P_RKV, DM, nullptr);
    GEMM(pg8::Epi16<pg8::M_PLAIN>, P_X6 + (size_t)NTOK * DM, P_WK, 1024, 1024, P_RKV + (size_t)NTOK * DM, DM, nullptr);
    GEMM(pg8::Epi16<pg8::M_PLAIN>, P_X6 + 2 * (size_t)NTOK * DM, P_WV, 1024, 1024, P_RKV + 2 * (size_t)NTOK * DM, DM, nullptr);
    PHASE_END
    PHASE_BEGIN
    for (int rep_ = 0; rep_ < REP_LORA; ++rep_) {
    GEMM(pg8::Epi16<pg8::M_WLOG>, P_TT, P_LW2, 1024, 256, P_WAG, DM, KA(rwkv_w0));
    GEMM(pg8::Epi16<pg8::M_ASIG>, P_TT + (size_t)NTOK * 256, P_LA2, 1024, 256, P_WAG + (size_t)NTOK * DM, DM, KA(rwkv_a0));
    GEMM(pg8::Epi16<pg8::M_PLAIN>, P_TT + (size_t)2 * NTOK * 256, P_LG2, 1024, 256, P_WAG + 2 * (size_t)NTOK * DM, DM, nullptr); }
    PHASE_END
    PHASE_BEGIN
    for (int rep_ = 0; rep_ < REP_SCAN; ++rep_)
    for (int u = bx; u < 256; u += G)
        scan_unit(P_RKV, P_RKV + (size_t)NTOK * DM, P_RKV + 2 * (size_t)NTOK * DM, (const unsigned short*)P_WAG, P_WAG + (size_t)NTOK * DM, P_WAG + 2 * (size_t)NTOK * DM,
                  KA(rwkv_k_k), KA(rwkv_k_a), KA(rwkv_r_k), KA(rwkv_ln_w), KA(rwkv_ln_b), P_Z, u >> 4, u & 15, lds);
    PHASE_END
    PHASE_BEGIN
    GEMM(pg8::EpiRes, P_Z, P_WO, 1024, 1024, P_H, P_H, DM);
    PHASE_END
    PHASE_BEGIN
    rms_phase_bf16(P_H, KA(norm_mlp) + DM, P_HN, gw, ngw, lane);
    PHASE_END
    PHASE_BEGIN
    GEMM(pg8::Epi16<pg8::M_RELU2>, P_HN, P_W1_1, DFF, 1024, P_U, DFF, nullptr);
    PHASE_END
    PHASE_BEGIN
    GEMM(pg8::EpiRes, P_U, P_W2_1, 1024, DFF, P_H, P_H, DM);
    PHASE_END
    PHASE_BEGIN
    rms_phase_f32(P_H, KA(norm_final), P_H, gw, ngw, lane);
    PHASE_END
#ifdef DBG_CHECK
    { TIDV
      const float* CTLp = P_CTL; int bad = 0; float ev = 0.f;
      for (int k = 1; k < 20; ++k) { const float e = CTLp[16 + k]; if (bad == 0 && !(e < 0.03f)) { bad = k; ev = (e == e) ? e : 9.99f; } }
      if (bad) { float* o = P_H; const float c = sqrtf(10.f * (float)bad); for (size_t i = gt; i < (size_t)NTOK * DM; i += ngt) o[i] = c; if (gt == 0) o[0] = 1000.f * ev; } }
#endif
}
constexpr int N_PHASES = 18;

extern "C" void kernel_launch(void* const* d_in, const int* in_sizes, int n_in, void* d_out, int out_size, void* d_ws, size_t ws_size, hipStream_t stream) {
    static int grid = 0;
    if (grid == 0) {
        if (n_in != 28 || in_sizes[0] != NTOK * DM || out_size != NTOK * DM || ws_size < WS_END) { fprintf(stderr, "kernel_launch: unexpected shapes (n_in %d, ws %zu)\n", n_in, ws_size); grid = -1; return; }
        int dev = 0, cus = 0, per_cu = 0;
        hipGetDevice(&dev); hipDeviceGetAttribute(&cus, hipDeviceAttributeMultiprocessorCount, dev);
        if (hipFuncSetAttribute((const void*)hybrid_fwd, hipFuncAttributeMaxDynamicSharedMemorySize, LDS_BYTES) != hipSuccess) { fprintf(stderr, "kernel_launch: hipFuncSetAttribute failed\n"); grid = -1; return; }
        hipOccupancyMaxActiveBlocksPerMultiprocessor(&per_cu, (const void*)hybrid_fwd, NTHR, LDS_BYTES);
        (void)hipGetLastError();
        if (per_cu < 1) per_cu = 1;
        grid = cus * per_cu;
        fprintf(stderr, "kernel_launch: %d CUs x %d -> grid %d\n", cus, per_cu, grid);
    }
    if (grid < 0) return;
    if (hipMemsetAsync(d_ws, 0, CTL_ZERO_BYTES, stream) != hipSuccess) { fprintf(stderr, "kernel_launch: hipMemsetAsync failed\n"); return; }
    Args a{};
    const float** fp = (const float**)&a;
    for (int i = 0; i < 28; ++i) fp[i] = (const float*)d_in[i];
    a.out = (float*)d_out; a.ws = (unsigned char*)d_ws; a.ph_lo = 0; a.ph_hi = N_PHASES;
    void* args[] = {&a};
    hipError_t e = hipLaunchCooperativeKernel((const void*)hybrid_fwd, dim3(grid), dim3(NTHR), args, LDS_BYTES, stream);
    if (e != hipSuccess) fprintf(stderr, "cooperative launch failed: %s (grid %d)\n", hipGetErrorString(e), grid);
}
```

```cpp
#include <hip/hip_runtime.h>
#include <hip/hip_cooperative_groups.h>
#include <cstdio>
#include <cstdint>
namespace cg = cooperative_groups;
namespace pg8 {
#define PG8_LAS __attribute__((address_space(3)))
typedef unsigned short bf16_t;
typedef short bf16x8 __attribute__((ext_vector_type(8)));
typedef float f32x4 __attribute__((ext_vector_type(4)));
typedef unsigned u32x4 __attribute__((ext_vector_type(4)));
constexpr int BM = 256, BK = 64, HALF = 128, HTB = HALF * BK * 2  , STAGE_BYTES = 8 * HTB, NXCD = 8, WGM = 8;

__host__ __device__ __forceinline__ int lds_byte(int r, int c) { const int st = (r >> 4) * 2 + (c >> 5), rr = r & 15, cc = c & 31, ob = rr * 64 + cc * 2; return st * 1024 + (ob ^ (((ob >> 9) & 1) << 5)); }
__host__ __device__ __forceinline__ void stage_rc(int b, int& R, int& C) { const int st = b / 1024, sb = b % 1024, swz = sb ^ (((sb >> 9) & 1) << 5); R = (st >> 1) * 16 + swz / 64; C = (st & 1) * 32 + (swz % 64) / 2; }
__host__ __device__ __forceinline__ int perm32(int rho) { const int n = rho >> 4, i = rho & 15; return 8 * (i >> 2) + 4 * n + (i & 3); }

struct Unit { int pm, pn; };
struct Gemm { const bf16_t* A; const bf16_t* Bt; int M, N, K; };

struct StaticOrder {
    int nM, nN, nwg, G, c;
    __host__ __device__ void init(int M, int N, int G_, int c_) { nM = M / BM; nN = N / BM; nwg = nM * nN; G = G_; c = c_; }
    __host__ __device__ bool next(int i, Unit& u) const {
        const long L = (long)i * G + c; if (L >= nwg) return false;
        int wgid = (int)L; { const int q = nwg / NXCD, r = nwg % NXCD, xcd = wgid % NXCD, off = wgid / NXCD; wgid = (xcd < r ? xcd * (q + 1) : r * (q + 1) + (xcd - r) * q) + off; }
        const int nig = WGM * nN, gid = wgid / nig, fm = gid * WGM, gsz = (nM - fm) < WGM ? (nM - fm) : WGM;
        u.pm = fm + ((wgid % nig) % gsz); u.pn = (wgid % nig) / gsz; return true;
    }
    __device__ __forceinline__ void a_ready(const Unit&) const {}
    __device__ __forceinline__ void done(const Unit&) const {}
};

__device__ __forceinline__ unsigned cvt_pk_bf16(float lo, float hi) { unsigned r; asm volatile("v_cvt_pk_bf16_f32 %0, %1, %2" : "=v"(r) : "v"(lo), "v"(hi)); return r; }
typedef float f32x2 __attribute__((ext_vector_type(2)));
typedef unsigned u32x4 __attribute__((ext_vector_type(4)));
typedef _Float16 f16x2 __attribute__((ext_vector_type(2)));
__device__ __forceinline__ unsigned cvt_pk_f16(float lo, float hi) { f32x2 v = {lo, hi}; f16x2 h = __builtin_convertvector(v, f16x2); return __builtin_bit_cast(unsigned, h); }
enum { M_PLAIN = 0, M_RELU2 = 1, M_TANH = 2, M_SIGMOID = 3, M_QKV = 4, M_ASIG = 5, M_WLOG = 6 };
template <int MODE> struct Epi16 {
    static constexpr bool PERM = true, AFTER_DRAIN = false;
    bf16_t* O; int ldc; const float* vec;
    __device__ __forceinline__ void operator()(const f32x4 (&acc)[2][2][4][2], const Unit& u, int wr, int wc, int fr, int fq) const {
        const int row0 = u.pm * BM + wr * 64 + fr;
        const int col0 = u.pn * BM + wc * 32 + 8 * fq;
        const int sec = u.pn >> 1;
        const bool rope = (MODE == M_QKV) && (sec != 2) && (sec != 5);
        const bool rot_wave = rope && ((wc & 1) == 0);
        const float qs = (MODE == M_QKV && (sec == 0 || sec == 3)) ? (0.125f * 1.4426950408889634f) : 1.0f;
        f32x4 bias_[2][2];
        if (MODE == M_ASIG || MODE == M_WLOG) {
#pragma unroll
            for (int bj = 0; bj < 2; ++bj) { bias_[bj][0] = *(const f32x4*)(vec + col0 + bj * HALF); bias_[bj][1] = *(const f32x4*)(vec + col0 + bj * HALF + 4); }
        }
#pragma unroll
        for (int ai = 0; ai < 2; ++ai) {
            f32x4 tab[4][4];
            if (MODE == M_QKV) { if (rot_wave) {
#pragma unroll
                for (int m = 0; m < 4; ++m) { const float* t = vec + (size_t)((row0 + ai * HALF + m * 16) & 4095) * 16;
#pragma unroll
                    for (int q = 0; q < 4; ++q) tab[m][q] = *(const f32x4*)(t + 4 * q); } } }
#pragma unroll
            for (int m = 0; m < 4; ++m) {
                const int row = row0 + ai * HALF + m * 16;
                bf16_t* rowp = O + (size_t)row * ldc + col0;
                f32x4 cs0 = {1.f, 1.f, 1.f, 1.f}, cs1 = cs0, sn0 = {0.f, 0.f, 0.f, 0.f}, sn1 = sn0;
                if (MODE == M_QKV) { if (rot_wave) { cs0 = tab[m][0]; cs1 = tab[m][1]; sn0 = tab[m][2]; sn1 = tab[m][3]; } }
#pragma unroll
                for (int bj = 0; bj < 2; ++bj) {
                    f32x4 v0 = acc[ai][bj][m][0], v1 = acc[ai][bj][m][1];
                    if (MODE == M_QKV) {
                        if (rot_wave) {
                            f32x4 p0, p1;
#pragma unroll
                            for (int e = 0; e < 4; ++e) {
                                const unsigned b0_ = __float_as_uint(v0[e]), b1_ = __float_as_uint(v1[e]);
                                auto r0_ = __builtin_amdgcn_permlane16_swap(b0_, b0_, false, false); auto r1_ = __builtin_amdgcn_permlane16_swap(b1_, b1_, false, false);
                                p0[e] = __uint_as_float((fq & 1) ? r0_[0] : r0_[1]); p1[e] = __uint_as_float((fq & 1) ? r1_[0] : r1_[1]);
                            }
                            if (fq < 2) { const float sg = (fq == 0) ? -1.f : 1.f; v0 = v0 * cs0 + (p0 * sn0) * sg; v1 = v1 * cs1 + (p1 * sn1) * sg; }
                        }
                        v0 = v0 * qs; v1 = v1 * qs;
                    }
                    if (MODE == M_RELU2) {
#pragma unroll
                        for (int e = 0; e < 4; ++e) { const float a = fmaxf(v0[e], 0.f), b = fmaxf(v1[e], 0.f); v0[e] = a * a; v1[e] = b * b; }
                    }
                    if (MODE == M_TANH) {
#pragma unroll
                        for (int e = 0; e < 4; ++e) { v0[e] = 1.f - 2.f * __builtin_amdgcn_rcpf(1.f + __builtin_amdgcn_exp2f(fminf(v0[e] * 2.885390081777927f, 60.f))); v1[e] = 1.f - 2.f * __builtin_amdgcn_rcpf(1.f + __builtin_amdgcn_exp2f(fminf(v1[e] * 2.885390081777927f, 60.f))); }
                    }
                    if (MODE == M_SIGMOID) {
#pragma unroll
                        for (int e = 0; e < 4; ++e) { v0[e] = 1.f / (1.f + __expf(-v0[e])); v1[e] = 1.f / (1.f + __expf(-v1[e])); }
                    }
                    if (MODE == M_ASIG) {
                        const f32x4 b0 = bias_[bj][0], b1 = bias_[bj][1];
#pragma unroll
                        for (int e = 0; e < 4; ++e) { v0[e] = 1.f / (1.f + __expf(-(v0[e] + b0[e]))); v1[e] = 1.f / (1.f + __expf(-(v1[e] + b1[e]))); }
                    }
                    u32x4 w;
                    if (MODE == M_WLOG) {
                        const f32x4 b0 = bias_[bj][0], b1 = bias_[bj][1];
#pragma unroll
                        for (int e = 0; e < 4; ++e) {
                            const float x0 = -(v0[e] + b0[e]), x1 = -(v1[e] + b1[e]);
                            const float s0 = fmaxf(x0, 0.f) + 0.6931471805599453f * __builtin_amdgcn_logf(1.f + __builtin_amdgcn_exp2f(-1.4426950408889634f * fabsf(x0)));
                            const float s1 = fmaxf(x1, 0.f) + 0.6931471805599453f * __builtin_amdgcn_logf(1.f + __builtin_amdgcn_exp2f(-1.4426950408889634f * fabsf(x1)));
                            v0[e] = -__builtin_amdgcn_exp2f(-1.4426950408889634f * (s0 + 0.5f)); v1[e] = -__builtin_amdgcn_exp2f(-1.4426950408889634f * (s1 + 0.5f));
                        }
                        w.x = cvt_pk_f16(v0[0], v0[1]); w.y = cvt_pk_f16(v0[2], v0[3]); w.z = cvt_pk_f16(v1[0], v1[1]); w.w = cvt_pk_f16(v1[2], v1[3]);
                    } else {
                        w.x = cvt_pk_bf16(v0[0], v0[1]); w.y = cvt_pk_bf16(v0[2], v0[3]); w.z = cvt_pk_bf16(v1[0], v1[1]); w.w = cvt_pk_bf16(v1[2], v1[3]);
                    }
                    *(u32x4*)(rowp + bj * HALF) = w;
                }
            }
        }
    }
};
struct EpiRes {
    static constexpr bool PERM = false, AFTER_DRAIN = false;
    const float* res; float* out; int ldc;
    __device__ __forceinline__ void operator()(const f32x4 (&acc)[2][2][4][2], const Unit& u, int wr, int wc, int fr, int fq) const {
        const int row0 = u.pm * BM + wr * 64 + fr, col0 = u.pn * BM + wc * 32 + 4 * fq;
#pragma unroll
        for (int ai = 0; ai < 2; ++ai)
#pragma unroll
            for (int m = 0; m < 4; ++m) {
                const size_t off = (size_t)(row0 + ai * HALF + m * 16) * ldc + col0;
#pragma unroll
                for (int bj = 0; bj < 2; ++bj)
#pragma unroll
                    for (int n = 0; n < 2; ++n) { const f32x4 r = *(const f32x4*)(res + off + bj * HALF + n * 16); *(f32x4*)(out + off + bj * HALF + n * 16) = r + acc[ai][bj][m][n]; }
            }
    }
};
template <class Epi, class Sched, bool ALIGN_EPI = false, bool SP2 = false>
__device__ __forceinline__ void gemm_phase(PG8_LAS unsigned char* lds, const Gemm g, const Sched& S, const Epi& E) {
    int tid = threadIdx.x; asm volatile("" : "+v"(tid)); const int wid = __builtin_amdgcn_readfirstlane(tid >> 6), lane = tid & 63, wr = wid >> 2, wc = wid & 3, fr = lane & 15, fq = lane >> 4;
    const int K = g.K, nt = K / BK;
    unsigned voffA[2], voffB[2];
#pragma unroll
    for (int i = 0; i < 2; ++i) { int R, C; stage_rc(tid * 16 + i * 8192, R, C); const int Rb = Epi::PERM ? ((R & ~31) + perm32(R & 31)) : R;
        voffA[i] = (unsigned)(R * K + C) * 2u; voffB[i] = (unsigned)(Rb * K + C) * 2u; }
    const size_t kstep = (size_t)(BK * 2);
    const size_t hstep = (size_t)HALF * K * 2;
    const size_t tstep = 2 * hstep;
    const unsigned ldsw = (unsigned)wid * 1024u;
    const int aoff = lds_byte(wr * 64 + fr, fq * 8), boff = lds_byte(wc * 32 + fr, fq * 8);
#define PG8_SA(b, h) (((b) * 2 + (h)) * HTB)
#define PG8_SB(b, h) ((4 + (b) * 2 + (h)) * HTB)
#define PG8_STAGE(bufoff, gbase, voff) do { _Pragma("unroll") for (int _i = 0; _i < 2; ++_i) \
        __builtin_amdgcn_global_load_lds((const unsigned*)((const char*)(gbase) + (voff)[_i]), (PG8_LAS unsigned*)(lds + (bufoff) + ldsw + _i * 8192), 16, 0, 0); } while (0)
#define PG8_LDA(dst, b, h) do { _Pragma("unroll") for (int m = 0; m < 4; ++m) _Pragma("unroll") for (int k = 0; k < 2; ++k) dst[m][k] = *(const PG8_LAS bf16x8*)(lds + PG8_SA(b, h) + aoff + m * 2048 + k * 1024); } while (0)
#define PG8_LDB(dst, b, h) do { _Pragma("unroll") for (int n = 0; n < 2; ++n) _Pragma("unroll") for (int k = 0; k < 2; ++k) dst[n][k] = *(const PG8_LAS bf16x8*)(lds + PG8_SB(b, h) + boff + n * 2048 + k * 1024); } while (0)
#define PG8_MMA(ai, bj, At, Bt) do { __builtin_amdgcn_s_setprio(1); _Pragma("unroll") for (int m = 0; m < 4; ++m) _Pragma("unroll") for (int n = 0; n < 2; ++n) _Pragma("unroll") for (int k = 0; k < 2; ++k) \
        acc[ai][bj][m][n] = __builtin_amdgcn_mfma_f32_16x16x32_bf16(Bt[n][k], At[m][k], acc[ai][bj][m][n], 0, 0, 0); __builtin_amdgcn_s_setprio(0); } while (0)
#define PG8_WAIT_V(n) asm volatile("s_waitcnt vmcnt(" #n ")" ::: "memory")
#define PG8_WAIT_L(n) asm volatile("s_waitcnt lgkmcnt(" #n ")" ::: "memory")
#define PG8_BAR __builtin_amdgcn_s_barrier()
#define PG8_SCHED __builtin_amdgcn_sched_barrier(0)
    Unit cur, nxt; int ui = 0;
    if (!S.next(0, cur)) return;
    f32x4 acc[2][2][4][2];
#pragma unroll
    for (int a = 0; a < 2; ++a)
#pragma unroll
        for (int b = 0; b < 2; ++b)
#pragma unroll
            for (int m = 0; m < 4; ++m)
#pragma unroll
                for (int n = 0; n < 2; ++n) acc[a][b][m][n] = (f32x4){0.f, 0.f, 0.f, 0.f};
    bf16x8 At[4][2], B0[2][2], B1[2][2];
    const char* cA = (const char*)g.A + (size_t)cur.pm * tstep; const char* cB = (const char*)g.Bt + (size_t)cur.pn * tstep;
    S.a_ready(cur);
    if constexpr (SP2) {
        PG8_STAGE(PG8_SB(0, 0), cB, voffB); PG8_STAGE(PG8_SB(0, 1), cB + hstep, voffB); PG8_STAGE(PG8_SA(0, 0), cA, voffA); PG8_STAGE(PG8_SA(0, 1), cA + hstep, voffA);
        if (wr == 1) PG8_BAR;
        PG8_WAIT_V(2); PG8_BAR;
        PG8_STAGE(PG8_SB(1, 0), cB + kstep, voffB); PG8_STAGE(PG8_SA(1, 0), cA + kstep, voffA); PG8_STAGE(PG8_SB(1, 1), cB + hstep + kstep, voffB);
        PG8_WAIT_V(6); PG8_BAR;
    } else {
        PG8_STAGE(PG8_SB(0, 0), cB, voffB); PG8_STAGE(PG8_SA(0, 0), cA, voffA); PG8_STAGE(PG8_SB(0, 1), cB + hstep, voffB); PG8_STAGE(PG8_SA(0, 1), cA + hstep, voffA);
        if (wr == 1) PG8_BAR;
        PG8_WAIT_V(4); PG8_BAR;
        PG8_STAGE(PG8_SB(1, 0), cB + kstep, voffB); PG8_STAGE(PG8_SA(1, 0), cA + kstep, voffA); PG8_STAGE(PG8_SB(1, 1), cB + hstep + kstep, voffB);
        PG8_WAIT_V(6); PG8_BAR;
    }
    for (;;) {
        const bool has_next = S.next(ui + 1, nxt);
        const char* nA = has_next ? (const char*)g.A + (size_t)nxt.pm * tstep : cA; const char* nB = has_next ? (const char*)g.Bt + (size_t)nxt.pn * tstep : cB;
        for (int t = 0; t < nt; t += 2) {
            const bool last = (t == nt - 2);
            const char* a1 = cA + (size_t)(t + 1) * kstep;
            const char* a2 = last ? nA : cA + (size_t)(t + 2) * kstep; const char* b2 = last ? nB : cB + (size_t)(t + 2) * kstep;
            const char* a3 = a2 + kstep; const char* b3 = b2 + kstep;
            if (last && has_next) S.a_ready(nxt);
            if constexpr (SP2) {
            PG8_LDB(B0, 0, 0); PG8_LDB(B1, 0, 1); PG8_SCHED; PG8_LDA(At, 0, 0); PG8_STAGE(PG8_SA(1, 1), a1 + hstep, voffA);
            PG8_WAIT_V(8); PG8_WAIT_L(0); PG8_BAR; PG8_MMA(0, 0, At, B0); PG8_MMA(0, 1, At, B1); PG8_BAR; PG8_SCHED;
            PG8_LDA(At, 0, 1); PG8_STAGE(PG8_SB(0, 0), b2, voffB); PG8_STAGE(PG8_SB(0, 1), b2 + hstep, voffB); PG8_STAGE(PG8_SA(0, 0), a2, voffA);
            PG8_WAIT_V(8); PG8_WAIT_L(0); PG8_BAR; PG8_MMA(1, 0, At, B0); PG8_MMA(1, 1, At, B1); PG8_BAR; PG8_SCHED;
            PG8_LDB(B0, 1, 0); PG8_LDB(B1, 1, 1); PG8_SCHED; PG8_LDA(At, 1, 0); PG8_STAGE(PG8_SA(0, 1), a2 + hstep, voffA);
            PG8_WAIT_V(8); PG8_WAIT_L(0); PG8_BAR; PG8_MMA(0, 0, At, B0); PG8_MMA(0, 1, At, B1); PG8_BAR; PG8_SCHED;
            PG8_LDA(At, 1, 1); PG8_STAGE(PG8_SB(1, 0), b3, voffB); PG8_STAGE(PG8_SB(1, 1), b3 + hstep, voffB); PG8_STAGE(PG8_SA(1, 0), a3, voffA);
            PG8_WAIT_V(8); PG8_WAIT_L(0); PG8_BAR; PG8_MMA(1, 0, At, B0); PG8_MMA(1, 1, At, B1); PG8_BAR; PG8_SCHED;
            } else {
            PG8_LDB(B0, 0, 0); PG8_SCHED; PG8_LDA(At, 0, 0); PG8_STAGE(PG8_SA(1, 1), a1 + hstep, voffA);
            PG8_WAIT_L(8); PG8_BAR; PG8_WAIT_L(0); PG8_MMA(0, 0, At, B0); PG8_BAR; PG8_SCHED;
            PG8_LDB(B1, 0, 1); PG8_STAGE(PG8_SB(0, 0), b2, voffB);
            PG8_BAR; PG8_WAIT_L(0); PG8_MMA(0, 1, At, B1); PG8_BAR;
            PG8_LDA(At, 0, 1); PG8_STAGE(PG8_SA(0, 0), a2, voffA);
            PG8_BAR; PG8_WAIT_L(0); PG8_MMA(1, 0, At, B0); PG8_BAR; PG8_SCHED;
            PG8_STAGE(PG8_SB(0, 1), b2 + hstep, voffB);
            PG8_WAIT_V(6); PG8_BAR; PG8_MMA(1, 1, At, B1); PG8_BAR;
            PG8_LDB(B0, 1, 0); PG8_SCHED; PG8_LDA(At, 1, 0); PG8_STAGE(PG8_SA(0, 1), a2 + hstep, voffA);
            PG8_WAIT_L(8); PG8_BAR; PG8_WAIT_L(0); PG8_MMA(0, 0, At, B0); PG8_BAR; PG8_SCHED;
            PG8_LDB(B1, 1, 1); PG8_STAGE(PG8_SB(1, 0), b3, voffB);
            PG8_BAR; PG8_WAIT_L(0); PG8_MMA(0, 1, At, B1); PG8_BAR;
            PG8_LDA(At, 1, 1); PG8_STAGE(PG8_SA(1, 0), a3, voffA);
            PG8_BAR; PG8_WAIT_L(0); PG8_MMA(1, 0, At, B0); PG8_BAR; PG8_SCHED;
            PG8_STAGE(PG8_SB(1, 1), b3 + hstep, voffB);
            PG8_WAIT_V(6); PG8_BAR; PG8_MMA(1, 1, At, B1); PG8_BAR;
            }
        }
        if constexpr (ALIGN_EPI) { if (wr == 0) PG8_BAR; }
        if constexpr (!Epi::AFTER_DRAIN) { E(acc, cur, wr, wc, fr, fq); S.done(cur); }
        if (!has_next) break;
#pragma unroll
        for (int a = 0; a < 2; ++a)
#pragma unroll
            for (int b = 0; b < 2; ++b)
#pragma unroll
                for (int m = 0; m < 4; ++m)
#pragma unroll
                    for (int n = 0; n < 2; ++n) acc[a][b][m][n] = (f32x4){0.f, 0.f, 0.f, 0.f};
        cur = nxt; cA = nA; cB = nB; ++ui;
        if constexpr (ALIGN_EPI) { if (wr == 1) PG8_BAR; }
    }
    PG8_WAIT_V(0);
    if constexpr (!ALIGN_EPI) { if (wr == 0) PG8_BAR; }
    PG8_BAR;
    if constexpr (Epi::AFTER_DRAIN) { E.fused(acc, cur, wr, wc, fr, fq, lds, wid, lane); S.done(cur); }
#undef PG8_SA
#undef PG8_SB
#undef PG8_STAGE
#undef PG8_LDA
#undef PG8_LDB
#undef PG8_MMA
#undef PG8_WAIT_V
#undef PG8_WAIT_L
#undef PG8_BAR
#undef PG8_SCHED
}
}
#define LAS __attribute__((address_space(3)))
typedef unsigned short bf16;
typedef float f32x4 __attribute__((ext_vector_type(4)));
typedef float f32x2 __attribute__((ext_vector_type(2)));
typedef float f32x16 __attribute__((ext_vector_type(16)));
typedef short bf16x8 __attribute__((ext_vector_type(8)));
typedef short s16x4 __attribute__((ext_vector_type(4)));
typedef unsigned u32x4 __attribute__((ext_vector_type(4)));
typedef unsigned u32x2 __attribute__((ext_vector_type(2)));

#ifndef REP_LORA
#define REP_LORA 1
#endif
#ifndef REP_UP
#define REP_UP 1
#endif
#ifndef REP_RMS
#define REP_RMS 1
#endif
#ifndef REP_XMIX
#define REP_XMIX 1
#endif
#ifndef REP_ATTN
#define REP_ATTN 1
#endif
#ifndef REP_ATTNA
#define REP_ATTNA 1
#endif
#ifndef REP_SCAN
#define REP_SCAN 1
#endif
constexpr int NWAVES = 8, NTHR = 512;
constexpr int NTOK = 65536, DM = 1024, SEQ = 4096, NBATCH = 16, DFF = 4096, QKVC = 3072;
constexpr size_t MiB = (size_t)1 << 20;
constexpr size_t WS_CTL = 0;
constexpr size_t WS_WIN = 1 * MiB, WS_WOUT = 7 * MiB, WS_W1_0 = 9 * MiB, WS_W2_0 = 17 * MiB, WS_W1_1 = 25 * MiB, WS_W2_1 = 33 * MiB;
constexpr size_t WS_WR = 41 * MiB, WS_WK = 43 * MiB, WS_WV = 45 * MiB, WS_WO = 47 * MiB;
constexpr size_t WS_LW1 = 49 * MiB, WS_LA1 = WS_LW1 + 512 * 1024, WS_LG1 = 50 * MiB, WS_LW2 = WS_LG1 + 512 * 1024, WS_LA2 = 51 * MiB, WS_LG2 = WS_LA2 + 512 * 1024;
constexpr size_t WS_ROPE = 52 * MiB;
constexpr size_t WS_HN = 65 * MiB;
constexpr size_t WS_QKV = 193 * MiB;
constexpr size_t WS_ATT = 577 * MiB;
constexpr size_t WS_OAP = 705 * MiB;
constexpr size_t WS_LSE = 897 * MiB;
constexpr size_t WS_U = 193 * MiB;
constexpr size_t WS_X6 = 65 * MiB;
constexpr size_t WS_T = 833 * MiB;
constexpr size_t WS_RKV = 449 * MiB;
constexpr size_t WS_WAG = 65 * MiB;
constexpr size_t WS_Z = 833 * MiB;
constexpr size_t WS_END = 961 * MiB;
constexpr size_t ACT = (size_t)NTOK * DM * 2;

constexpr int RING_BYTES = 131072, LDS_BYTES = 147456;
constexpr int LDS_BARST = 147200;
constexpr size_t WS_BAR = 16384;
constexpr size_t CTL_ZERO_BYTES = 65536;
#define XB_TMO      128
#define XB_XCNT(j)  (256  + 64 * (j))
#define XB_XSUB(j)  (1280 + 64 * (j))
#define XB_XGEN(j)  (2304 + 64 * (j))
#define XB_TOP      3328
#define XB_TOPGEN   3392
#define XCD_BAR_WORDS 3456
#define XB_SPIN_CAP (1u << 18)

__device__ __forceinline__ unsigned xb_ld(unsigned* p)              { return __hip_atomic_load(p, __ATOMIC_RELAXED, __HIP_MEMORY_SCOPE_AGENT); }
__device__ __forceinline__ unsigned xb_add(unsigned* p, unsigned v) { return __hip_atomic_fetch_add(p, v, __ATOMIC_RELAXED, __HIP_MEMORY_SCOPE_AGENT); }
__device__ __forceinline__ unsigned xb_xcc_id() { return (unsigned)__builtin_amdgcn_s_getreg((3 << 11) | 20) & 0xFu; }
#define XB_SPIN(cond, bar) do { unsigned _sp = 0; while (cond) { __builtin_amdgcn_s_sleep(1); \
    if ((++_sp & 255u) == 0u) { if (xb_ld(&(bar)[XB_TMO])) break; if (_sp > XB_SPIN_CAP) { atomicAdd(&(bar)[XB_TMO], 1u); break; } } } } while (0)

struct XcdBarrier {
    unsigned* bar; unsigned x;
    volatile LAS unsigned* st;
};

__device__ __forceinline__ XcdBarrier xcd_barrier_post(unsigned* bar, volatile LAS unsigned* st) {
    XcdBarrier b; b.bar = bar; b.x = xb_xcc_id(); b.st = st;
    if (threadIdx.x == 0) (void)xb_add(&bar[XB_XCNT(b.x)], 1u);
    return b;
}
__device__ __forceinline__ void xcd_barrier_complete(unsigned* bar, unsigned x, unsigned& nloc, unsigned& nx) {
    const unsigned G = gridDim.x * gridDim.y * gridDim.z;
    unsigned sum, cnt, mine, sp = 0u;
    for (;;) {
        sum = 0u; cnt = 0u; mine = 0u;
#pragma unroll
        for (unsigned j = 0; j < 16; ++j) { const unsigned c = xb_ld(&bar[XB_XCNT(j)]); sum += c; cnt += (c > 0u) ? 1u : 0u; mine = (j == x) ? c : mine; }
        if (sum == G) break;
        __builtin_amdgcn_s_sleep(1);
        if ((++sp & 255u) == 0u) { if (xb_ld(&bar[XB_TMO])) break; if (sp > XB_SPIN_CAP) { atomicAdd(&bar[XB_TMO], 1u); break; } }
    }
    nloc = mine > 0u ? mine : 1u; nx = cnt > 0u ? cnt : 1u;
}

__device__ __forceinline__ void xcd_barrier(const XcdBarrier& b) {
    asm volatile("s_waitcnt vmcnt(0)" ::: "memory");
    __syncthreads();
    if (threadIdx.x == 0) {
        unsigned* bar = b.bar;
        __builtin_amdgcn_s_waitcnt(0);
        unsigned nloc = b.st[0], nx = b.st[1];
        if (nloc == 0u) { xcd_barrier_complete(bar, b.x, nloc, nx); b.st[0] = nloc; b.st[1] = nx; }
        const unsigned old = xb_add(&bar[XB_XSUB(b.x)], 1u);
        const unsigned gen = old / nloc;
        if (old + 1u == (gen + 1u) * nloc) {
            __builtin_amdgcn_fence(__ATOMIC_RELEASE, "agent");
            asm volatile("s_waitcnt vmcnt(0)" ::: "memory");
            const unsigned og = xb_add(&bar[XB_TOP], 1u);
            const unsigned tg = og / nx;
            if (og + 1u == (tg + 1u) * nx) xb_add(&bar[XB_TOPGEN], 1u);
            else XB_SPIN(xb_ld(&bar[XB_TOPGEN]) == tg, bar);
            __builtin_amdgcn_fence(__ATOMIC_ACQUIRE, "agent");
            xb_add(&bar[XB_XGEN(b.x)], 1u);
            asm volatile("s_waitcnt vmcnt(0)" ::: "memory");
        } else {
            XB_SPIN(xb_ld(&bar[XB_XGEN(b.x)]) == gen, bar);
            __builtin_amdgcn_fence(__ATOMIC_ACQUIRE, "agent");
            asm volatile("s_waitcnt vmcnt(0)" ::: "memory");
        }
    }
    __syncthreads();
}


__device__ __forceinline__ unsigned pkbf(float lo, float hi) { return pg8::cvt_pk_bf16(lo, hi); }
__device__ __forceinline__ float bf2f(unsigned short h) { return __uint_as_float(((unsigned)h) << 16); }
__device__ __forceinline__ float bflo(unsigned w) { return __uint_as_float(w << 16); }
__device__ __forceinline__ float bfhi(unsigned w) { return __uint_as_float(w & 0xffff0000u); }
__device__ __forceinline__ float wave_sum(float v) {
#define WS_DPP_(x, ctrl, rmask, bctl) __int_as_float(__builtin_amdgcn_update_dpp(0, __float_as_int(x), (ctrl), (rmask), 0xF, (bctl)))
    v += WS_DPP_(v, 0xB1, 0xF, true);
    v += WS_DPP_(v, 0x4E, 0xF, true);
    v += WS_DPP_(v, 0x124, 0xF, true);
    v += WS_DPP_(v, 0x128, 0xF, true);
    v += WS_DPP_(v, 0x142, 0xA, false);
    v += WS_DPP_(v, 0x143, 0xC, false);
#undef WS_DPP_
    return __int_as_float(__builtin_amdgcn_readlane(__float_as_int(v), 63));
}

struct Args {
    const float* x; const float* norm_mix; const float* norm_mlp; const float* norm_final;
    const float* attn_w_in; const float* attn_w_out; const float* diff_lambda; const float* diff_subln;
    const float* rwkv_mu; const float* rwkv_w_r; const float* rwkv_w_k; const float* rwkv_w_v; const float* rwkv_w_o;
    const float* rwkv_w0; const float* rwkv_w1; const float* rwkv_w2; const float* rwkv_a0; const float* rwkv_a1; const float* rwkv_a2;
    const float* rwkv_g1; const float* rwkv_g2; const float* rwkv_k_k; const float* rwkv_k_a; const float* rwkv_r_k;
    const float* rwkv_ln_w; const float* rwkv_ln_b; const float* mlp_w1; const float* mlp_w2;
    float* out; unsigned char* ws; int ph_lo, ph_hi;
};

__device__ __forceinline__ void transpose_item(const float* __restrict__ W, int N, bf16* __restrict__ WT, int pitch, LAS float* scr, int item, int lane) {
    const int nblk = N >> 5, kb = item / nblk, nb = item - kb * nblk, k0 = kb * 32, n0 = nb * 32;
#pragma unroll 4
    for (int i = 0; i < 16; ++i) { const int kk = 2 * i + (lane >> 5); scr[kk * 33 + (lane & 31)] = W[(size_t)(k0 + kk) * N + n0 + (lane & 31)]; }
    asm volatile("s_waitcnt lgkmcnt(0)" ::: "memory");
    const int c = lane & 3;
#pragma unroll
    for (int j = 0; j < 2; ++j) { const int n = (lane >> 2) + 16 * j; const LAS float* s = scr + (8 * c) * 33 + n;
        u32x4 o; o.x = pkbf(s[0], s[33]); o.y = pkbf(s[66], s[99]); o.z = pkbf(s[132], s[165]); o.w = pkbf(s[198], s[231]);
        *(u32x4*)(WT + (size_t)(n0 + n) * pitch + k0 + 8 * c) = o; }
    asm volatile("s_waitcnt lgkmcnt(0)" ::: "memory");
}
__device__ __forceinline__ void zero_region(bf16* p, int pitch, int r0, int r1, int c0, int c1, int gt, int ngt) {
    const int cw = (c1 - c0) >> 3, n = (r1 - r0) * cw;
    for (int i = gt; i < n; i += ngt) { const int r = r0 + i / cw, c = c0 + (i % cw) * 8; *(u32x4*)(p + (size_t)r * pitch + c) = (u32x4){0u, 0u, 0u, 0u}; }
}
__device__ __forceinline__ void rms_row_bf16(const float* xrow, const float* gain, bf16* orow, int lane) {
    const f32x4* xr = (const f32x4*)xrow + lane; const f32x4* gr = (const f32x4*)gain + lane;
    f32x4 v[4]; float s = 0.f;
#pragma unroll
    for (int j = 0; j < 4; ++j) { v[j] = xr[64 * j]; s += (v[j].x * v[j].x + v[j].y * v[j].y) + (v[j].z * v[j].z + v[j].w * v[j].w); }
    const float rstd = 1.f / sqrtf(wave_sum(s) * (1.f / 1024.f) + 1e-5f);
    u32x2* o8 = (u32x2*)orow + lane;
#pragma unroll
    for (int j = 0; j < 4; ++j) { const f32x4 g = gr[64 * j]; u32x2 w; w.x = pkbf(v[j].x * rstd * g.x, v[j].y * rstd * g.y); w.y = pkbf(v[j].z * rstd * g.z, v[j].w * rstd * g.w); o8[64 * j] = w; }
}
__device__ __forceinline__ void rms_phase_bf16(const float* __restrict__ src, const float* __restrict__ gain, bf16* __restrict__ dst, int gw, int ngw, int lane) {
    const f32x4* gr = (const f32x4*)gain + lane;
    for (int m = 2 * gw; m < NTOK; m += 2 * ngw) {
        const f32x4* x0 = (const f32x4*)(src + (size_t)m * DM) + lane; const f32x4* x1 = x0 + DM / 4;
        f32x4 v[4], u[4]; float s = 0.f, t = 0.f;
#pragma unroll
        for (int j = 0; j < 4; ++j) { v[j] = x0[64 * j]; u[j] = x1[64 * j]; }
#pragma unroll
        for (int j = 0; j < 4; ++j) { s += (v[j].x * v[j].x + v[j].y * v[j].y) + (v[j].z * v[j].z + v[j].w * v[j].w); t += (u[j].x * u[j].x + u[j].y * u[j].y) + (u[j].z * u[j].z + u[j].w * u[j].w); }
        const float r0 = 1.f / sqrtf(wave_sum(s) * (1.f / 1024.f) + 1e-5f), r1 = 1.f / sqrtf(wave_sum(t) * (1.f / 1024.f) + 1e-5f);
        u32x2* o0 = (u32x2*)(dst + (size_t)m * DM) + lane; u32x2* o1 = o0 + DM / 4;
#pragma unroll
        for (int j = 0; j < 4; ++j) { const f32x4 g = gr[64 * j];
            u32x2 w; w.x = pkbf(v[j].x * r0 * g.x, v[j].y * r0 * g.y); w.y = pkbf(v[j].z * r0 * g.z, v[j].w * r0 * g.w); o0[64 * j] = w;
            u32x2 z; z.x = pkbf(u[j].x * r1 * g.x, u[j].y * r1 * g.y); z.y = pkbf(u[j].z * r1 * g.z, u[j].w * r1 * g.w); o1[64 * j] = z; }
    }
}
__device__ __forceinline__ void rms_phase_f32(const float* src, const float* gain, float* dst, int gw, int ngw, int lane) {
    const f32x4* gr = (const f32x4*)gain + lane;
    for (int m = 2 * gw; m < NTOK; m += 2 * ngw) {
        const f32x4* x0 = (const f32x4*)(src + (size_t)m * DM) + lane; const f32x4* x1 = x0 + DM / 4;
        f32x4 v[4], u[4]; float s = 0.f, t = 0.f;
#pragma unroll
        for (int j = 0; j < 4; ++j) { v[j] = x0[64 * j]; u[j] = x1[64 * j]; }
#pragma unroll
        for (int j = 0; j < 4; ++j) { s += (v[j].x * v[j].x + v[j].y * v[j].y) + (v[j].z * v[j].z + v[j].w * v[j].w); t += (u[j].x * u[j].x + u[j].y * u[j].y) + (u[j].z * u[j].z + u[j].w * u[j].w); }
        const float r0 = 1.f / sqrtf(wave_sum(s) * (1.f / 1024.f) + 1e-5f), r1 = 1.f / sqrtf(wave_sum(t) * (1.f / 1024.f) + 1e-5f);
        f32x4* o0 = (f32x4*)(dst + (size_t)m * DM) + lane; f32x4* o1 = o0 + DM / 4;
#pragma unroll
        for (int j = 0; j < 4; ++j) { const f32x4 g = gr[64 * j]; o0[64 * j] = v[j] * r0 * g; o1[64 * j] = u[j] * r1 * g; }
    }
}

__device__ __forceinline__ void xmix_phase(const float* __restrict__ h, const float* __restrict__ gain, const float* __restrict__ mu, bf16* __restrict__ X6, int gw, int ngw, int lane) {
    f32x4 g4[4], m6[6][4];
#pragma unroll
    for (int j = 0; j < 4; ++j) g4[j] = ((const f32x4*)gain + lane)[64 * j];
#pragma unroll
    for (int i = 0; i < 6; ++i) {
        const int mi = (i == 1) ? 2 : ((i == 2) ? 3 : ((i == 3) ? 1 : i));
#pragma unroll
        for (int j = 0; j < 4; ++j) m6[i][j] = ((const f32x4*)(mu + mi * DM) + lane)[64 * j];
    }
    for (int chunk = gw; chunk < NTOK / 32; chunk += ngw) {
        const int t0 = chunk * 32;
        f32x4 prev[4];
        if ((t0 & (SEQ - 1)) == 0) {
#pragma unroll
            for (int j = 0; j < 4; ++j) prev[j] = (f32x4){0.f, 0.f, 0.f, 0.f};
        } else {
            const f32x4* xr = (const f32x4*)(h + (size_t)(t0 - 1) * DM) + lane; float s = 0.f;
#pragma unroll
            for (int j = 0; j < 4; ++j) { prev[j] = xr[64 * j]; s += (prev[j].x * prev[j].x + prev[j].y * prev[j].y) + (prev[j].z * prev[j].z + prev[j].w * prev[j].w); }
            const float rstd = 1.f / sqrtf(wave_sum(s) * (1.f / 1024.f) + 1e-5f);
#pragma unroll
            for (int j = 0; j < 4; ++j) prev[j] = prev[j] * rstd * g4[j];
        }
        f32x4 nx[4];
        { const f32x4* xr = (const f32x4*)(h + (size_t)t0 * DM) + lane;
#pragma unroll
          for (int j = 0; j < 4; ++j) nx[j] = xr[64 * j]; }
        for (int t = t0; t < t0 + 32; ++t) {
            f32x4 v[4]; float s = 0.f;
#pragma unroll
            for (int j = 0; j < 4; ++j) v[j] = nx[j];
            if (t + 1 < t0 + 32) { const f32x4* xr = (const f32x4*)(h + (size_t)(t + 1) * DM) + lane;
#pragma unroll
              for (int j = 0; j < 4; ++j) nx[j] = xr[64 * j]; }
#pragma unroll
            for (int j = 0; j < 4; ++j) s += (v[j].x * v[j].x + v[j].y * v[j].y) + (v[j].z * v[j].z + v[j].w * v[j].w);
            const float rstd = 1.f / sqrtf(wave_sum(s) * (1.f / 1024.f) + 1e-5f);
#pragma unroll
            for (int j = 0; j < 4; ++j) v[j] = v[j] * rstd * g4[j];
#pragma unroll
            for (int i = 0; i < 6; ++i) {
                u32x2* o8 = (u32x2*)(X6 + (size_t)i * NTOK * DM + (size_t)t * DM) + lane;
#pragma unroll
                for (int j = 0; j < 4; ++j) { const f32x4 xx = v[j] + (prev[j] - v[j]) * m6[i][j]; u32x2 w; w.x = pkbf(xx.x, xx.y); w.y = pkbf(xx.z, xx.w); o8[64 * j] = w; }
            }
#pragma unroll
            for (int j = 0; j < 4; ++j) prev[j] = v[j];
        }
    }
}

__device__ __forceinline__ int crow(int r, int hi) { return (r & 3) + 8 * (r >> 2) + 4 * hi; }
__device__ __forceinline__ s16x4 vtr(const LAS unsigned char* p) {
    typedef short v4i16_t __attribute__((ext_vector_type(4)));
    return __builtin_bit_cast(s16x4, __builtin_amdgcn_ds_read_tr16_b64_v4i16((LAS v4i16_t*)p));
}
__device__ __forceinline__ bf16x8 vfrag(const LAS unsigned char* p, int row8) {
    const s16x4 lo = vtr(p), hi = vtr(p + row8);
    return (bf16x8){lo[0], lo[1], lo[2], lo[3], hi[0], hi[1], hi[2], hi[3]};
}
__device__ __forceinline__ bf16x8 packp(const f32x16& p, int b) {
    u32x4 w; w.x = pkbf(p[b], p[b + 1]); w.y = pkbf(p[b + 2], p[b + 3]); w.z = pkbf(p[b + 4], p[b + 5]); w.w = pkbf(p[b + 6], p[b + 7]);
    return __builtin_bit_cast(bf16x8, w);
}
__device__ __forceinline__ float max16(const f32x16& p) {
    float a = fmaxf(fmaxf(p[0], p[1]), fmaxf(p[2], p[3])), b = fmaxf(fmaxf(p[4], p[5]), fmaxf(p[6], p[7]));
    float c = fmaxf(fmaxf(p[8], p[9]), fmaxf(p[10], p[11])), d = fmaxf(fmaxf(p[12], p[13]), fmaxf(p[14], p[15]));
    return fmaxf(fmaxf(a, b), fmaxf(c, d));
}
__device__ __forceinline__ float sum16(const f32x16& p) {
    return ((p[0] + p[1]) + (p[2] + p[3])) + ((p[4] + p[5]) + (p[6] + p[7])) + ((p[8] + p[9]) + (p[10] + p[11])) + ((p[12] + p[13]) + (p[14] + p[15]));
}
__device__ __forceinline__ float other_half(float v) {
    const unsigned b = __float_as_uint(v);
    auto rr = __builtin_amdgcn_permlane32_swap(b, b, false, false);
    return __uint_as_float(((threadIdx.x & 32) != 0) ? rr[0] : rr[1]);
}
#define MFMA32(a, b, c) __builtin_amdgcn_mfma_f32_32x32x16_bf16((a), (b), (c), 0, 0, 0)

constexpr int KB_STR = 144, VB_STR = 320, KB_BYTES = 64 * KB_STR, VB_BYTES = 64 * VB_STR, BBUF = 2 * KB_BYTES + VB_BYTES;
constexpr int BX_OFF = 2 * BBUF;
__device__ __forceinline__ void diffattn_unit(const bf16* __restrict__ QKV, bf16* __restrict__ ATT, const float* subln, float lam, int b, int h, int qb, LAS unsigned char* lds) {
    int tid = threadIdx.x; asm volatile("" : "+v"(tid)); const int lane = tid & 63, wid = __builtin_amdgcn_readfirstlane(tid >> 6), c = wid >> 2, g = wid & 3, i32 = lane & 31, hi = lane >> 5;
    const size_t tok0 = (size_t)b * SEQ;
    const int qrow = qb * 128 + 32 * g + i32;
    bf16x8 qf[4];
    { const bf16* qp = QKV + (tok0 + qrow) * QKVC + 1536 + h * 128 + c * 64 + 8 * hi;
#pragma unroll
      for (int s = 0; s < 4; ++s) qf[s] = *(const bf16x8*)(qp + 16 * s); }
    const int krow = tid >> 3, kch = tid & 7;
    const bf16* ksrc = QKV + (tok0 + krow) * QKVC + 2048 + h * 128 + kch * 8;
    const int vrow0 = tid >> 4, vch = tid & 15;
    const bf16* vsrc = QKV + (tok0 + vrow0) * QKVC + 2560 + h * 128 + vch * 8;
    const int kdst = krow * KB_STR + kch * 16, vdst = vrow0 * VB_STR + vch * 16;
    const int NT = 2 * qb + 2;
    u32x4 rk0, rk1, rv0, rv1;
#define B_LOAD(t) do { const size_t o_ = (size_t)(t) * 64 * QKVC; rk0 = *(const u32x4*)(ksrc + o_); rk1 = *(const u32x4*)(ksrc + o_ + 64); rv0 = *(const u32x4*)(vsrc + o_); rv1 = *(const u32x4*)(vsrc + o_ + (size_t)32 * QKVC); } while (0)
#define B_STORE(buf) do { LAS unsigned char* b_ = lds + (buf) * BBUF; *(LAS u32x4*)(b_ + kdst) = rk0; *(LAS u32x4*)(b_ + KB_BYTES + kdst) = rk1; *(LAS u32x4*)(b_ + 2 * KB_BYTES + vdst) = rv0; *(LAS u32x4*)(b_ + 2 * KB_BYTES + vdst + 32 * VB_STR) = rv1; } while (0)
    B_LOAD(0);
    f32x16 o[4];
#pragma unroll
    for (int d = 0; d < 4; ++d) o[d] = (f32x16){};
    float m_ref = 0.f, l_run = 0.f;
    const int qmin = qb * 128 + 32 * g;
    const int lg = lane & 15, gg = (lane >> 4) & 1;
    const int voff = (4 * hi + (lg >> 2)) * VB_STR + (16 * gg + 4 * (lg & 3)) * 2;
    for (int t = 0; t < NT; ++t) {
        B_STORE(t & 1);
        __syncthreads();
        if (t + 1 < NT) B_LOAD(t + 1);
        const int k0 = 64 * t;
        if (k0 <= qmin + 31) {
            const LAS unsigned char* kb = lds + (t & 1) * BBUF + c * KB_BYTES;
            const LAS unsigned char* vb = lds + (t & 1) * BBUF + 2 * KB_BYTES + voff;
            f32x16 p0 = (f32x16){}, p1 = (f32x16){};
#pragma unroll
            for (int s = 0; s < 4; ++s) {
                const bf16x8 a0 = *(const LAS bf16x8*)(kb + i32 * KB_STR + 32 * s + 16 * hi);
                const bf16x8 a1 = *(const LAS bf16x8*)(kb + (32 + i32) * KB_STR + 32 * s + 16 * hi);
                p0 = MFMA32(a0, qf[s], p0); p1 = MFMA32(a1, qf[s], p1);
            }
            if (k0 + 63 > qmin) {
#pragma unroll
                for (int r = 0; r < 16; ++r) { const int kv = k0 + crow(r, hi); if (kv > qrow) p0[r] = -INFINITY; if (kv + 32 > qrow) p1[r] = -INFINITY; }
            }
            float mx = fmaxf(max16(p0), max16(p1));
            mx = fmaxf(mx, other_half(mx));
            if (t == 0) m_ref = mx;
            else if (__any(mx - m_ref > 8.f)) {
                const float dl = fmaxf(mx - m_ref, 0.f);
                m_ref += dl;
                const float alpha = __builtin_amdgcn_exp2f(-dl);
                l_run *= alpha;
#pragma unroll
                for (int d = 0; d < 4; ++d) o[d] = o[d] * alpha;
            }
#pragma unroll
            for (int r = 0; r < 16; ++r) { p0[r] = __builtin_amdgcn_exp2f(p0[r] - m_ref); p1[r] = __builtin_amdgcn_exp2f(p1[r] - m_ref); }
            l_run += sum16(p0) + sum16(p1);
#pragma unroll
            for (int s4 = 0; s4 < 4; ++s4) {
                const bf16x8 pfs = packp((s4 < 2) ? p0 : p1, 8 * (s4 & 1));
#pragma unroll
                for (int d = 0; d < 4; ++d) { const bf16x8 a = vfrag(vb + s4 * 16 * VB_STR + d * 64, 8 * VB_STR); o[d] = MFMA32(a, pfs, o[d]); }
                __builtin_amdgcn_sched_barrier(0);
            }
        }
    }
#undef B_LOAD
#undef B_STORE
    __syncthreads();
    float l_tot = l_run + __shfl_xor(l_run, 32);
    const float inv = 1.f / l_tot;
    LAS float* X = (LAS float*)(lds + BX_OFF) + g * 4096;
    if (c == 1) {
        const float sc = inv * lam;
#pragma unroll
        for (int d = 0; d < 4; ++d)
#pragma unroll
            for (int r = 0; r < 16; ++r) X[(32 * d + crow(r, hi)) * 32 + i32] = o[d][r] * sc;
    }
    __syncthreads();
    if (c == 0) {
        float ss = 0.f;
#pragma unroll
        for (int d = 0; d < 4; ++d)
#pragma unroll
            for (int r = 0; r < 16; ++r) { const float v = o[d][r] * inv - X[(32 * d + crow(r, hi)) * 32 + i32]; o[d][r] = v; ss += v * v; }
        ss += __shfl_xor(ss, 32);
        const float rs = (1.f / sqrtf(ss * (1.f / 128.f) + 1e-5f)) * 0.8f;
        bf16* op = ATT + (tok0 + qrow) * DM + 512 + h * 128;
#pragma unroll
        for (int d = 0; d < 4; ++d)
#pragma unroll
            for (int r4 = 0; r4 < 4; ++r4) {
                const int dv = 32 * d + 8 * r4 + 4 * hi; const f32x4 gn = *(const f32x4*)(subln + dv);
                u32x2 w; w.x = pkbf(o[d][4 * r4] * rs * gn.x, o[d][4 * r4 + 1] * rs * gn.y); w.y = pkbf(o[d][4 * r4 + 2] * rs * gn.z, o[d][4 * r4 + 3] * rs * gn.w);
                *(u32x2*)(op + dv) = w;
            }
    }
    __syncthreads();
}

constexpr int KA_STR = 144, VA_STR = 192, KA_BYTES = 384 * KA_STR, VA_BYTES = 384 * VA_STR;
__device__ __forceinline__ void dilattn_unit(const bf16* __restrict__ QKV, bf16* __restrict__ OAP, float* __restrict__ LSE, int b, int h, int dil, int res, int n, LAS unsigned char* lds) {
    int tid = threadIdx.x; asm volatile("" : "+v"(tid)); const int lane = tid & 63, wid = __builtin_amdgcn_readfirstlane(tid >> 6), i32 = lane & 31, hi = lane >> 5;
    const size_t tok0 = (size_t)b * SEQ;
    {
#pragma unroll
        for (int i = 0; i < 6; ++i) {
            const int e = tid + 512 * i, kr = e >> 3, ch = e & 7, j = 256 * n - 128 + kr;
            u32x4 kv = (u32x4){0u, 0u, 0u, 0u}, vv = kv;
            if (j >= 0) { const bf16* p = QKV + (tok0 + (size_t)j * dil + res) * QKVC + h * 64 + ch * 8; kv = *(const u32x4*)(p + 512); vv = *(const u32x4*)(p + 1024); }
            *(LAS u32x4*)(lds + kr * KA_STR + ch * 16) = kv;
            *(LAS u32x4*)(lds + KA_BYTES + kr * VA_STR + ch * 16) = vv;
        }
    }
    const int jq = 256 * n + 32 * wid + i32;
    const size_t qtok = tok0 + (size_t)jq * dil + res;
    bf16x8 qf[4];
    { const bf16* qp = QKV + qtok * QKVC + h * 64 + 8 * hi;
#pragma unroll
      for (int s = 0; s < 4; ++s) qf[s] = *(const bf16x8*)(qp + 16 * s); }
    __syncthreads();
    f32x16 p[5];
    const int ufirst = (n == 0) ? ((wid < 4) ? 4 - wid : 0) : 0;
#pragma unroll
    for (int u = 0; u < 5; ++u) {
        p[u] = (f32x16){};
        if (u >= ufirst) {
            const LAS unsigned char* kb = lds + (32 * (wid + u) + i32) * KA_STR + 16 * hi;
#pragma unroll
            for (int s = 0; s < 4; ++s) { const bf16x8 a = *(const LAS bf16x8*)(kb + 32 * s); p[u] = MFMA32(a, qf[s], p[u]); }
        } else {
#pragma unroll
            for (int r = 0; r < 16; ++r) p[u][r] = -INFINITY;
        }
    }
#pragma unroll
    for (int r = 0; r < 16; ++r) { const int kl = crow(r, hi); if (kl < i32) p[0][r] = -INFINITY; if (kl > i32) p[4][r] = -INFINITY; }
    float mx = fmaxf(fmaxf(fmaxf(max16(p[0]), max16(p[1])), fmaxf(max16(p[2]), max16(p[3]))), max16(p[4]));
    mx = fmaxf(mx, other_half(mx));
    float l = 0.f;
#pragma unroll
    for (int u = 0; u < 5; ++u) {
#pragma unroll
        for (int r = 0; r < 16; ++r) p[u][r] = __builtin_amdgcn_exp2f(p[u][r] - mx);
        l += sum16(p[u]);
    }
    l += __shfl_xor(l, 32);
    f32x16 o[2]; o[0] = (f32x16){}; o[1] = (f32x16){};
    const int lg = lane & 15, gg = (lane >> 4) & 1;
    const LAS unsigned char* vb = lds + KA_BYTES + (4 * hi + (lg >> 2)) * VA_STR + (16 * gg + 4 * (lg & 3)) * 2;
#pragma unroll
    for (int u = 0; u < 5; ++u) {
        if (u >= ufirst) {
#pragma unroll
            for (int s2 = 0; s2 < 2; ++s2) {
                const bf16x8 pf = packp(p[u], 8 * s2);
#pragma unroll
                for (int d = 0; d < 2; ++d) { const bf16x8 a = vfrag(vb + (32 * (wid + u) + 16 * s2) * VA_STR + d * 64, 8 * VA_STR); o[d] = MFMA32(a, pf, o[d]); }
            }
        }
    }
    const float inv = 1.f / l;
    const int pat = (dil == 1) ? 0 : ((dil == 4) ? 1 : 2);
    bf16* op = OAP + (size_t)pat * NTOK * 512 + qtok * 512 + h * 64;
#pragma unroll
    for (int d = 0; d < 2; ++d)
#pragma unroll
        for (int r4 = 0; r4 < 4; ++r4) {
            const int dv = 32 * d + 8 * r4 + 4 * hi;
            u32x2 w; w.x = pkbf(o[d][4 * r4] * inv, o[d][4 * r4 + 1] * inv); w.y = pkbf(o[d][4 * r4 + 2] * inv, o[d][4 * r4 + 3] * inv);
            *(u32x2*)(op + dv) = w;
        }
    if (hi == 0) LSE[(size_t)pat * NTOK * 8 + qtok * 8 + h] = mx + __builtin_amdgcn_logf(l);
    __syncthreads();
}

__device__ __forceinline__ void combine_phase(const bf16* __restrict__ OAP, const float* __restrict__ LSE, bf16* __restrict__ ATT, int gt, int ngt) {
    for (int i = gt; i < NTOK * 64; i += ngt) {
        const int tokh = i >> 3, ch = i & 7; const size_t tok = (size_t)(tokh >> 3); const int h = tokh & 7;
        const float l0 = LSE[tokh], l1 = LSE[(size_t)NTOK * 8 + tokh], l2 = LSE[(size_t)2 * NTOK * 8 + tokh];
        const float m = fmaxf(l0, fmaxf(l1, l2));
        float w0 = __builtin_amdgcn_exp2f(l0 - m), w1 = __builtin_amdgcn_exp2f(l1 - m), w2 = __builtin_amdgcn_exp2f(l2 - m);
        const float is = 1.f / (w0 + w1 + w2); w0 *= is; w1 *= is; w2 *= is;
        const size_t off = tok * 512 + h * 64 + ch * 8;
        const u32x4 a = *(const u32x4*)(OAP + off), bq = *(const u32x4*)(OAP + (size_t)NTOK * 512 + off), cq = *(const u32x4*)(OAP + (size_t)2 * NTOK * 512 + off);
        u32x4 o;
#pragma unroll
        for (int e = 0; e < 4; ++e) o[e] = pkbf(w0 * bflo(a[e]) + w1 * bflo(bq[e]) + w2 * bflo(cq[e]), w0 * bfhi(a[e]) + w1 * bfhi(bq[e]) + w2 * bfhi(cq[e]));
        *(u32x4*)(ATT + tok * DM + h * 64 + ch * 8) = o;
    }
}

constexpr int SC_T = 32, SC_VEC = SC_T * 64 * 4, SC_BUF = 6 * SC_VEC + 256;
constexpr int SC_BON = 2 * SC_BUF + 2 * SC_T * 64 * 4;
constexpr int SC_Y = 2 * SC_BUF;
template <int CTRL> __device__ __forceinline__ float dpp_add(float v) {
    const int m = __builtin_amdgcn_update_dpp(0, __float_as_int(v), CTRL, 0xf, 0xf, true);
    return v + __int_as_float(m);
}
#ifdef DBG_SHFL
__device__ __forceinline__ float red8(float v) { v += __shfl_xor(v, 1); v += __shfl_xor(v, 2); v += __shfl_xor(v, 4); return v; }
#else
__device__ __forceinline__ float red8(float v) { v = dpp_add<0xB1>(v); v = dpp_add<0x4E>(v); v = dpp_add<0x141>(v); return v; }
#endif
__device__ __forceinline__ float red16x2(float v0, float v1, bool odd) {
    const float keep = odd ? v1 : v0, send = odd ? v0 : v1;
    float x = keep + __int_as_float(__builtin_amdgcn_update_dpp(0, __float_as_int(send), 0xB1, 0xf, 0xf, true));
    x = dpp_add<0x4E>(x);
    x = dpp_add<0x124>(x);
    x = dpp_add<0x128>(x);
    return x;
}
__device__ __forceinline__ u32x2 ld8_agent(const void* p) {
    const unsigned long long v = __hip_atomic_load((const unsigned long long*)p, __ATOMIC_RELAXED, __HIP_MEMORY_SCOPE_AGENT);
    return __builtin_bit_cast(u32x2, v);
}
__device__ __forceinline__ unsigned short ld2_agent(const unsigned short* p) {
    const unsigned* q = (const unsigned*)((size_t)p & ~(size_t)3);
    const unsigned w = __hip_atomic_load(q, __ATOMIC_RELAXED, __HIP_MEMORY_SCOPE_AGENT);
    return (unsigned short)(((size_t)p & 2) ? (w >> 16) : (w & 0xffffu));
}
__device__ __forceinline__ float wave_sum_dpp(float v) {
    v = dpp_add<0xB1>(v);
    v = dpp_add<0x4E>(v);
    v = dpp_add<0x124>(v);
    v = dpp_add<0x128>(v);
    v += __int_as_float(__builtin_amdgcn_update_dpp(0, __float_as_int(v), 0x142, 0xA, 0xF, false));
    v += __int_as_float(__builtin_amdgcn_update_dpp(0, __float_as_int(v), 0x143, 0xC, 0xF, false));
    return __int_as_float(__builtin_amdgcn_readlane(__float_as_int(v), 63));
}
struct ScanRegs { u32x2 r, k, v, a, w; };
__device__ __forceinline__ float red8x2(float v0, float v1, bool odd) {
    const float keep = odd ? v1 : v0, send = odd ? v0 : v1;
    float x = keep + __int_as_float(__builtin_amdgcn_update_dpp(0, __float_as_int(send), 0xB1, 0xf, 0xf, true));
    x = dpp_add<0x4E>(x);
    int t = __builtin_amdgcn_update_dpp(0, __float_as_int(x), 0x104, 0xf, 0x5, false);
    t = __builtin_amdgcn_update_dpp(t, __float_as_int(x), 0x114, 0xf, 0xA, false);
    return x + __int_as_float(t);
}
__device__ __forceinline__ float dot8(const f32x4& sa, const f32x4& sb, const f32x4& va, const f32x4& vb) {
    f32x2 acc = (f32x2){sa.x, sa.y} * (f32x2){va.x, va.y};
    acc = __builtin_elementwise_fma((f32x2){sa.z, sa.w}, (f32x2){va.z, va.w}, acc);
    acc = __builtin_elementwise_fma((f32x2){sb.x, sb.y}, (f32x2){vb.x, vb.y}, acc);
    acc = __builtin_elementwise_fma((f32x2){sb.z, sb.w}, (f32x2){vb.z, vb.w}, acc);
    asm volatile("" : "+v"(acc));
    return acc.x + acc.y;
}
__device__ __forceinline__ void scan_unit(const bf16* __restrict__ R, const bf16* __restrict__ Kb, const bf16* __restrict__ Vb, const unsigned short* __restrict__ W16, const bf16* __restrict__ Ab,
                                          const bf16* __restrict__ Gb, const float* k_k, const float* k_a, const float* r_k, const float* ln_w, const float* ln_b, bf16* __restrict__ Z,
                                          int b, int h, LAS unsigned char* lds) {
    int tid = threadIdx.x; asm volatile("" : "+v"(tid)); const int lane = tid & 63, wid = __builtin_amdgcn_readfirstlane(tid >> 6);
    const size_t tok0 = (size_t)b * SEQ;
    constexpr int NC = SEQ / SC_T;
    constexpr int SC_YB = SC_T * 64 * 4;
    if (wid >= 4) {
        const int ht = tid - 256, ptt = ht >> 4, pj0 = 4 * (ht & 15), pcol = h * 64 + pj0, hw = wid - 4;
        const f32x4 kk4 = *(const f32x4*)(k_k + pcol), ka4 = *(const f32x4*)(k_a + pcol), rk4 = *(const f32x4*)(r_k + pcol);
        const int col = h * 64 + lane;
        const float lnw = ln_w[col], lnb = ln_b[col];
        ScanRegs pr, pq;
#define S_LOAD1(P, c, TT) do { const size_t o_ = (tok0 + (size_t)(c) * SC_T + (TT)) * DM + pcol; P.r = ld8_agent(R + o_); P.k = ld8_agent(Kb + o_); P.v = ld8_agent(Vb + o_); P.a = ld8_agent(Ab + o_); P.w = ld8_agent(W16 + o_); } while (0)
#define S_PREP1(P, buf, TT, BIDX) do { \
        LAS unsigned char* b_ = lds + (buf) * SC_BUF; \
        const f32x4 r4 = {bflo(P.r[0]), bfhi(P.r[0]), bflo(P.r[1]), bfhi(P.r[1])}; \
        const f32x4 k4 = {bflo(P.k[0]), bfhi(P.k[0]), bflo(P.k[1]), bfhi(P.k[1])}; \
        const f32x4 v4 = {bflo(P.v[0]), bfhi(P.v[0]), bflo(P.v[1]), bfhi(P.v[1])}; \
        const f32x4 a4 = {bflo(P.a[0]), bfhi(P.a[0]), bflo(P.a[1]), bfhi(P.a[1])}; \
        const unsigned wx_ = P.w[0], wy_ = P.w[1]; \
        const pg8::f16x2 wlo_ = __builtin_bit_cast(pg8::f16x2, wx_); const pg8::f16x2 whi_ = __builtin_bit_cast(pg8::f16x2, wy_); \
        const f32x4 w4 = {__expf((float)wlo_.x), __expf((float)wlo_.y), __expf((float)whi_.x), __expf((float)whi_.y)}; \
        f32x4 kk = k4 * kk4; float ss = (kk.x * kk.x + kk.y * kk.y) + (kk.z * kk.z + kk.w * kk.w); \
        ss += __shfl_xor(ss, 1); ss += __shfl_xor(ss, 2); ss += __shfl_xor(ss, 4); ss += __shfl_xor(ss, 8); \
        kk = kk * fminf(__builtin_amdgcn_rsqf(ss), 1e12f); \
        const f32x4 km = k4 * (1.f + (a4 - 1.f) * ka4); \
        float bo = (r4.x * km.x * rk4.x + r4.y * km.y * rk4.y) + (r4.z * km.z * rk4.z + r4.w * km.w * rk4.w); \
        bo += __shfl_xor(bo, 1); bo += __shfl_xor(bo, 2); bo += __shfl_xor(bo, 4); bo += __shfl_xor(bo, 8); \
        const int eo_ = ((TT) * 64 + pj0) * 4; \
        *(LAS f32x4*)(b_ + 0 * SC_VEC + eo_) = r4; *(LAS f32x4*)(b_ + 1 * SC_VEC + eo_) = w4; *(LAS f32x4*)(b_ + 2 * SC_VEC + eo_) = km; \
        *(LAS f32x4*)(b_ + 3 * SC_VEC + eo_) = -kk; *(LAS f32x4*)(b_ + 4 * SC_VEC + eo_) = kk * a4; *(LAS f32x4*)(b_ + 5 * SC_VEC + eo_) = v4; \
        if ((ht & 15) == 0) *(LAS float*)(lds + SC_BON + (BIDX) * 128 + (TT) * 4) = bo; } while (0)
        S_LOAD1(pr, 0, ptt); S_LOAD1(pq, 0, ptt + 16); S_PREP1(pr, 0, ptt, 0); S_PREP1(pq, 0, ptt + 16, 0);
        __syncthreads();
        for (int c = 0; c <= NC; ++c) {
            if (c + 1 < NC) { S_LOAD1(pr, c + 1, ptt); S_LOAD1(pq, c + 1, ptt + 16); }
            if (c >= 1) {
                const int cp = c - 1;
                const LAS float* ybuf = (const LAS float*)(lds + SC_Y + (cp & 1) * SC_YB);
#pragma unroll
                for (int q = 0; q < SC_T / 4; ++q) {
                    const int tt = hw + 4 * q;
                    const float y = ybuf[tt * 64 + lane];
                    const float mean = wave_sum_dpp(y) * (1.f / 64.f); const float dy = y - mean;
                    const float var = wave_sum_dpp(dy * dy) * (1.f / 64.f);
                    const float yn = dy * __builtin_amdgcn_rsqf(var + 64e-5f) * lnw + lnb;
                    const size_t o_ = (tok0 + (size_t)cp * SC_T + tt) * DM + col;
                    const float bo = *(const LAS float*)(lds + SC_BON + (cp % 3) * 128 + tt * 4), vv = bf2f(ld2_agent(Vb + o_));
                    const float gt = bf2f(ld2_agent(Gb + o_));
                    const float outv = (yn + bo * vv) * gt;
                    Z[o_] = (bf16)(pkbf(outv, outv) & 0xffffu);
                }
            }
            if (c + 1 < NC) { const int bi_ = (c + 1) % 3; S_PREP1(pr, (c + 1) & 1, ptt, bi_); S_PREP1(pq, (c + 1) & 1, ptt + 16, bi_); }
            __syncthreads();
        }
#undef S_LOAD1
#undef S_PREP1
    } else {
        const int sq = lane & 7, si0 = 16 * wid + 2 * (lane >> 3), sj = 8 * sq;
        const bool odd = (sq & 1) != 0;
        f32x4 S0a = {0.f, 0.f, 0.f, 0.f}, S0b = S0a, S1a = S0a, S1b = S0a;
        __syncthreads();
        for (int c = 0; c <= NC; ++c) {
            if (c < NC) {
                const LAS unsigned char* bb = lds + (c & 1) * SC_BUF;
                LAS float* ybuf = (LAS float*)(lds + SC_Y + (c & 1) * SC_YB);
                const LAS unsigned char* vp_ = bb + sj * 4;
                const LAS unsigned char* vv_ = bb + 5 * SC_VEC + si0 * 4;
#define LD8(dstA, dstB, slot, TT) dstA = *(const LAS f32x4*)(vp_ + (slot) * SC_VEC + (TT) * 256); dstB = *(const LAS f32x4*)(vp_ + (slot) * SC_VEC + (TT) * 256 + 16)
                f32x4 rA, rB, wA, wB, kA, kB, aA, aB, bA, bB; f32x2 v2;
                LD8(rA, rB, 0, 0); LD8(wA, wB, 1, 0); LD8(kA, kB, 2, 0); LD8(aA, aB, 3, 0); LD8(bA, bB, 4, 0); v2 = *(const LAS f32x2*)(vv_);
#pragma unroll 2
                for (int tt = 0; tt < SC_T; ++tt) {
                    const int tn = (tt + 1) & (SC_T - 1);
                    f32x4 nrA, nrB, nwA, nwB, nkA, nkB, naA, naB, nbA, nbB;
                    LD8(nrA, nrB, 0, tn); LD8(nwA, nwB, 1, tn); LD8(nkA, nkB, 2, tn); LD8(naA, naB, 3, tn); LD8(nbA, nbB, 4, tn);
                    const f32x2 nv2 = *(const LAS f32x2*)(vv_ + tn * 256);
                    const float sx = red8x2(dot8(S0a, S0b, aA, aB), dot8(S1a, S1b, aA, aB), odd);
                    const float sa0 = __int_as_float(__builtin_amdgcn_update_dpp(0, __float_as_int(sx), 0x00, 0xf, 0xf, true));
                    const float sa1 = __int_as_float(__builtin_amdgcn_update_dpp(0, __float_as_int(sx), 0x55, 0xf, 0xf, true));
                    S0a = S0a * wA + (bA * sa0 + kA * v2.x); S0b = S0b * wB + (bB * sa0 + kB * v2.x);
                    S1a = S1a * wA + (bA * sa1 + kA * v2.y); S1b = S1b * wB + (bB * sa1 + kB * v2.y);
                    const float yx = red8x2(dot8(S0a, S0b, rA, rB), dot8(S1a, S1b, rA, rB), odd);
                    if (sq < 2) ybuf[tt * 64 + si0 + sq] = yx;
                    rA = nrA; rB = nrB; wA = nwA; wB = nwB; kA = nkA; kB = nkB; aA = naA; aB = naB; bA = nbA; bB = nbB; v2 = nv2;
                }
#undef LD8
            }
            __syncthreads();
        }
    }
    __syncthreads();
}

#ifdef DBG_CHECK
__device__ __forceinline__ unsigned hsh(unsigned x) { x ^= x >> 16; x *= 0x7feb352dU; x ^= x >> 15; x *= 0x846ca68bU; x ^= x >> 16; return x; }
__device__ __forceinline__ float dotcol(const bf16* arow, const float* W, int N, int c, int K, int lane) {
    float s = 0.f; for (int k = lane; k < K; k += 64) s += bf2f(arow[k]) * W[(size_t)k * N + c]; return wave_sum(s);
}
#define ERR_ACC(ref, fast) do { const float r_ = (ref), f_ = (fast); d2 += (r_ - f_) * (r_ - f_); r2 += r_ * r_; } while (0)
#define ERR_DONE(stage) do { d2 = wave_sum(d2); r2 = wave_sum(r2); if (lane == 0) CTLp[16 + (stage)] = sqrtf(d2 / fmaxf(r2, 1e-30f)); } while (0)
__device__ __forceinline__ void dbg_check(int ph, const Args* Ap, LAS unsigned char* lds, int lane) {
    asm volatile("" : "+s"(Ap)); const Args& A = *Ap; unsigned char* ws = A.ws; float* CTLp = (float*)(ws + WS_CTL);
    const bf16* HN = (const bf16*)(ws + WS_HN); const bf16* QKV = (const bf16*)(ws + WS_QKV); const bf16* ATT = (const bf16*)(ws + WS_ATT); const bf16* U = (const bf16*)(ws + WS_U);
    const bf16* X6 = (const bf16*)(ws + WS_X6); const bf16* TT = (const bf16*)(ws + WS_T); const bf16* RKV = (const bf16*)(ws + WS_RKV); const bf16* WAG = (const bf16*)(ws + WS_WAG); const bf16* Z = (const bf16*)(ws + WS_Z);
    const float* H = A.out; LAS float* sl = (LAS float*)lds;
    float d2 = 0.f, r2 = 0.f;
    if (ph == 1) {
        for (int smp = 0; smp < 48; ++smp) {
            const int t = hsh(smp) & 65535; int c = hsh(smp + 1000) % 3072; if (smp % 3 == 0) c = (c & ~63) | (hsh(smp + 7) & 15);
            const int sec = c / 512, hc = c & 63; const bf16* ar = HN + (size_t)t * DM;
            float v = dotcol(ar, A.attn_w_in, 3072, c, 1024, lane);
            if (sec != 2 && sec != 5 && hc < 16) { const float vp = dotcol(ar, A.attn_w_in, 3072, c ^ 8, 1024, lane); const float ang = (float)(t & 4095) * powf(500000.f, -(float)(hc & 7) / 8.f);
                v = (hc < 8) ? v * cosf(ang) - vp * sinf(ang) : v * cosf(ang) + vp * sinf(ang); }
            if (sec == 0 || sec == 3) v *= 0.125f * 1.4426950408889634f;
            if (lane == 0) ERR_ACC(v, bf2f(QKV[(size_t)t * QKVC + c]));
        }
        ERR_DONE(1);
    }
    if (ph == 2) {
        const float lam = CTLp[0];
        for (int smp = 0; smp < 7; ++smp) {
            int q = 0; if (smp == 1) q = 63; if (smp == 2) q = 64; if (smp == 3) q = 127; if (smp == 4) q = 128; if (smp == 5) q = 1000; if (smp == 6) q = 4095;
            const int b = hsh(smp + 50) & 15, h = hsh(smp + 60) & 3; const size_t tok0 = (size_t)b * SEQ;
            float mc[2], lc[2];
            for (int c = 0; c < 2; ++c) {
                const bf16* qp = QKV + (tok0 + q) * QKVC + 1536 + h * 128 + c * 64; float m = -INFINITY;
                for (int k = lane; k <= q; k += 64) { const bf16* kp = QKV + (tok0 + k) * QKVC + 2048 + h * 128 + c * 64; float s = 0.f; for (int d = 0; d < 64; ++d) s += bf2f(qp[d]) * bf2f(kp[d]); sl[c * 4096 + k] = s; m = fmaxf(m, s); }
#pragma unroll
                for (int o = 1; o < 64; o <<= 1) m = fmaxf(m, __shfl_xor(m, o));
                float l = 0.f; for (int k = lane; k <= q; k += 64) l += exp2f(sl[c * 4096 + k] - m);
                mc[c] = m; lc[c] = wave_sum(l);
            }
            asm volatile("s_waitcnt lgkmcnt(0)" ::: "memory");
            float o0 = 0.f, o1 = 0.f;
            for (int k = 0; k <= q; ++k) { const float a = exp2f(sl[k] - mc[0]) / lc[0] - lam * exp2f(sl[4096 + k] - mc[1]) / lc[1]; const bf16* vp = QKV + (tok0 + k) * QKVC + 2560 + h * 128; o0 += a * bf2f(vp[lane]); o1 += a * bf2f(vp[64 + lane]); }
            const float ss = wave_sum(o0 * o0 + o1 * o1), rs = 0.8f / sqrtf(ss / 128.f + 1e-5f);
            const bf16* ap = ATT + (tok0 + q) * DM + 512 + h * 128;
            ERR_ACC(o0 * rs * A.diff_subln[lane], bf2f(ap[lane])); ERR_ACC(o1 * rs * A.diff_subln[64 + lane], bf2f(ap[64 + lane]));
        }
        ERR_DONE(2);
    }
    if (ph == 3) {
        for (int smp = 0; smp < 10; ++smp) {
            int t = 0; if (smp == 1) t = 1; if (smp == 2) t = 127; if (smp == 3) t = 128; if (smp == 4) t = 129; if (smp == 5) t = 515; if (smp == 6) t = 2047; if (smp == 7) t = 2048; if (smp == 8) t = 4095; if (smp == 9) t = 3001;
            const int b = hsh(smp + 150) & 15, h = hsh(smp + 160) & 7; const size_t tok0 = (size_t)b * SEQ;
            const bf16* qp = QKV + (tok0 + t) * QKVC + h * 64; float m = -INFINITY;
            for (int e = lane; e < 387; e += 64) { const int pat = e / 129, mm = e % 129, dil = (pat == 0) ? 1 : ((pat == 1) ? 4 : 16), pos = t - mm * dil; float s = -INFINITY;
                if (pos >= 0) { const bf16* kp = QKV + (tok0 + pos) * QKVC + 512 + h * 64; s = 0.f; for (int d = 0; d < 64; ++d) s += bf2f(qp[d]) * bf2f(kp[d]); }
                sl[e] = s; m = fmaxf(m, s); }
#pragma unroll
            for (int o = 1; o < 64; o <<= 1) m = fmaxf(m, __shfl_xor(m, o));
            float l = 0.f; for (int e = lane; e < 387; e += 64) l += exp2f(sl[e] - m);
            l = wave_sum(l);
            asm volatile("s_waitcnt lgkmcnt(0)" ::: "memory");
            float o = 0.f;
            for (int e = 0; e < 387; ++e) { const int pat = e / 129, mm = e % 129, dil = (pat == 0) ? 1 : ((pat == 1) ? 4 : 16), pos = t - mm * dil; if (pos >= 0) o += exp2f(sl[e] - m) / l * bf2f(QKV[(tok0 + pos) * QKVC + 1024 + h * 64 + lane]); }
            ERR_ACC(o, bf2f(ATT[(tok0 + t) * DM + h * 64 + lane]));
        }
        ERR_DONE(3);
    }
    if (ph == 4) {
        for (int smp = 0; smp < 32; ++smp) { const int t = hsh(smp + 300) & 65535, c = hsh(smp + 400) & 1023;
            const float v = A.x[(size_t)t * DM + c] + dotcol(ATT + (size_t)t * DM, A.attn_w_out, 1024, c, 1024, lane); if (lane == 0) ERR_ACC(v, H[(size_t)t * DM + c]); }
        ERR_DONE(4);
    }
    if (ph == 6) {
        for (int smp = 0; smp < 32; ++smp) { const int t = hsh(smp + 500) & 65535, c = hsh(smp + 600) & 4095;
            float v = fmaxf(dotcol(HN + (size_t)t * DM, A.mlp_w1, 4096, c, 1024, lane), 0.f); v *= v; if (lane == 0) ERR_ACC(v, bf2f(U[(size_t)t * DFF + c])); }
        ERR_DONE(6);
    }
    if (ph == 8) {
        for (int smp = 0; smp < 12; ++smp) { int t = hsh(smp + 700) & 65535; if (smp == 0) t = 4096; if (smp == 1) t = 4095; if (smp == 2) t = 32; const int slot = smp % 6, mi = (slot == 1) ? 2 : ((slot == 2) ? 3 : ((slot == 3) ? 1 : slot));
            float s0 = 0.f, s1 = 0.f; const bool hp = (t & 4095) != 0;
            for (int k = lane; k < 1024; k += 64) { const float a = H[(size_t)t * DM + k]; s0 += a * a; if (hp) { const float p = H[(size_t)(t - 1) * DM + k]; s1 += p * p; } }
            const float r0 = 1.f / sqrtf(wave_sum(s0) / 1024.f + 1e-5f), r1 = 1.f / sqrtf(wave_sum(s1) / 1024.f + 1e-5f);
            for (int k = lane; k < 1024; k += 64) { const float g = A.norm_mix[DM + k]; const float hn = H[(size_t)t * DM + k] * r0 * g, hpv = hp ? H[(size_t)(t - 1) * DM + k] * r1 * g : 0.f;
                ERR_ACC(hn + (hpv - hn) * A.rwkv_mu[mi * DM + k], bf2f(X6[(size_t)slot * NTOK * DM + (size_t)t * DM + k])); } }
        ERR_DONE(8);
    }
    if (ph == 9) {
        for (int smp = 0; smp < 30; ++smp) { const int t = hsh(smp + 800) & 65535, wh = smp % 3, nn = (wh == 2) ? 160 : 64, c = hsh(smp + 900) % nn;
            const float* W = (wh == 0) ? A.rwkv_w1 : ((wh == 1) ? A.rwkv_a1 : A.rwkv_g1);
            float v = dotcol(X6 + (size_t)(3 + wh) * NTOK * DM + (size_t)t * DM, W, nn, c, 1024, lane); if (wh == 0) v = tanhf(v); if (wh == 2) v = 1.f / (1.f + expf(-v));
            if (lane == 0) ERR_ACC(v, bf2f(TT[(size_t)wh * NTOK * 256 + (size_t)t * 256 + c])); }
        ERR_DONE(9);
    }
    if (ph == 10) {
        for (int smp = 0; smp < 30; ++smp) { const int t = hsh(smp + 1100) & 65535, wh = smp % 3, c = hsh(smp + 1200) & 1023;
            const float* W = (wh == 0) ? A.rwkv_w_r : ((wh == 1) ? A.rwkv_w_k : A.rwkv_w_v);
            const float v = dotcol(X6 + (size_t)wh * NTOK * DM + (size_t)t * DM, W, 1024, c, 1024, lane); if (lane == 0) ERR_ACC(v, bf2f(RKV[(size_t)wh * NTOK * DM + (size_t)t * DM + c])); }
        ERR_DONE(10);
    }
    if (ph == 11) {
        for (int smp = 0; smp < 30; ++smp) { const int t = hsh(smp + 1300) & 65535, wh = smp % 3, kk = (wh == 2) ? 160 : 64, c = hsh(smp + 1400) & 1023;
            const float* W = (wh == 0) ? A.rwkv_w2 : ((wh == 1) ? A.rwkv_a2 : A.rwkv_g2);
            float v = dotcol(TT + (size_t)wh * NTOK * 256 + (size_t)t * 256, W, 1024, c, kk, lane); float f;
            const unsigned short raw = WAG[(size_t)wh * NTOK * DM + (size_t)t * DM + c];
            if (wh == 0) { const float z = A.rwkv_w0[c] + v; const float sp = fmaxf(-z, 0.f) + log1pf(expf(-fabsf(z))); v = -expf(-sp - 0.5f); f = (float)__builtin_bit_cast(_Float16, raw); }
            else if (wh == 1) { v = 1.f / (1.f + expf(-(A.rwkv_a0[c] + v))); f = bf2f(raw); } else f = bf2f(raw);
            if (lane == 0) ERR_ACC(v, f); }
        ERR_DONE(11);
    }
    if (ph == 12) {
        float ed[5] = {0.f, 0.f, 0.f, 0.f, 0.f}, er[5] = {0.f, 0.f, 0.f, 0.f, 0.f};
#pragma unroll
        for (int smp = 0; smp < 3; ++smp) {
            const int b = 0, h = smp; const size_t tok0 = (size_t)b * SEQ; const int col = h * 64 + lane;
            LAS float* sv = sl + 4096;
            for (int i = 0; i < 64; ++i) sl[i * 64 + lane] = 0.f;
            for (int t = 0; t < 40; ++t) {
                const size_t o = (tok0 + t) * DM + col;
                const float r = bf2f(RKV[o]), k = bf2f(RKV[(size_t)NTOK * DM + o]), v = bf2f(RKV[2 * (size_t)NTOK * DM + o]);
                const float w = expf((float)__builtin_bit_cast(_Float16, (unsigned short)WAG[o])), a = bf2f(WAG[(size_t)NTOK * DM + o]);
                float kk = k * A.rwkv_k_k[col]; kk = kk / fmaxf(sqrtf(wave_sum(kk * kk)), 1e-12f);
                const float km = k * (1.f + (a - 1.f) * A.rwkv_k_a[col]);
                float yl = 0.f;
                sv[lane] = v; asm volatile("s_waitcnt lgkmcnt(0)" ::: "memory");
#pragma unroll 1
                for (int i = 0; i < 64; ++i) { float st = sl[i * 64 + lane]; const float sa = wave_sum(st * (-kk)); st = st * w + sa * (kk * a) + sv[i] * km; sl[i * 64 + lane] = st; const float y = wave_sum(st * r); if (lane == i) yl = sa; }
                const float bonus = wave_sum(r * km * A.rwkv_r_k[col]);
                const float f_ = bf2f(Z[o]);
                if (smp == 0) { const float dd = (yl - f_) * (yl - f_), rr = yl * yl; if (t == 1) { ed[0] += 36.f * dd; er[0] += rr; } if (t == 2) { ed[3] += 36.f * dd; er[3] += rr; } if (t < 32) { ed[4] += dd; er[4] += rr; } }
                if (smp == 1) { ed[1] += (1.f - w - f_) * (1.f - w - f_); er[1] += (1.f - w) * (1.f - w); }
                if (smp == 2) { ed[2] += (kk * a - f_) * (kk * a - f_); er[2] += kk * a * kk * a; }
            }
        }
#pragma unroll
        for (int q = 0; q < 5; ++q) { d2 = ed[q]; r2 = er[q]; ERR_DONE(12 + q); }
    }
    if (ph == 13) {
    }
}
#endif
#define AS4 __attribute__((address_space(4)))
__device__ __forceinline__ const unsigned char AS4* kargs() { const unsigned char AS4* p = (const unsigned char AS4*)__builtin_amdgcn_kernarg_segment_ptr(); asm volatile("" : "+s"(p)); return p; }
#define KA(member) (*(decltype(Args::member) const AS4*)(kargs() + offsetof(Args, member)))
#define WSB(off) ((bf16*)(KA(ws) + (off)))
#define P_W_IN WSB(WS_WIN)
#define P_W_OUT WSB(WS_WOUT)
#define P_W1_0 WSB(WS_W1_0)
#define P_W2_0 WSB(WS_W2_0)
#define P_W1_1 WSB(WS_W1_1)
#define P_W2_1 WSB(WS_W2_1)
#define P_WR WSB(WS_WR)
#define P_WK WSB(WS_WK)
#define P_WV WSB(WS_WV)
#define P_WO WSB(WS_WO)
#define P_LW1 WSB(WS_LW1)
#define P_LA1 WSB(WS_LA1)
#define P_LG1 WSB(WS_LG1)
#define P_LW2 WSB(WS_LW2)
#define P_LA2 WSB(WS_LA2)
#define P_LG2 WSB(WS_LG2)
#define P_HN WSB(WS_HN)
#define P_QKV WSB(WS_QKV)
#define P_ATT WSB(WS_ATT)
#define P_OAP WSB(WS_OAP)
#define P_U WSB(WS_U)
#define P_X6 WSB(WS_X6)
#define P_TT WSB(WS_T)
#define P_RKV WSB(WS_RKV)
#define P_WAG WSB(WS_WAG)
#define P_Z WSB(WS_Z)
#define P_ROPE ((float*)(KA(ws) + WS_ROPE))
#define P_CTL ((float*)(KA(ws) + WS_CTL))
#define P_LSE ((float*)(KA(ws) + WS_LSE))
#define P_H (KA(out))
__global__ void __launch_bounds__(NTHR, 2) hybrid_fwd(Args A_unused) {
    extern __shared__ __attribute__((aligned(16))) unsigned char lds_raw[];
    LAS unsigned char* lds = (LAS unsigned char*)lds_raw;
    cg::grid_group grid = cg::this_grid();
    { int t0_ = threadIdx.x; asm volatile("" : "+v"(t0_)); if (t0_ < 2) ((LAS unsigned*)(lds + LDS_BARST))[t0_] = 0u; }
    __syncthreads();
    (void)xcd_barrier_post((unsigned*)(KA(ws) + WS_BAR), (volatile LAS unsigned*)(lds + LDS_BARST));
    const int G = gridDim.x, bx = blockIdx.x, ngw = G * NWAVES, ngt = G * NTHR;
#define TIDV int tid = threadIdx.x; asm volatile("" : "+v"(tid)); const int lane = tid & 63, wave = __builtin_amdgcn_readfirstlane(tid >> 6), gw = bx * NWAVES + wave, gt = bx * NTHR + tid; (void)lane; (void)gw; (void)gt;
    constexpr int lo = 0, hi = 18;
    int ph = 0;
#define PHASE_BEGIN if (ph >= lo && ph < hi) { TIDV
#ifdef DBG_CHECK
#define PHASE_END   } grid.sync(); { int t2_ = threadIdx.x; asm volatile("" : "+v"(t2_)); if (bx == 0 && t2_ < 64) dbg_check(ph, (const Args*)(const void*)__builtin_amdgcn_kernarg_segment_ptr(), lds, t2_); } grid.sync(); ++ph;
#else
#define PHASE_END   if (ph + 1 < hi) { if (ph == 0) grid.sync(); else { XcdBarrier xb_; xb_.bar = (unsigned*)(KA(ws) + WS_BAR); xb_.x = xb_xcc_id(); xb_.st = (volatile LAS unsigned*)(lds + LDS_BARST); xcd_barrier(xb_); } } } ++ph;
#endif
#define GEMM(EPI, Aptr, Bptr, N_, K_, ...) do { pg8::Gemm g_{(const pg8::bf16_t*)(Aptr), (const pg8::bf16_t*)(Bptr), NTOK, (N_), (K_)}; pg8::StaticOrder S_; S_.init(NTOK, (N_), G, bx); \
        EPI E_{__VA_ARGS__}; pg8::gemm_phase<EPI, pg8::StaticOrder, true, true>(lds, g_, S_, E_); } while (0)

    PHASE_BEGIN
    {
        LAS float* scr = (LAS float*)(lds + wave * 8192);
        int it0 = gw;
#define TJOB(W, K_, N_, WT, PITCH) { const int ni_ = ((K_) / 32) * ((N_) / 32); for (; it0 < ni_; it0 += ngw) transpose_item((W), (N_), (WT), (PITCH), scr, it0, lane); it0 -= ni_; }
        TJOB(KA(attn_w_in), 1024, 3072, P_W_IN, 1024)
        TJOB(KA(attn_w_out), 1024, 1024, P_W_OUT, 1024)
        TJOB(KA(mlp_w1), 1024, 4096, P_W1_0, 1024)
        TJOB(KA(mlp_w1) + (size_t)1024 * 4096, 1024, 4096, P_W1_1, 1024)
        TJOB(KA(mlp_w2), 4096, 1024, P_W2_0, 4096)
        TJOB(KA(mlp_w2) + (size_t)4096 * 1024, 4096, 1024, P_W2_1, 4096)
        TJOB(KA(rwkv_w_r), 1024, 1024, P_WR, 1024)
        TJOB(KA(rwkv_w_k), 1024, 1024, P_WK, 1024)
        TJOB(KA(rwkv_w_v), 1024, 1024, P_WV, 1024)
        TJOB(KA(rwkv_w_o), 1024, 1024, P_WO, 1024)
        TJOB(KA(rwkv_w1), 1024, 64, P_LW1, 1024)
        TJOB(KA(rwkv_a1), 1024, 64, P_LA1, 1024)
        TJOB(KA(rwkv_g1), 1024, 160, P_LG1, 1024)
        TJOB(KA(rwkv_w2), 64, 1024, P_LW2, 256)
        TJOB(KA(rwkv_a2), 64, 1024, P_LA2, 256)
        TJOB(KA(rwkv_g2), 160, 1024, P_LG2, 256)
#undef TJOB
        zero_region(P_LW1, 1024, 64, 256, 0, 1024, gt, ngt); zero_region(P_LA1, 1024, 64, 256, 0, 1024, gt, ngt); zero_region(P_LG1, 1024, 160, 256, 0, 1024, gt, ngt);
        zero_region(P_LW2, 256, 0, 1024, 64, 256, gt, ngt); zero_region(P_LA2, 256, 0, 1024, 64, 256, gt, ngt); zero_region(P_LG2, 256, 0, 1024, 160, 256, gt, ngt);
        for (int i = gt; i < 4096 * 8; i += ngt) {
            const int pos = i >> 3, f = i & 7;
            const float invf = (float)exp(-(double)f * 0.125 * log(500000.0));
            const float ang = (float)pos * invf;
            P_ROPE[pos * 16 + f] = (float)cos((double)ang); P_ROPE[pos * 16 + 8 + f] = (float)sin((double)ang);
        }
        if (bx == 0 && wave == 0) {
            const float* lp = KA(diff_lambda);
            const float s01 = wave_sum(lp[lane] * lp[64 + lane]), s23 = wave_sum(lp[128 + lane] * lp[192 + lane]);
            if (lane == 0) P_CTL[0] = expf(s01) - expf(s23) + 0.2f;
        }
        rms_phase_bf16(KA(x), KA(norm_mix), P_HN, gw, ngw, lane);
    }
    PHASE_END
    PHASE_BEGIN
    GEMM(pg8::Epi16<pg8::M_QKV>, P_HN, P_W_IN, QKVC, 1024, P_QKV, QKVC, P_ROPE);
    PHASE_END
    PHASE_BEGIN
    {
        const float lam = P_CTL[0];
        for (int rep_ = 0; rep_ < REP_ATTN; ++rep_)
        for (int u = bx; u < 2048; u += G) {
            const int i = u >> 8, cidx = u & 255, bh = cidx >> 2, s = (cidx & 3) * 4 + (i >> 1), qb = (i & 1) ? 31 - s : s;
            diffattn_unit(P_QKV, P_ATT, KA(diff_subln), lam, bh >> 2, bh & 3, qb, lds);
        }
        for (int rep_ = 0; rep_ < REP_ATTNA; ++rep_)
        for (int v = bx; v < 6144; v += G) {
            const int bh = v / 48, r48 = v - bh * 48, pat = r48 >> 4, q16 = r48 & 15;
            const int dil = (pat == 0) ? 1 : ((pat == 1) ? 4 : 16);
            const int nper = 16 / dil;
            const int res = q16 / nper, n = q16 - res * nper;
            dilattn_unit(P_QKV, P_OAP, P_LSE, bh >> 3, bh & 7, dil, res, n, lds);
        }
    }
    PHASE_END
    PHASE_BEGIN
    combine_phase(P_OAP, P_LSE, P_ATT, gt, ngt);
    PHASE_END
    PHASE_BEGIN
    GEMM(pg8::EpiRes, P_ATT, P_W_OUT, 1024, 1024, KA(x), P_H, DM);
    PHASE_END
    PHASE_BEGIN
    for (int rep_ = 0; rep_ < REP_RMS; ++rep_)
    rms_phase_bf16(P_H, KA(norm_mlp), P_HN, gw, ngw, lane);
    PHASE_END
    PHASE_BEGIN
    for (int rep_ = 0; rep_ < REP_UP; ++rep_)
    GEMM(pg8::Epi16<pg8::M_RELU2>, P_HN, P_W1_0, DFF, 1024, P_U, DFF, nullptr);
    PHASE_END
    PHASE_BEGIN
    GEMM(pg8::EpiRes, P_U, P_W2_0, 1024, DFF, P_H, P_H, DM);
    PHASE_END
    PHASE_BEGIN
    for (int rep_ = 0; rep_ < REP_XMIX; ++rep_)
    xmix_phase(P_H, KA(norm_mix) + DM, KA(rwkv_mu), P_X6, gw, ngw, lane);
    PHASE_END
    PHASE_BEGIN
    for (int rep_ = 0; rep_ < REP_LORA; ++rep_) {
    GEMM(pg8::Epi16<pg8::M_TANH>, P_X6 + 3 * (size_t)NTOK * DM, P_LW1, 256, 1024, P_TT, 256, nullptr);
    GEMM(pg8::Epi16<pg8::M_PLAIN>, P_X6 + 4 * (size_t)NTOK * DM, P_LA1, 256, 1024, P_TT + (size_t)NTOK * 256, 256, nullptr);
    GEMM(pg8::Epi16<pg8::M_SIGMOID>, P_X6 + 5 * (size_t)NTOK * DM, P_LG1, 256, 1024, P_TT + (size_t)2 * NTOK * 256, 256, nullptr); }
    PHASE_END
    PHASE_BEGIN
    GEMM(pg8::Epi16<pg8::M_PLAIN>, P_X6, P_WR, 1024, 1024, P_RKV, DM, nullptr);
    GEMM(pg8::Epi16<pg8::M_PLAIN>, P_X6 + (size_t)NTOK * DM, P_WK, 1024, 1024, P_RKV + (size_t)NTOK * DM, DM, nullptr);
    GEMM(pg8::Epi16<pg8::M_PLAIN>, P_X6 + 2 * (size_t)NTOK * DM, P_WV, 1024, 1024, P_RKV + 2 * (size_t)NTOK * DM, DM, nullptr);
    PHASE_END
    PHASE_BEGIN
    for (int rep_ = 0; rep_ < REP_LORA; ++rep_) {
    GEMM(pg8::Epi16<pg8::M_WLOG>, P_TT, P_LW2, 1024, 256, P_WAG, DM, KA(rwkv_w0));
    GEMM(pg8::Epi16<pg8::M_ASIG>, P_TT + (size_t)NTOK * 256, P_LA2, 1024, 256, P_WAG + (size_t)NTOK * DM, DM, KA(rwkv_a0));
    GEMM(pg8::Epi16<pg8::M_PLAIN>, P_TT + (size_t)2 * NTOK * 256, P_LG2, 1024, 256, P_WAG + 2 * (size_t)NTOK * DM, DM, nullptr); }
    PHASE_END
    PHASE_BEGIN
    for (int rep_ = 0; rep_ < REP_SCAN; ++rep_)
    for (int u = bx; u < 256; u += G)
        scan_unit(P_RKV, P_RKV + (size_t)NTOK * DM, P_RKV + 2 * (size_t)NTOK * DM, (const unsigned short*)P_WAG, P_WAG + (size_t)NTOK * DM, P_WAG + 2 * (size_t)NTOK * DM,
                  KA(rwkv_k_k), KA(rwkv_k_a), KA(rwkv_r_k), KA(rwkv_ln_w), KA(rwkv_ln_b), P_Z, u >> 4, u & 15, lds);
    PHASE_END
    PHASE_BEGIN
    GEMM(pg8::EpiRes, P_Z, P_WO, 1024, 1024, P_H, P_H, DM);
    PHASE_END
    PHASE_BEGIN
    rms_phase_bf16(P_H, KA(norm_mlp) + DM, P_HN, gw, ngw, lane);
    PHASE_END
    PHASE_BEGIN
    GEMM(pg8::Epi16<pg8::M_RELU2>, P_HN, P_W1_1, DFF, 1024, P_U, DFF, nullptr);
    PHASE_END
    PHASE_BEGIN
    GEMM(pg8::EpiRes, P_U, P_W2_1, 1024, DFF, P_H, P_H, DM);
    PHASE_END
    PHASE_BEGIN
    rms_phase_f32(P_H, KA(norm_final), P_H, gw, ngw, lane);
    PHASE_END
#ifdef DBG_CHECK
    { TIDV
      const float* CTLp = P_CTL; int bad = 0; float ev = 0.f;
      for (int k = 1; k < 20; ++k) { const float e = CTLp[16 + k]; if (bad == 0 && !(e < 0.03f)) { bad = k; ev = (e == e) ? e : 9.99f; } }
      if (bad) { float* o = P_H; const float c = sqrtf(10.f * (float)bad); for (size_t i = gt; i < (size_t)NTOK * DM; i += ngt) o[i] = c; if (gt == 0) o[0] = 1000.f * ev; } }
#endif
}
constexpr int N_PHASES = 18;

extern "C" void kernel_launch(void* const* d_in, const int* in_sizes, int n_in, void* d_out, int out_size, void* d_ws, size_t ws_size, hipStream_t stream) {
    static int grid = 0;
    if (grid == 0) {
        if (n_in != 28 || in_sizes[0] != NTOK * DM || out_size != NTOK * DM || ws_size < WS_END) { fprintf(stderr, "kernel_launch: unexpected shapes (n_in %d, ws %zu)\n", n_in, ws_size); grid = -1; return; }
        int dev = 0, cus = 0, per_cu = 0;
        hipGetDevice(&dev); hipDeviceGetAttribute(&cus, hipDeviceAttributeMultiprocessorCount, dev);
        if (hipFuncSetAttribute((const void*)hybrid_fwd, hipFuncAttributeMaxDynamicSharedMemorySize, LDS_BYTES) != hipSuccess) { fprintf(stderr, "kernel_launch: hipFuncSetAttribute failed\n"); grid = -1; return; }
        hipOccupancyMaxActiveBlocksPerMultiprocessor(&per_cu, (const void*)hybrid_fwd, NTHR, LDS_BYTES);
        (void)hipGetLastError();
        if (per_cu < 1) per_cu = 1;
        grid = cus * per_cu;
        fprintf(stderr, "kernel_launch: %d CUs x %d -> grid %d\n", cus, per_cu, grid);
    }
    if (grid < 0) return;
    if (hipMemsetAsync(d_ws, 0, CTL_ZERO_BYTES, stream) != hipSuccess) { fprintf(stderr, "kernel_launch: hipMemsetAsync failed\n"); return; }
    Args a{};
    const float** fp = (const float**)&a;
    for (int i = 0; i < 28; ++i) fp[i] = (const float*)d_in[i];
    a.out = (float*)d_out; a.ws = (unsigned char*)d_ws; a.ph_lo = 0; a.ph_hi = N_PHASES;
    void* args[] = {&a};
    hipError_t e = hipLaunchCooperativeKernel((const void*)hybrid_fwd, dim3(grid), dim3(NTHR), args, LDS_BYTES, stream);
    if (e != hipSuccess) fprintf(stderr, "cooperative launch failed: %s (grid %d)\n", hipGetErrorString(e), grid);
}
```

```cpp
#include <hip/hip_runtime.h>
#include <hip/hip_cooperative_groups.h>
#include <cstdio>
#include <cstdint>
namespace cg = cooperative_groups;
namespace pg8 {
#define PG8_LAS __attribute__((address_space(3)))
typedef unsigned short bf16_t;
typedef short bf16x8 __attribute__((ext_vector_type(8)));
typedef float f32x4 __attribute__((ext_vector_type(4)));
typedef unsigned u32x4 __attribute__((ext_vector_type(4)));
constexpr int BM = 256, BK = 64, HALF = 128, HTB = HALF * BK * 2  , STAGE_BYTES = 8 * HTB, NXCD = 8, WGM = 8;

__host__ __device__ __forceinline__ int lds_byte(int r, int c) { const int st = (r >> 4) * 2 + (c >> 5), rr = r & 15, cc = c & 31, ob = rr * 64 + cc * 2; return st * 1024 + (ob ^ (((ob >> 9) & 1) << 5)); }
__host__ __device__ __forceinline__ void stage_rc(int b, int& R, int& C) { const int st = b / 1024, sb = b % 1024, swz = sb ^ (((sb >> 9) & 1) << 5); R = (st >> 1) * 16 + swz / 64; C = (st & 1) * 32 + (swz % 64) / 2; }
__host__ __device__ __forceinline__ int perm32(int rho) { const int n = rho >> 4, i = rho & 15; return 8 * (i >> 2) + 4 * n + (i & 3); }

struct Unit { int pm, pn; };
struct Gemm { const bf16_t* A; const bf16_t* Bt; int M, N, K; };

struct StaticOrder {
    int nM, nN, nwg, G, c;
    __host__ __device__ void init(int M, int N, int G_, int c_) { nM = M / BM; nN = N / BM; nwg = nM * nN; G = G_; c = c_; }
    __host__ __device__ bool next(int i, Unit& u) const {
        const long L = (long)i * G + c; if (L >= nwg) return false;
        int wgid = (int)L; { const int q = nwg / NXCD, r = nwg % NXCD, xcd = wgid % NXCD, off = wgid / NXCD; wgid = (xcd < r ? xcd * (q + 1) : r * (q + 1) + (xcd - r) * q) + off; }
        const int nig = WGM * nN, gid = wgid / nig, fm = gid * WGM, gsz = (nM - fm) < WGM ? (nM - fm) : WGM;
        u.pm = fm + ((wgid % nig) % gsz); u.pn = (wgid % nig) / gsz; return true;
    }
    __device__ __forceinline__ void a_ready(const Unit&) const {}
    __device__ __forceinline__ void done(const Unit&) const {}
};

__device__ __forceinline__ unsigned cvt_pk_bf16(float lo, float hi) { unsigned r; asm volatile("v_cvt_pk_bf16_f32 %0, %1, %2" : "=v"(r) : "v"(lo), "v"(hi)); return r; }
typedef float f32x2 __attribute__((ext_vector_type(2)));
typedef unsigned u32x4 __attribute__((ext_vector_type(4)));
typedef _Float16 f16x2 __attribute__((ext_vector_type(2)));
__device__ __forceinline__ unsigned cvt_pk_f16(float lo, float hi) { f32x2 v = {lo, hi}; f16x2 h = __builtin_convertvector(v, f16x2); return __builtin_bit_cast(unsigned, h); }
enum { M_PLAIN = 0, M_RELU2 = 1, M_TANH = 2, M_SIGMOID = 3, M_QKV = 4, M_ASIG = 5, M_WLOG = 6 };
template <int MODE> struct Epi16 {
    static constexpr bool PERM = true, AFTER_DRAIN = false;
    bf16_t* O; int ldc; const float* vec;
    __device__ __forceinline__ void operator()(const f32x4 (&acc)[2][2][4][2], const Unit& u, int wr, int wc, int fr, int fq) const {
        const int row0 = u.pm * BM + wr * 64 + fr;
        const int col0 = u.pn * BM + wc * 32 + 8 * fq;
        const int sec = u.pn >> 1;
        const bool rope = (MODE == M_QKV) && (sec != 2) && (sec != 5);
        const bool rot_wave = rope && ((wc & 1) == 0);
        const float qs = (MODE == M_QKV && (sec == 0 || sec == 3)) ? (0.125f * 1.4426950408889634f) : 1.0f;
        f32x4 bias_[2][2];
        if (MODE == M_ASIG || MODE == M_WLOG) {
#pragma unroll
            for (int bj = 0; bj < 2; ++bj) { bias_[bj][0] = *(const f32x4*)(vec + col0 + bj * HALF); bias_[bj][1] = *(const f32x4*)(vec + col0 + bj * HALF + 4); }
        }
#pragma unroll
        for (int ai = 0; ai < 2; ++ai) {
            f32x4 tab[4][4];
            if (MODE == M_QKV) { if (rot_wave) {
#pragma unroll
                for (int m = 0; m < 4; ++m) { const float* t = vec + (size_t)((row0 + ai * HALF + m * 16) & 4095) * 16;
#pragma unroll
                    for (int q = 0; q < 4; ++q) tab[m][q] = *(const f32x4*)(t + 4 * q); } } }
#pragma unroll
            for (int m = 0; m < 4; ++m) {
                const int row = row0 + ai * HALF + m * 16;
                bf16_t* rowp = O + (size_t)row * ldc + col0;
                f32x4 cs0 = {1.f, 1.f, 1.f, 1.f}, cs1 = cs0, sn0 = {0.f, 0.f, 0.f, 0.f}, sn1 = sn0;
                if (MODE == M_QKV) { if (rot_wave) { cs0 = tab[m][0]; cs1 = tab[m][1]; sn0 = tab[m][2]; sn1 = tab[m][3]; } }
#pragma unroll
                for (int bj = 0; bj < 2; ++bj) {
                    f32x4 v0 = acc[ai][bj][m][0], v1 = acc[ai][bj][m][1];
                    if (MODE == M_QKV) {
                        if (rot_wave) {
                            f32x4 p0, p1;
#pragma unroll
                            for (int e = 0; e < 4; ++e) {
                                const unsigned b0_ = __float_as_uint(v0[e]), b1_ = __float_as_uint(v1[e]);
                                auto r0_ = __builtin_amdgcn_permlane16_swap(b0_, b0_, false, false); auto r1_ = __builtin_amdgcn_permlane16_swap(b1_, b1_, false, false);
                                p0[e] = __uint_as_float((fq & 1) ? r0_[0] : r0_[1]); p1[e] = __uint_as_float((fq & 1) ? r1_[0] : r1_[1]);
                            }
                            if (fq < 2) { const float sg = (fq == 0) ? -1.f : 1.f; v0 = v0 * cs0 + (p0 * sn0) * sg; v1 = v1 * cs1 + (p1 * sn1) * sg; }
                        }
                        v0 = v0 * qs; v1 = v1 * qs;
                    }
                    if (MODE == M_RELU2) {
#pragma unroll
                        for (int e = 0; e < 4; ++e) { const float a = fmaxf(v0[e], 0.f), b = fmaxf(v1[e], 0.f); v0[e] = a * a; v1[e] = b * b; }
                    }
                    if (MODE == M_TANH) {
#pragma unroll
                        for (int e = 0; e < 4; ++e) { v0[e] = 1.f - 2.f * __builtin_amdgcn_rcpf(1.f + __builtin_amdgcn_exp2f(fminf(v0[e] * 2.885390081777927f, 60.f))); v1[e] = 1.f - 2.f * __builtin_amdgcn_rcpf(1.f + __builtin_amdgcn_exp2f(fminf(v1[e] * 2.885390081777927f, 60.f))); }
                    }
                    if (MODE == M_SIGMOID) {
#pragma unroll
                        for (int e = 0; e < 4; ++e) { v0[e] = 1.f / (1.f + __expf(-v0[e])); v1[e] = 1.f / (1.f + __expf(-v1[e])); }
                    }
                    if (MODE == M_ASIG) {
                        const f32x4 b0 = bias_[bj][0], b1 = bias_[bj][1];
#pragma unroll
                        for (int e = 0; e < 4; ++e) { v0[e] = 1.f / (1.f + __expf(-(v0[e] + b0[e]))); v1[e] = 1.f / (1.f + __expf(-(v1[e] + b1[e]))); }
                    }
                    u32x4 w;
                    if (MODE == M_WLOG) {
                        const f32x4 b0 = bias_[bj][0], b1 = bias_[bj][1];
#pragma unroll
                        for (int e = 0; e < 4; ++e) {
                            const float x0 = -(v0[e] + b0[e]), x1 = -(v1[e] + b1[e]);
                            const float s0 = fmaxf(x0, 0.f) + 0.6931471805599453f * __builtin_amdgcn_logf(1.f + __builtin_amdgcn_exp2f(-1.4426950408889634f * fabsf(x0)));
                            const float s1 = fmaxf(x1, 0.f) + 0.6931471805599453f * __builtin_amdgcn_logf(1.f + __builtin_amdgcn_exp2f(-1.4426950408889634f * fabsf(x1)));
                            v0[e] = -__builtin_amdgcn_exp2f(-1.4426950408889634f * (s0 + 0.5f)); v1[e] = -__builtin_amdgcn_exp2f(-1.4426950408889634f * (s1 + 0.5f));
                        }
                        w.x = cvt_pk_f16(v0[0], v0[1]); w.y = cvt_pk_f16(v0[2], v0[3]); w.z = cvt_pk_f16(v1[0], v1[1]); w.w = cvt_pk_f16(v1[2], v1[3]);
                    } else {
                        w.x = cvt_pk_bf16(v0[0], v0[1]); w.y = cvt_pk_bf16(v0[2], v0[3]); w.z = cvt_pk_bf16(v1[0], v1[1]); w.w = cvt_pk_bf16(v1[2], v1[3]);
                    }
                    *(u32x4*)(rowp + bj * HALF) = w;
                }
            }
        }
    }
};
struct EpiRes {
    static constexpr bool PERM = false, AFTER_DRAIN = false;
    const float* res; float* out; int ldc;
    __device__ __forceinline__ void operator()(const f32x4 (&acc)[2][2][4][2], const Unit& u, int wr, int wc, int fr, int fq) const {
        const int row0 = u.pm * BM + wr * 64 + fr, col0 = u.pn * BM + wc * 32 + 4 * fq;
#pragma unroll
        for (int ai = 0; ai < 2; ++ai)
#pragma unroll
            for (int m = 0; m < 4; ++m) {
                const size_t off = (size_t)(row0 + ai * HALF + m * 16) * ldc + col0;
#pragma unroll
                for (int bj = 0; bj < 2; ++bj)
#pragma unroll
                    for (int n = 0; n < 2; ++n) { const f32x4 r = *(const f32x4*)(res + off + bj * HALF + n * 16); *(f32x4*)(out + off + bj * HALF + n * 16) = r + acc[ai][bj][m][n]; }
            }
    }
};
template <class Epi, class Sched, bool ALIGN_EPI = false, bool SP2 = false>
__device__ __forceinline__ void gemm_phase(PG8_LAS unsigned char* lds, const Gemm g, const Sched& S, const Epi& E) {
    int tid = threadIdx.x; asm volatile("" : "+v"(tid)); const int wid = __builtin_amdgcn_readfirstlane(tid >> 6), lane = tid & 63, wr = wid >> 2, wc = wid & 3, fr = lane & 15, fq = lane >> 4;
    const int K = g.K, nt = K / BK;
    unsigned voffA[2], voffB[2];
#pragma unroll
    for (int i = 0; i < 2; ++i) { int R, C; stage_rc(tid * 16 + i * 8192, R, C); const int Rb = Epi::PERM ? ((R & ~31) + perm32(R & 31)) : R;
        voffA[i] = (unsigned)(R * K + C) * 2u; voffB[i] = (unsigned)(Rb * K + C) * 2u; }
    const size_t kstep = (size_t)(BK * 2);
    const size_t hstep = (size_t)HALF * K * 2;
    const size_t tstep = 2 * hstep;
    const unsigned ldsw = (unsigned)wid * 1024u;
    const int aoff = lds_byte(wr * 64 + fr, fq * 8), boff = lds_byte(wc * 32 + fr, fq * 8);
#define PG8_SA(b, h) (((b) * 2 + (h)) * HTB)
#define PG8_SB(b, h) ((4 + (b) * 2 + (h)) * HTB)
#define PG8_STAGE(bufoff, gbase, voff) do { _Pragma("unroll") for (int _i = 0; _i < 2; ++_i) \
        __builtin_amdgcn_global_load_lds((const unsigned*)((const char*)(gbase) + (voff)[_i]), (PG8_LAS unsigned*)(lds + (bufoff) + ldsw + _i * 8192), 16, 0, 0); } while (0)
#define PG8_LDA(dst, b, h) do { _Pragma("unroll") for (int m = 0; m < 4; ++m) _Pragma("unroll") for (int k = 0; k < 2; ++k) dst[m][k] = *(const PG8_LAS bf16x8*)(lds + PG8_SA(b, h) + aoff + m * 2048 + k * 1024); } while (0)
#define PG8_LDB(dst, b, h) do { _Pragma("unroll") for (int n = 0; n < 2; ++n) _Pragma("unroll") for (int k = 0; k < 2; ++k) dst[n][k] = *(const PG8_LAS bf16x8*)(lds + PG8_SB(b, h) + boff + n * 2048 + k * 1024); } while (0)
#define PG8_MMA(ai, bj, At, Bt) do { __builtin_amdgcn_s_setprio(1); _Pragma("unroll") for (int m = 0; m < 4; ++m) _Pragma("unroll") for (int n = 0; n < 2; ++n) _Pragma("unroll") for (int k = 0; k < 2; ++k) \
        acc[ai][bj][m][n] = __builtin_amdgcn_mfma_f32_16x16x32_bf16(Bt[n][k], At[m][k], acc[ai][bj][m][n], 0, 0, 0); __builtin_amdgcn_s_setprio(0); } while (0)
#define PG8_WAIT_V(n) asm volatile("s_waitcnt vmcnt(" #n ")" ::: "memory")
#define PG8_WAIT_L(n) asm volatile("s_waitcnt lgkmcnt(" #n ")" ::: "memory")
#define PG8_BAR __builtin_amdgcn_s_barrier()
#define PG8_SCHED __builtin_amdgcn_sched_barrier(0)
    Unit cur, nxt; int ui = 0;
    if (!S.next(0, cur)) return;
    f32x4 acc[2][2][4][2];
#pragma unroll
    for (int a = 0; a < 2; ++a)
#pragma unroll
        for (int b = 0; b < 2; ++b)
#pragma unroll
            for (int m = 0; m < 4; ++m)
#pragma unroll
                for (int n = 0; n < 2; ++n) acc[a][b][m][n] = (f32x4){0.f, 0.f, 0.f, 0.f};
    bf16x8 At[4][2], B0[2][2], B1[2][2];
    const char* cA = (const char*)g.A + (size_t)cur.pm * tstep; const char* cB = (const char*)g.Bt + (size_t)cur.pn * tstep;
    S.a_ready(cur);
    if constexpr (SP2) {
        PG8_STAGE(PG8_SB(0, 0), cB, voffB); PG8_STAGE(PG8_SB(0, 1), cB + hstep, voffB); PG8_STAGE(PG8_SA(0, 0), cA, voffA); PG8_STAGE(PG8_SA(0, 1), cA + hstep, voffA);
        if (wr == 1) PG8_BAR;
        PG8_WAIT_V(2); PG8_BAR;
        PG8_STAGE(PG8_SB(1, 0), cB + kstep, voffB); PG8_STAGE(PG8_SA(1, 0), cA + kstep, voffA); PG8_STAGE(PG8_SB(1, 1), cB + hstep + kstep, voffB);
        PG8_WAIT_V(6); PG8_BAR;
    } else {
        PG8_STAGE(PG8_SB(0, 0), cB, voffB); PG8_STAGE(PG8_SA(0, 0), cA, voffA); PG8_STAGE(PG8_SB(0, 1), cB + hstep, voffB); PG8_STAGE(PG8_SA(0, 1), cA + hstep, voffA);
        if (wr == 1) PG8_BAR;
        PG8_WAIT_V(4); PG8_BAR;
        PG8_STAGE(PG8_SB(1, 0), cB + kstep, voffB); PG8_STAGE(PG8_SA(1, 0), cA + kstep, voffA); PG8_STAGE(PG8_SB(1, 1), cB + hstep + kstep, voffB);
        PG8_WAIT_V(6); PG8_BAR;
    }
    for (;;) {
        const bool has_next = S.next(ui + 1, nxt);
        const char* nA = has_next ? (const char*)g.A + (size_t)nxt.pm * tstep : cA; const char* nB = has_next ? (const char*)g.Bt + (size_t)nxt.pn * tstep : cB;
        for (int t = 0; t < nt; t += 2) {
            const bool last = (t == nt - 2);
            const char* a1 = cA + (size_t)(t + 1) * kstep;
            const char* a2 = last ? nA : cA + (size_t)(t + 2) * kstep; const char* b2 = last ? nB : cB + (size_t)(t + 2) * kstep;
            const char* a3 = a2 + kstep; const char* b3 = b2 + kstep;
            if (last && has_next) S.a_ready(nxt);
            if constexpr (SP2) {
            PG8_LDB(B0, 0, 0); PG8_LDB(B1, 0, 1); PG8_SCHED; PG8_LDA(At, 0, 0); PG8_STAGE(PG8_SA(1, 1), a1 + hstep, voffA);
            PG8_WAIT_V(8); PG8_WAIT_L(0); PG8_BAR; PG8_MMA(0, 0, At, B0); PG8_MMA(0, 1, At, B1); PG8_BAR; PG8_SCHED;
            PG8_LDA(At, 0, 1); PG8_STAGE(PG8_SB(0, 0), b2, voffB); PG8_STAGE(PG8_SB(0, 1), b2 + hstep, voffB); PG8_STAGE(PG8_SA(0, 0), a2, voffA);
            PG8_WAIT_V(8); PG8_WAIT_L(0); PG8_BAR; PG8_MMA(1, 0, At, B0); PG8_MMA(1, 1, At, B1); PG8_BAR; PG8_SCHED;
            PG8_LDB(B0, 1, 0); PG8_LDB(B1, 1, 1); PG8_SCHED; PG8_LDA(At, 1, 0); PG8_STAGE(PG8_SA(0, 1), a2 + hstep, voffA);
            PG8_WAIT_V(8); PG8_WAIT_L(0); PG8_BAR; PG8_MMA(0, 0, At, B0); PG8_MMA(0, 1, At, B1); PG8_BAR; PG8_SCHED;
            PG8_LDA(At, 1, 1); PG8_STAGE(PG8_SB(1, 0), b3, voffB); PG8_STAGE(PG8_SB(1, 1), b3 + hstep, voffB); PG8_STAGE(PG8_SA(1, 0), a3, voffA);
            PG8_WAIT_V(8); PG8_WAIT_L(0); PG8_BAR; PG8_MMA(1, 0, At, B0); PG8_MMA(1, 1, At, B1); PG8_BAR; PG8_SCHED;
            } else {
            PG8_LDB(B0, 0, 0); PG8_SCHED; PG8_LDA(At, 0, 0); PG8_STAGE(PG8_SA(1, 1), a1 + hstep, voffA);
            PG8_WAIT_L(8); PG8_BAR; PG8_WAIT_L(0); PG8_MMA(0, 0, At, B0); PG8_BAR; PG8_SCHED;
            PG8_LDB(B1, 0, 1); PG8_STAGE(PG8_SB(0, 0), b2, voffB);
            PG8_BAR; PG8_WAIT_L(0); PG8_MMA(0, 1, At, B1); PG8_BAR;
            PG8_LDA(At, 0, 1); PG8_STAGE(PG8_SA(0, 0), a2, voffA);
            PG8_BAR; PG8_WAIT_L(0); PG8_MMA(1, 0, At, B0); PG8_BAR; PG8_SCHED;
            PG8_STAGE(PG8_SB(0, 1), b2 + hstep, voffB);
            PG8_WAIT_V(6); PG8_BAR; PG8_MMA(1, 1, At, B1); PG8_BAR;
            PG8_LDB(B0, 1, 0); PG8_SCHED; PG8_LDA(At, 1, 0); PG8_STAGE(PG8_SA(0, 1), a2 + hstep, voffA);
            PG8_WAIT_L(8); PG8_BAR; PG8_WAIT_L(0); PG8_MMA(0, 0, At, B0); PG8_BAR; PG8_SCHED;
            PG8_LDB(B1, 1, 1); PG8_STAGE(PG8_SB(1, 0), b3, voffB);
            PG8_BAR; PG8_WAIT_L(0); PG8_MMA(0, 1, At, B1); PG8_BAR;
            PG8_LDA(At, 1, 1); PG8_STAGE(PG8_SA(1, 0), a3, voffA);
            PG8_BAR; PG8_WAIT_L(0); PG8_MMA(1, 0, At, B0); PG8_BAR; PG8_SCHED;
            PG8_STAGE(PG8_SB(1, 1), b3 + hstep, voffB);
            PG8_WAIT_V(6); PG8_BAR; PG8_MMA(1, 1, At, B1); PG8_BAR;
            }
        }
        if constexpr (ALIGN_EPI) { if (wr == 0) PG8_BAR; }
        if constexpr (!Epi::AFTER_DRAIN) { E(acc, cur, wr, wc, fr, fq); S.done(cur); }
        if (!has_next) break;
#pragma unroll
        for (int a = 0; a < 2; ++a)
#pragma unroll
            for (int b = 0; b < 2; ++b)
#pragma unroll
                for (int m = 0; m < 4; ++m)
#pragma unroll
                    for (int n = 0; n < 2; ++n) acc[a][b][m][n] = (f32x4){0.f, 0.f, 0.f, 0.f};
        cur = nxt; cA = nA; cB = nB; ++ui;
        if constexpr (ALIGN_EPI) { if (wr == 1) PG8_BAR; }
    }
    PG8_WAIT_V(0);
    if constexpr (!ALIGN_EPI) { if (wr == 0) PG8_BAR; }
    PG8_BAR;
    if constexpr (Epi::AFTER_DRAIN) { E.fused(acc, cur, wr, wc, fr, fq, lds, wid, lane); S.done(cur); }
#undef PG8_SA
#undef PG8_SB
#undef PG8_STAGE
#undef PG8_LDA
#undef PG8_LDB
#undef PG8_MMA
#undef PG8_WAIT_V
#undef PG8_WAIT_L
#undef PG8_BAR
#undef PG8_SCHED
}
}
#define LAS __attribute__((address_space(3)))
typedef unsigned short bf16;
typedef float f32x4 __attribute__((ext_vector_type(4)));
typedef float f32x2 __attribute__((ext_vector_type(2)));
typedef float f32x16 __attribute__((ext_vector_type(16)));
typedef short bf16x8 __attribute__((ext_vector_type(8)));
typedef short s16x4 __attribute__((ext_vector_type(4)));
typedef unsigned u32x4 __attribute__((ext_vector_type(4)));
typedef unsigned u32x2 __attribute__((ext_vector_type(2)));

#ifndef REP_LORA
#define REP_LORA 1
#endif
#ifndef REP_UP
#define REP_UP 1
#endif
#ifndef REP_RMS
#define REP_RMS 1
#endif
#ifndef REP_XMIX
#define REP_XMIX 1
#endif
#ifndef REP_ATTN
#define REP_ATTN 1
#endif
#ifndef REP_ATTNA
#define REP_ATTNA 1
#endif
#ifndef REP_SCAN
#define REP_SCAN 1
#endif
constexpr int NWAVES = 8, NTHR = 512;
constexpr int NTOK = 65536, DM = 1024, SEQ = 4096, NBATCH = 16, DFF = 4096, QKVC = 3072;
constexpr size_t MiB = (size_t)1 << 20;
constexpr size_t WS_CTL = 0;
constexpr size_t WS_WIN = 1 * MiB, WS_WOUT = 7 * MiB, WS_W1_0 = 9 * MiB, WS_W2_0 = 17 * MiB, WS_W1_1 = 25 * MiB, WS_W2_1 = 33 * MiB;
constexpr size_t WS_WR = 41 * MiB, WS_WK = 43 * MiB, WS_WV = 45 * MiB, WS_WO = 47 * MiB;
constexpr size_t WS_LW1 = 49 * MiB, WS_LA1 = WS_LW1 + 512 * 1024, WS_LG1 = 50 * MiB, WS_LW2 = WS_LG1 + 512 * 1024, WS_LA2 = 51 * MiB, WS_LG2 = WS_LA2 + 512 * 1024;
constexpr size_t WS_ROPE = 52 * MiB;
constexpr size_t WS_HN = 65 * MiB;
constexpr size_t WS_QKV = 193 * MiB;
constexpr size_t WS_ATT = 577 * MiB;
constexpr size_t WS_OAP = 705 * MiB;
constexpr size_t WS_LSE = 897 * MiB;
constexpr size_t WS_U = 193 * MiB;
constexpr size_t WS_X6 = 65 * MiB;
constexpr size_t WS_T = 833 * MiB;
constexpr size_t WS_RKV = 449 * MiB;
constexpr size_t WS_WAG = 65 * MiB;
constexpr size_t WS_Z = 833 * MiB;
constexpr size_t WS_END = 961 * MiB;
constexpr size_t ACT = (size_t)NTOK * DM * 2;

constexpr int RING_BYTES = 131072, LDS_BYTES = 147456;
constexpr int LDS_BARST = 147200;
constexpr size_t WS_BAR = 16384;
constexpr size_t CTL_ZERO_BYTES = 65536;
#define XB_TMO      128
#define XB_XCNT(j)  (256  + 64 * (j))
#define XB_XSUB(j)  (1280 + 64 * (j))
#define XB_XGEN(j)  (2304 + 64 * (j))
#define XB_TOP      3328
#define XB_TOPGEN   3392
#define XCD_BAR_WORDS 3456
#define XB_SPIN_CAP (1u << 18)

__device__ __forceinline__ unsigned xb_ld(unsigned* p)              { return __hip_atomic_load(p, __ATOMIC_RELAXED, __HIP_MEMORY_SCOPE_AGENT); }
__device__ __forceinline__ unsigned xb_add(unsigned* p, unsigned v) { return __hip_atomic_fetch_add(p, v, __ATOMIC_RELAXED, __HIP_MEMORY_SCOPE_AGENT); }
__device__ __forceinline__ unsigned xb_xcc_id() { return (unsigned)__builtin_amdgcn_s_getreg((3 << 11) | 20) & 0xFu; }
#define XB_SPIN(cond, bar) do { unsigned _sp = 0; while (cond) { __builtin_amdgcn_s_sleep(1); \
    if ((++_sp & 255u) == 0u) { if (xb_ld(&(bar)[XB_TMO])) break; if (_sp > XB_SPIN_CAP) { atomicAdd(&(bar)[XB_TMO], 1u); break; } } } } while (0)

struct XcdBarrier {
    unsigned* bar; unsigned x;
    volatile LAS unsigned* st;
};

__device__ __forceinline__ XcdBarrier xcd_barrier_post(unsigned* bar, volatile LAS unsigned* st) {
    XcdBarrier b; b.bar = bar; b.x = xb_xcc_id(); b.st = st;
    if (threadIdx.x == 0) (void)xb_add(&bar[XB_XCNT(b.x)], 1u);
    return b;
}
__device__ __forceinline__ void xcd_barrier_complete(unsigned* bar, unsigned x, unsigned& nloc, unsigned& nx) {
    const unsigned G = gridDim.x * gridDim.y * gridDim.z;
    unsigned sum, cnt, mine, sp = 0u;
    for (;;) {
        sum = 0u; cnt = 0u; mine = 0u;
#pragma unroll
        for (unsigned j = 0; j < 16; ++j) { const unsigned c = xb_ld(&bar[XB_XCNT(j)]); sum += c; cnt += (c > 0u) ? 1u : 0u; mine = (j == x) ? c : mine; }
        if (sum == G) break;
        __builtin_amdgcn_s_sleep(1);
        if ((++sp & 255u) == 0u) { if (xb_ld(&bar[XB_TMO])) break; if (sp > XB_SPIN_CAP) { atomicAdd(&bar[XB_TMO], 1u); break; } }
    }
    nloc = mine > 0u ? mine : 1u; nx = cnt > 0u ? cnt : 1u;
}

__device__ __forceinline__ void xcd_barrier(const XcdBarrier& b) {
    asm volatile("s_waitcnt vmcnt(0)" ::: "memory");
    __syncthreads();
    if (threadIdx.x == 0) {
        unsigned* bar = b.bar;
        __builtin_amdgcn_s_waitcnt(0);
        unsigned nloc = b.st[0], nx = b.st[1];
        if (nloc == 0u) { xcd_barrier_complete(bar, b.x, nloc, nx); b.st[0] = nloc; b.st[1] = nx; }
        const unsigned old = xb_add(&bar[XB_XSUB(b.x)], 1u);
        const unsigned gen = old / nloc;
        if (old + 1u == (gen + 1u) * nloc) {
            __builtin_amdgcn_fence(__ATOMIC_RELEASE, "agent");
            asm volatile("s_waitcnt vmcnt(0)" ::: "memory");
            const unsigned og = xb_add(&bar[XB_TOP], 1u);
            const unsigned tg = og / nx;
            if (og + 1u == (tg + 1u) * nx) xb_add(&bar[XB_TOPGEN], 1u);
            else XB_SPIN(xb_ld(&bar[XB_TOPGEN]) == tg, bar);
            __builtin_amdgcn_fence(__ATOMIC_ACQUIRE, "agent");
            xb_add(&bar[XB_XGEN(b.x)], 1u);
            asm volatile("s_waitcnt vmcnt(0)" ::: "memory");
        } else {
            XB_SPIN(xb_ld(&bar[XB_XGEN(b.x)]) == gen, bar);
            __builtin_amdgcn_fence(__ATOMIC_ACQUIRE, "agent");
            asm volatile("s_waitcnt vmcnt(0)" ::: "memory");
        }
    }
    __syncthreads();
}


__device__ __forceinline__ unsigned pkbf(float lo, float hi) { return pg8::cvt_pk_bf16(lo, hi); }
__device__ __forceinline__ float bf2f(unsigned short h) { return __uint_as_float(((unsigned)h) << 16); }
__device__ __forceinline__ float bflo(unsigned w) { return __uint_as_float(w << 16); }
__device__ __forceinline__ float bfhi(unsigned w) { return __uint_as_float(w & 0xffff0000u); }
__device__ __forceinline__ float wave_sum(float v) {
#define WS_DPP_(x, ctrl, rmask, bctl) __int_as_float(__builtin_amdgcn_update_dpp(0, __float_as_int(x), (ctrl), (rmask), 0xF, (bctl)))
    v += WS_DPP_(v, 0xB1, 0xF, true);
    v += WS_DPP_(v, 0x4E, 0xF, true);
    v += WS_DPP_(v, 0x124, 0xF, true);
    v += WS_DPP_(v, 0x128, 0xF, true);
    v += WS_DPP_(v, 0x142, 0xA, false);
    v += WS_DPP_(v, 0x143, 0xC, false);
#undef WS_DPP_
    return __int_as_float(__builtin_amdgcn_readlane(__float_as_int(v), 63));
}

struct Args {
    const float* x; const float* norm_mix; const float* norm_mlp; const float* norm_final;
    const float* attn_w_in; const float* attn_w_out; const float* diff_lambda; const float* diff_subln;
    const float* rwkv_mu; const float* rwkv_w_r; const float* rwkv_w_k; const float* rwkv_w_v; const float* rwkv_w_o;
    const float* rwkv_w0; const float* rwkv_w1; const float* rwkv_w2; const float* rwkv_a0; const float* rwkv_a1; const float* rwkv_a2;
    const float* rwkv_g1; const float* rwkv_g2; const float* rwkv_k_k; const float* rwkv_k_a; const float* rwkv_r_k;
    const float* rwkv_ln_w; const float* rwkv_ln_b; const float* mlp_w1; const float* mlp_w2;
    float* out; unsigned char* ws; int ph_lo, ph_hi;
};

__device__ __forceinline__ void transpose_item(const float* __restrict__ W, int N, bf16* __restrict__ WT, int pitch, LAS float* scr, int item, int lane) {
    const int nblk = N >> 5, kb = item / nblk, nb = item - kb * nblk, k0 = kb * 32, n0 = nb * 32;
#pragma unroll 4
    for (int i = 0; i < 16; ++i) { const int kk = 2 * i + (lane >> 5); scr[kk * 33 + (lane & 31)] = W[(size_t)(k0 + kk) * N + n0 + (lane & 31)]; }
    asm volatile("s_waitcnt lgkmcnt(0)" ::: "memory");
    const int c = lane & 3;
#pragma unroll
    for (int j = 0; j < 2; ++j) { const int n = (lane >> 2) + 16 * j; const LAS float* s = scr + (8 * c) * 33 + n;
        u32x4 o; o.x = pkbf(s[0], s[33]); o.y = pkbf(s[66], s[99]); o.z = pkbf(s[132], s[165]); o.w = pkbf(s[198], s[231]);
        *(u32x4*)(WT + (size_t)(n0 + n) * pitch + k0 + 8 * c) = o; }
    asm volatile("s_waitcnt lgkmcnt(0)" ::: "memory");
}
__device__ __forceinline__ void zero_region(bf16* p, int pitch, int r0, int r1, int c0, int c1, int gt, int ngt) {
    const int cw = (c1 - c0) >> 3, n = (r1 - r0) * cw;
    for (int i = gt; i < n; i += ngt) { const int r = r0 + i / cw, c = c0 + (i % cw) * 8; *(u32x4*)(p + (size_t)r * pitch + c) = (u32x4){0u, 0u, 0u, 0u}; }
}
__device__ __forceinline__ void rms_row_bf16(const float* xrow, const float* gain, bf16* orow, int lane) {
    const f32x4* xr = (const f32x4*)xrow + lane; const f32x4* gr = (const f32x4*)gain + lane;
    f32x4 v[4]; float s = 0.f;
#pragma unroll
    for (int j = 0; j < 4; ++j) { v[j] = xr[64 * j]; s += (v[j].x * v[j].x + v[j].y * v[j].y) + (v[j].z * v[j].z + v[j].w * v[j].w); }
    const float rstd = 1.f / sqrtf(wave_sum(s) * (1.f / 1024.f) + 1e-5f);
    u32x2* o8 = (u32x2*)orow + lane;
#pragma unroll
    for (int j = 0; j < 4; ++j) { const f32x4 g = gr[64 * j]; u32x2 w; w.x = pkbf(v[j].x * rstd * g.x, v[j].y * rstd * g.y); w.y = pkbf(v[j].z * rstd * g.z, v[j].w * rstd * g.w); o8[64 * j] = w; }
}
__device__ __forceinline__ void rms_phase_bf16(const float* __restrict__ src, const float* __restrict__ gain, bf16* __restrict__ dst, int gw, int ngw, int lane) {
    const f32x4* gr = (const f32x4*)gain + lane;
    for (int m = 2 * gw; m < NTOK; m += 2 * ngw) {
        const f32x4* x0 = (const f32x4*)(src + (size_t)m * DM) + lane; const f32x4* x1 = x0 + DM / 4;
        f32x4 v[4], u[4]; float s = 0.f, t = 0.f;
#pragma unroll
        for (int j = 0; j < 4; ++j) { v[j] = x0[64 * j]; u[j] = x1[64 * j]; }
#pragma unroll
        for (int j = 0; j < 4; ++j) { s += (v[j].x * v[j].x + v[j].y * v[j].y) + (v[j].z * v[j].z + v[j].w * v[j].w); t += (u[j].x * u[j].x + u[j].y * u[j].y) + (u[j].z * u[j].z + u[j].w * u[j].w); }
        const float r0 = 1.f / sqrtf(wave_sum(s) * (1.f / 1024.f) + 1e-5f), r1 = 1.f / sqrtf(wave_sum(t) * (1.f / 1024.f) + 1e-5f);
        u32x2* o0 = (u32x2*)(dst + (size_t)m * DM) + lane; u32x2* o1 = o0 + DM / 4;
#pragma unroll
        for (int j = 0; j < 4; ++j) { const f32x4 g = gr[64 * j];
            u32x2 w; w.x = pkbf(v[j].x * r0 * g.x, v[j].y * r0 * g.y); w.y = pkbf(v[j].z * r0 * g.z, v[j].w * r0 * g.w); o0[64 * j] = w;
            u32x2 z; z.x = pkbf(u[j].x * r1 * g.x, u[j].y * r1 * g.y); z.y = pkbf(u[j].z * r1 * g.z, u[j].w * r1 * g.w); o1[64 * j] = z; }
    }
}
__device__ __forceinline__ void rms_phase_f32(const float* src, const float* gain, float* dst, int gw, int ngw, int lane) {
    const f32x4* gr = (const f32x4*)gain + lane;
    for (int m = 2 * gw; m < NTOK; m += 2 * ngw) {
        const f32x4* x0 = (const f32x4*)(src + (size_t)m * DM) + lane; const f32x4* x1 = x0 + DM / 4;
        f32x4 v[4], u[4]; float s = 0.f, t = 0.f;
#pragma unroll
        for (int j = 0; j < 4; ++j) { v[j] = x0[64 * j]; u[j] = x1[64 * j]; }
#pragma unroll
        for (int j = 0; j < 4; ++j) { s += (v[j].x * v[j].x + v[j].y * v[j].y) + (v[j].z * v[j].z + v[j].w * v[j].w); t += (u[j].x * u[j].x + u[j].y * u[j].y) + (u[j].z * u[j].z + u[j].w * u[j].w); }
        const float r0 = 1.f / sqrtf(wave_sum(s) * (1.f / 1024.f) + 1e-5f), r1 = 1.f / sqrtf(wave_sum(t) * (1.f / 1024.f) + 1e-5f);
        f32x4* o0 = (f32x4*)(dst + (size_t)m * DM) + lane; f32x4* o1 = o0 + DM / 4;
#pragma unroll
        for (int j = 0; j < 4; ++j) { const f32x4 g = gr[64 * j]; o0[64 * j] = v[j] * r0 * g; o1[64 * j] = u[j] * r1 * g; }
    }
}

__device__ __forceinline__ void xmix_phase(const float* __restrict__ h, const float* __restrict__ gain, const float* __restrict__ mu, bf16* __restrict__ X6, int gw, int ngw, int lane) {
    f32x4 g4[4], m6[6][4];
#pragma unroll
    for (int j = 0; j < 4; ++j) g4[j] = ((const f32x4*)gain + lane)[64 * j];
#pragma unroll
    for (int i = 0; i < 6; ++i) {
        const int mi = (i == 1) ? 2 : ((i == 2) ? 3 : ((i == 3) ? 1 : i));
#pragma unroll
        for (int j = 0; j < 4; ++j) m6[i][j] = ((const f32x4*)(mu + mi * DM) + lane)[64 * j];
    }
    for (int chunk = gw; chunk < NTOK / 32; chunk += ngw) {
        const int t0 = chunk * 32;
        f32x4 prev[4];
        if ((t0 & (SEQ - 1)) == 0) {
#pragma unroll
            for (int j = 0; j < 4; ++j) prev[j] = (f32x4){0.f, 0.f, 0.f, 0.f};
        } else {
            const f32x4* xr = (const f32x4*)(h + (size_t)(t0 - 1) * DM) + lane; float s = 0.f;
#pragma unroll
            for (int j = 0; j < 4; ++j) { prev[j] = xr[64 * j]; s += (prev[j].x * prev[j].x + prev[j].y * prev[j].y) + (prev[j].z * prev[j].z + prev[j].w * prev[j].w); }
            const float rstd = 1.f / sqrtf(wave_sum(s) * (1.f / 1024.f) + 1e-5f);
#pragma unroll
            for (int j = 0; j < 4; ++j) prev[j] = prev[j] * rstd * g4[j];
        }
        f32x4 nx[4];
        { const f32x4* xr = (const f32x4*)(h + (size_t)t0 * DM) + lane;
#pragma unroll
          for (int j = 0; j < 4; ++j) nx[j] = xr[64 * j]; }
        for (int t = t0; t < t0 + 32; ++t) {
            f32x4 v[4]; float s = 0.f;
#pragma unroll
            for (int j = 0; j < 4; ++j) v[j] = nx[j];
            if (t + 1 < t0 + 32) { const f32x4* xr = (const f32x4*)(h + (size_t)(t + 1) * DM) + lane;
#pragma unroll
              for (int j = 0; j < 4; ++j) nx[j] = xr[64 * j]; }
#pragma unroll
            for (int j = 0; j < 4; ++j) s += (v[j].x * v[j].x + v[j].y * v[j].y) + (v[j].z * v[j].z + v[j].w * v[j].w);
            const float rstd = 1.f / sqrtf(wave_sum(s) * (1.f / 1024.f) + 1e-5f);
#pragma unroll
            for (int j = 0; j < 4; ++j) v[j] = v[j] * rstd * g4[j];
#pragma unroll
            for (int i = 0; i < 6; ++i) {
                u32x2* o8 = (u32x2*)(X6 + (size_t)i * NTOK * DM + (size_t)t * DM) + lane;
#pragma unroll
                for (int j = 0; j < 4; ++j) { const f32x4 xx = v[j] + (prev[j] - v[j]) * m6[i][j]; u32x2 w; w.x = pkbf(xx.x, xx.y); w.y = pkbf(xx.z, xx.w); o8[64 * j] = w; }
            }
#pragma unroll
            for (int j = 0; j < 4; ++j) prev[j] = v[j];
        }
    }
}

__device__ __forceinline__ int crow(int r, int hi) { return (r & 3) + 8 * (r >> 2) + 4 * hi; }
__device__ __forceinline__ s16x4 vtr(const LAS unsigned char* p) {
    typedef short v4i16_t __attribute__((ext_vector_type(4)));
    return __builtin_bit_cast(s16x4, __builtin_amdgcn_ds_read_tr16_b64_v4i16((LAS v4i16_t*)p));
}
__device__ __forceinline__ bf16x8 vfrag(const LAS unsigned char* p, int row8) {
    const s16x4 lo = vtr(p), hi = vtr(p + row8);
    return (bf16x8){lo[0], lo[1], lo[2], lo[3], hi[0], hi[1], hi[2], hi[3]};
}
__device__ __forceinline__ bf16x8 packp(const f32x16& p, int b) {
    u32x4 w; w.x = pkbf(p[b], p[b + 1]); w.y = pkbf(p[b + 2], p[b + 3]); w.z = pkbf(p[b + 4], p[b + 5]); w.w = pkbf(p[b + 6], p[b + 7]);
    return __builtin_bit_cast(bf16x8, w);
}
__device__ __forceinline__ float max16(const f32x16& p) {
    float a = fmaxf(fmaxf(p[0], p[1]), fmaxf(p[2], p[3])), b = fmaxf(fmaxf(p[4], p[5]), fmaxf(p[6], p[7]));
    float c = fmaxf(fmaxf(p[8], p[9]), fmaxf(p[10], p[11])), d = fmaxf(fmaxf(p[12], p[13]), fmaxf(p[14], p[15]));
    return fmaxf(fmaxf(a, b), fmaxf(c, d));
}
__device__ __forceinline__ float sum16(const f32x16& p) {
    return ((p[0] + p[1]) + (p[2] + p[3])) + ((p[4] + p[5]) + (p[6] + p[7])) + ((p[8] + p[9]) + (p[10] + p[11])) + ((p[12] + p[13]) + (p[14] + p[15]));
}
__device__ __forceinline__ float other_half(float v) {
    const unsigned b = __float_as_uint(v);
    auto rr = __builtin_amdgcn_permlane32_swap(b, b, false, false);
    return __uint_as_float(((threadIdx.x & 32) != 0) ? rr[0] : rr[1]);
}
#define MFMA32(a, b, c) __builtin_amdgcn_mfma_f32_32x32x16_bf16((a), (b), (c), 0, 0, 0)

constexpr int KB_STR = 144, VB_STR = 320, KB_BYTES = 64 * KB_STR, VB_BYTES = 64 * VB_STR, BBUF = 2 * KB_BYTES + VB_BYTES;
constexpr int BX_OFF = 2 * BBUF;
__device__ __forceinline__ void diffattn_unit(const bf16* __restrict__ QKV, bf16* __restrict__ ATT, const float* subln, float lam, int b, int h, int qb, LAS unsigned char* lds) {
    int tid = threadIdx.x; asm volatile("" : "+v"(tid)); const int lane = tid & 63, wid = __builtin_amdgcn_readfirstlane(tid >> 6), c = wid >> 2, g = wid & 3, i32 = lane & 31, hi = lane >> 5;
    const size_t tok0 = (size_t)b * SEQ;
    const int qrow = qb * 128 + 32 * g + i32;
    bf16x8 qf[4];
    { const bf16* qp = QKV + (tok0 + qrow) * QKVC + 1536 + h * 128 + c * 64 + 8 * hi;
#pragma unroll
      for (int s = 0; s < 4; ++s) qf[s] = *(const bf16x8*)(qp + 16 * s); }
    const int krow = tid >> 3, kch = tid & 7;
    const bf16* ksrc = QKV + (tok0 + krow) * QKVC + 2048 + h * 128 + kch * 8;
    const int vrow0 = tid >> 4, vch = tid & 15;
    const bf16* vsrc = QKV + (tok0 + vrow0) * QKVC + 2560 + h * 128 + vch * 8;
    const int kdst = krow * KB_STR + kch * 16, vdst = vrow0 * VB_STR + vch * 16;
    const int NT = 2 * qb + 2;
    u32x4 rk0, rk1, rv0, rv1;
#define B_LOAD(t) do { const size_t o_ = (size_t)(t) * 64 * QKVC; rk0 = *(const u32x4*)(ksrc + o_); rk1 = *(const u32x4*)(ksrc + o_ + 64); rv0 = *(const u32x4*)(vsrc + o_); rv1 = *(const u32x4*)(vsrc + o_ + (size_t)32 * QKVC); } while (0)
#define B_STORE(buf) do { LAS unsigned char* b_ = lds + (buf) * BBUF; *(LAS u32x4*)(b_ + kdst) = rk0; *(LAS u32x4*)(b_ + KB_BYTES + kdst) = rk1; *(LAS u32x4*)(b_ + 2 * KB_BYTES + vdst) = rv0; *(LAS u32x4*)(b_ + 2 * KB_BYTES + vdst + 32 * VB_STR) = rv1; } while (0)
    B_LOAD(0);
    f32x16 o[4];
#pragma unroll
    for (int d = 0; d < 4; ++d) o[d] = (f32x16){};
    float m_ref = 0.f, l_run = 0.f;
    const int qmin = qb * 128 + 32 * g;
    const int lg = lane & 15, gg = (lane >> 4) & 1;
    const int voff = (4 * hi + (lg >> 2)) * VB_STR + (16 * gg + 4 * (lg & 3)) * 2;
    for (int t = 0; t < NT; ++t) {
        B_STORE(t & 1);
        __syncthreads();
        if (t + 1 < NT) B_LOAD(t + 1);
        const int k0 = 64 * t;
        if (k0 <= qmin + 31) {
            const LAS unsigned char* kb = lds + (t & 1) * BBUF + c * KB_BYTES;
            const LAS unsigned char* vb = lds + (t & 1) * BBUF + 2 * KB_BYTES + voff;
            f32x16 p0 = (f32x16){}, p1 = (f32x16){};
#pragma unroll
            for (int s = 0; s < 4; ++s) {
                const bf16x8 a0 = *(const LAS bf16x8*)(kb + i32 * KB_STR + 32 * s + 16 * hi);
                const bf16x8 a1 = *(const LAS bf16x8*)(kb + (32 + i32) * KB_STR + 32 * s + 16 * hi);
                p0 = MFMA32(a0, qf[s], p0); p1 = MFMA32(a1, qf[s], p1);
            }
            if (k0 + 63 > qmin) {
#pragma unroll
                for (int r = 0; r < 16; ++r) { const int kv = k0 + crow(r, hi); if (kv > qrow) p0[r] = -INFINITY; if (kv + 32 > qrow) p1[r] = -INFINITY; }
            }
            float mx = fmaxf(max16(p0), max16(p1));
            mx = fmaxf(mx, other_half(mx));
            if (t == 0) m_ref = mx;
            else if (__any(mx - m_ref > 8.f)) {
                const float dl = fmaxf(mx - m_ref, 0.f);
                m_ref += dl;
                const float alpha = __builtin_amdgcn_exp2f(-dl);
                l_run *= alpha;
#pragma unroll
                for (int d = 0; d < 4; ++d) o[d] = o[d] * alpha;
            }
#pragma unroll
            for (int r = 0; r < 16; ++r) { p0[r] = __builtin_amdgcn_exp2f(p0[r] - m_ref); p1[r] = __builtin_amdgcn_exp2f(p1[r] - m_ref); }
            l_run += sum16(p0) + sum16(p1);
#pragma unroll
            for (int s4 = 0; s4 < 4; ++s4) {
                const bf16x8 pfs = packp((s4 < 2) ? p0 : p1, 8 * (s4 & 1));
#pragma unroll
                for (int d = 0; d < 4; ++d) { const bf16x8 a = vfrag(vb + s4 * 16 * VB_STR + d * 64, 8 * VB_STR); o[d] = MFMA32(a, pfs, o[d]); }
                __builtin_amdgcn_sched_barrier(0);
            }
        }
    }
#undef B_LOAD
#undef B_STORE
    __syncthreads();
    float l_tot = l_run + __shfl_xor(l_run, 32);
    const float inv = 1.f / l_tot;
    LAS float* X = (LAS float*)(lds + BX_OFF) + g * 4096;
    if (c == 1) {
        const float sc = inv * lam;
#pragma unroll
        for (int d = 0; d < 4; ++d)
#pragma unroll
            for (int r = 0; r < 16; ++r) X[(32 * d + crow(r, hi)) * 32 + i32] = o[d][r] * sc;
    }
    __syncthreads();
    if (c == 0) {
        float ss = 0.f;
#pragma unroll
        for (int d = 0; d < 4; ++d)
#pragma unroll
            for (int r = 0; r < 16; ++r) { const float v = o[d][r] * inv - X[(32 * d + crow(r, hi)) * 32 + i32]; o[d][r] = v; ss += v * v; }
        ss += __shfl_xor(ss, 32);
        const float rs = (1.f / sqrtf(ss * (1.f / 128.f) + 1e-5f)) * 0.8f;
        bf16* op = ATT + (tok0 + qrow) * DM + 512 + h * 128;
#pragma unroll
        for (int d = 0; d < 4; ++d)
#pragma unroll
            for (int r4 = 0; r4 < 4; ++r4) {
                const int dv = 32 * d + 8 * r4 + 4 * hi; const f32x4 gn = *(const f32x4*)(subln + dv);
                u32x2 w; w.x = pkbf(o[d][4 * r4] * rs * gn.x, o[d][4 * r4 + 1] * rs * gn.y); w.y = pkbf(o[d][4 * r4 + 2] * rs * gn.z, o[d][4 * r4 + 3] * rs * gn.w);
                *(u32x2*)(op + dv) = w;
            }
    }
    __syncthreads();
}

constexpr int KA_STR = 144, VA_STR = 192, KA_BYTES = 384 * KA_STR, VA_BYTES = 384 * VA_STR;
__device__ __forceinline__ void dilattn_unit(const bf16* __restrict__ QKV, bf16* __restrict__ OAP, float* __restrict__ LSE, int b, int h, int dil, int res, int n, LAS unsigned char* lds) {
    int tid = threadIdx.x; asm volatile("" : "+v"(tid)); const int lane = tid & 63, wid = __builtin_amdgcn_readfirstlane(tid >> 6), i32 = lane & 31, hi = lane >> 5;
    const size_t tok0 = (size_t)b * SEQ;
    {
#pragma unroll
        for (int i = 0; i < 6; ++i) {
            const int e = tid + 512 * i, kr = e >> 3, ch = e & 7, j = 256 * n - 128 + kr;
            u32x4 kv = (u32x4){0u, 0u, 0u, 0u}, vv = kv;
            if (j >= 0) { const bf16* p = QKV + (tok0 + (size_t)j * dil + res) * QKVC + h * 64 + ch * 8; kv = *(const u32x4*)(p + 512); vv = *(const u32x4*)(p + 1024); }
            *(LAS u32x4*)(lds + kr * KA_STR + ch * 16) = kv;
            *(LAS u32x4*)(lds + KA_BYTES + kr * VA_STR + ch * 16) = vv;
        }
    }
    const int jq = 256 * n + 32 * wid + i32;
    const size_t qtok = tok0 + (size_t)jq * dil + res;
    bf16x8 qf[4];
    { const bf16* qp = QKV + qtok * QKVC + h * 64 + 8 * hi;
#pragma unroll
      for (int s = 0; s < 4; ++s) qf[s] = *(const bf16x8*)(qp + 16 * s); }
    __syncthreads();
    f32x16 p[5];
    const int ufirst = (n == 0) ? ((wid < 4) ? 4 - wid : 0) : 0;
#pragma unroll
    for (int u = 0; u < 5; ++u) {
        p[u] = (f32x16){};
        if (u >= ufirst) {
            const LAS unsigned char* kb = lds + (32 * (wid + u) + i32) * KA_STR + 16 * hi;
#pragma unroll
            for (int s = 0; s < 4; ++s) { const bf16x8 a = *(const LAS bf16x8*)(kb + 32 * s); p[u] = MFMA32(a, qf[s], p[u]); }
        } else {
#pragma unroll
            for (int r = 0; r < 16; ++r) p[u][r] = -INFINITY;
        }
    }
#pragma unroll
    for (int r = 0; r < 16; ++r) { const int kl = crow(r, hi); if (kl < i32) p[0][r] = -INFINITY; if (kl > i32) p[4][r] = -INFINITY; }
    float mx = fmaxf(fmaxf(fmaxf(max16(p[0]), max16(p[1])), fmaxf(max16(p[2]), max16(p[3]))), max16(p[4]));
    mx = fmaxf(mx, other_half(mx));
    float l = 0.f;
#pragma unroll
    for (int u = 0; u < 5; ++u) {
#pragma unroll
        for (int r = 0; r < 16; ++r) p[u][r] = __builtin_amdgcn_exp2f(p[u][r] - mx);
        l += sum16(p[u]);
    }
    l += __shfl_xor(l, 32);
    f32x16 o[2]; o[0] = (f32x16){}; o[1] = (f32x16){};
    const int lg = lane & 15, gg = (lane >> 4) & 1;
    const LAS unsigned char* vb = lds + KA_BYTES + (4 * hi + (lg >> 2)) * VA_STR + (16 * gg + 4 * (lg & 3)) * 2;
#pragma unroll
    for (int u = 0; u < 5; ++u) {
        if (u >= ufirst) {
#pragma unroll
            for (int s2 = 0; s2 < 2; ++s2) {
                const bf16x8 pf = packp(p[u], 8 * s2);
#pragma unroll
                for (int d = 0; d < 2; ++d) { const bf16x8 a = vfrag(vb + (32 * (wid + u) + 16 * s2) * VA_STR + d * 64, 8 * VA_STR); o[d] = MFMA32(a, pf, o[d]); }
            }
        }
    }
    const float inv = 1.f / l;
    const int pat = (dil == 1) ? 0 : ((dil == 4) ? 1 : 2);
    bf16* op = OAP + (size_t)pat * NTOK * 512 + qtok * 512 + h * 64;
#pragma unroll
    for (int d = 0; d < 2; ++d)
#pragma unroll
        for (int r4 = 0; r4 < 4; ++r4) {
            const int dv = 32 * d + 8 * r4 + 4 * hi;
            u32x2 w; w.x = pkbf(o[d][4 * r4] * inv, o[d][4 * r4 + 1] * inv); w.y = pkbf(o[d][4 * r4 + 2] * inv, o[d][4 * r4 + 3] * inv);
            *(u32x2*)(op + dv) = w;
        }
    if (hi == 0) LSE[(size_t)pat * NTOK * 8 + qtok * 8 + h] = mx + __builtin_amdgcn_logf(l);
    __syncthreads();
}

__device__ __forceinline__ void combine_phase(const bf16* __restrict__ OAP, const float* __restrict__ LSE, bf16* __restrict__ ATT, int gt, int ngt) {
    for (int i = gt; i < NTOK * 64; i += ngt) {
        const int tokh = i >> 3, ch = i & 7; const size_t tok = (size_t)(tokh >> 3); const int h = tokh & 7;
        const float l0 = LSE[tokh], l1 = LSE[(size_t)NTOK * 8 + tokh], l2 = LSE[(size_t)2 * NTOK * 8 + tokh];
        const float m = fmaxf(l0, fmaxf(l1, l2));
        float w0 = __builtin_amdgcn_exp2f(l0 - m), w1 = __builtin_amdgcn_exp2f(l1 - m), w2 = __builtin_amdgcn_exp2f(l2 - m);
        const float is = 1.f / (w0 + w1 + w2); w0 *= is; w1 *= is; w2 *= is;
        const size_t off = tok * 512 + h * 64 + ch * 8;
        const u32x4 a = *(const u32x4*)(OAP + off), bq = *(const u32x4*)(OAP + (size_t)NTOK * 512 + off), cq = *(const u32x4*)(OAP + (size_t)2 * NTOK * 512 + off);
        u32x4 o;
#pragma unroll
        for (int e = 0; e < 4; ++e) o[e] = pkbf(w0 * bflo(a[e]) + w1 * bflo(bq[e]) + w2 * bflo(cq[e]), w0 * bfhi(a[e]) + w1 * bfhi(bq[e]) + w2 * bfhi(cq[e]));
        *(u32x4*)(ATT + tok * DM + h * 64 + ch * 8) = o;
    }
}

constexpr int SC_T = 32, SC_VEC = SC_T * 64 * 4, SC_BUF = 6 * SC_VEC + 256;
constexpr int SC_BON = 2 * SC_BUF + 2 * SC_T * 64 * 4;
constexpr int SC_Y = 2 * SC_BUF;
template <int CTRL> __device__ __forceinline__ float dpp_add(float v) {
    const int m = __builtin_amdgcn_update_dpp(0, __float_as_int(v), CTRL, 0xf, 0xf, true);
    return v + __int_as_float(m);
}
#ifdef DBG_SHFL
__device__ __forceinline__ float red8(float v) { v += __shfl_xor(v, 1); v += __shfl_xor(v, 2); v += __shfl_xor(v, 4); return v; }
#else
__device__ __forceinline__ float red8(float v) { v = dpp_add<0xB1>(v); v = dpp_add<0x4E>(v); v = dpp_add<0x141>(v); return v; }
#endif
__device__ __forceinline__ float red16x2(float v0, float v1, bool odd) {
    const float keep = odd ? v1 : v0, send = odd ? v0 : v1;
    float x = keep + __int_as_float(__builtin_amdgcn_update_dpp(0, __float_as_int(send), 0xB1, 0xf, 0xf, true));
    x = dpp_add<0x4E>(x);
    x = dpp_add<0x124>(x);
    x = dpp_add<0x128>(x);
    return x;
}
__device__ __forceinline__ u32x2 ld8_agent(const void* p) {
    const unsigned long long v = __hip_atomic_load((const unsigned long long*)p, __ATOMIC_RELAXED, __HIP_MEMORY_SCOPE_AGENT);
    return __builtin_bit_cast(u32x2, v);
}
__device__ __forceinline__ unsigned short ld2_agent(const unsigned short* p) {
    const unsigned odd = (unsigned)(((size_t)p >> 1) & 1);
    const unsigned w = __hip_atomic_load((const unsigned*)(p - odd), __ATOMIC_RELAXED, __HIP_MEMORY_SCOPE_AGENT);
    return (unsigned short)(odd ? (w >> 16) : (w & 0xffffu));
}
__device__ __forceinline__ float wave_sum_dpp(float v) {
    v = dpp_add<0xB1>(v);
    v = dpp_add<0x4E>(v);
    v = dpp_add<0x124>(v);
    v = dpp_add<0x128>(v);
    v += __int_as_float(__builtin_amdgcn_update_dpp(0, __float_as_int(v), 0x142, 0xA, 0xF, false));
    v += __int_as_float(__builtin_amdgcn_update_dpp(0, __float_as_int(v), 0x143, 0xC, 0xF, false));
    return __int_as_float(__builtin_amdgcn_readlane(__float_as_int(v), 63));
}
struct ScanRegs { u32x2 r, k, v, a, w; };
__device__ __forceinline__ float red8x2(float v0, float v1, bool odd) {
    const float keep = odd ? v1 : v0, send = odd ? v0 : v1;
    float x = keep + __int_as_float(__builtin_amdgcn_update_dpp(0, __float_as_int(send), 0xB1, 0xf, 0xf, true));
    x = dpp_add<0x4E>(x);
    int t = __builtin_amdgcn_update_dpp(0, __float_as_int(x), 0x104, 0xf, 0x5, false);
    t = __builtin_amdgcn_update_dpp(t, __float_as_int(x), 0x114, 0xf, 0xA, false);
    return x + __int_as_float(t);
}
__device__ __forceinline__ float dot8(const f32x4& sa, const f32x4& sb, const f32x4& va, const f32x4& vb) {
    f32x2 acc = (f32x2){sa.x, sa.y} * (f32x2){va.x, va.y};
    acc = __builtin_elementwise_fma((f32x2){sa.z, sa.w}, (f32x2){va.z, va.w}, acc);
    acc = __builtin_elementwise_fma((f32x2){sb.x, sb.y}, (f32x2){vb.x, vb.y}, acc);
    acc = __builtin_elementwise_fma((f32x2){sb.z, sb.w}, (f32x2){vb.z, vb.w}, acc);
    asm volatile("" : "+v"(acc));
    return acc.x + acc.y;
}
__device__ __forceinline__ void scan_unit(const bf16* __restrict__ R, const bf16* __restrict__ Kb, const bf16* __restrict__ Vb, const unsigned short* __restrict__ W16, const bf16* __restrict__ Ab,
                                          const bf16* __restrict__ Gb, const float* k_k, const float* k_a, const float* r_k, const float* ln_w, const float* ln_b, bf16* __restrict__ Z,
                                          int b, int h, LAS unsigned char* lds) {
    int tid = threadIdx.x; asm volatile("" : "+v"(tid)); const int lane = tid & 63, wid = __builtin_amdgcn_readfirstlane(tid >> 6);
    const size_t tok0 = (size_t)b * SEQ;
    constexpr int NC = SEQ / SC_T;
    constexpr int SC_YB = SC_T * 64 * 4;
    if (wid >= 4) {
        const int ht = tid - 256, ptt = ht >> 4, pj0 = 4 * (ht & 15), pcol = h * 64 + pj0, hw = wid - 4;
        const f32x4 kk4 = *(const f32x4*)(k_k + pcol), ka4 = *(const f32x4*)(k_a + pcol), rk4 = *(const f32x4*)(r_k + pcol);
        const int col = h * 64 + lane;
        const float lnw = ln_w[col], lnb = ln_b[col];
        ScanRegs pr, pq;
#define S_LOAD1(P, c, TT) do { const size_t o_ = (tok0 + (size_t)(c) * SC_T + (TT)) * DM + pcol; P.r = ld8_agent(R + o_); P.k = ld8_agent(Kb + o_); P.v = ld8_agent(Vb + o_); P.a = ld8_agent(Ab + o_); P.w = ld8_agent(W16 + o_); } while (0)
#define S_PREP1(P, buf, TT, BIDX) do { \
        LAS unsigned char* b_ = lds + (buf) * SC_BUF; \
        const f32x4 r4 = {bflo(P.r[0]), bfhi(P.r[0]), bflo(P.r[1]), bfhi(P.r[1])}; \
        const f32x4 k4 = {bflo(P.k[0]), bfhi(P.k[0]), bflo(P.k[1]), bfhi(P.k[1])}; \
        const f32x4 v4 = {bflo(P.v[0]), bfhi(P.v[0]), bflo(P.v[1]), bfhi(P.v[1])}; \
        const f32x4 a4 = {bflo(P.a[0]), bfhi(P.a[0]), bflo(P.a[1]), bfhi(P.a[1])}; \
        const unsigned wx_ = P.w[0], wy_ = P.w[1]; \
        const pg8::f16x2 wlo_ = __builtin_bit_cast(pg8::f16x2, wx_); const pg8::f16x2 whi_ = __builtin_bit_cast(pg8::f16x2, wy_); \
        const f32x4 w4 = {__expf((float)wlo_.x), __expf((float)wlo_.y), __expf((float)whi_.x), __expf((float)whi_.y)}; \
        f32x4 kk = k4 * kk4; float ss = (kk.x * kk.x + kk.y * kk.y) + (kk.z * kk.z + kk.w * kk.w); \
        ss += __shfl_xor(ss, 1); ss += __shfl_xor(ss, 2); ss += __shfl_xor(ss, 4); ss += __shfl_xor(ss, 8); \
        kk = kk * fminf(__builtin_amdgcn_rsqf(ss), 1e12f); \
        const f32x4 km = k4 * (1.f + (a4 - 1.f) * ka4); \
        float bo = (r4.x * km.x * rk4.x + r4.y * km.y * rk4.y) + (r4.z * km.z * rk4.z + r4.w * km.w * rk4.w); \
        bo += __shfl_xor(bo, 1); bo += __shfl_xor(bo, 2); bo += __shfl_xor(bo, 4); bo += __shfl_xor(bo, 8); \
        const int eo_ = ((TT) * 64 + pj0) * 4; \
        *(LAS f32x4*)(b_ + 0 * SC_VEC + eo_) = r4; *(LAS f32x4*)(b_ + 1 * SC_VEC + eo_) = w4; *(LAS f32x4*)(b_ + 2 * SC_VEC + eo_) = km; \
        *(LAS f32x4*)(b_ + 3 * SC_VEC + eo_) = -kk; *(LAS f32x4*)(b_ + 4 * SC_VEC + eo_) = kk * a4; *(LAS f32x4*)(b_ + 5 * SC_VEC + eo_) = v4; \
        if ((ht & 15) == 0) *(LAS float*)(lds + SC_BON + (BIDX) * 128 + (TT) * 4) = bo; } while (0)
        S_LOAD1(pr, 0, ptt); S_LOAD1(pq, 0, ptt + 16); S_PREP1(pr, 0, ptt, 0); S_PREP1(pq, 0, ptt + 16, 0);
        __syncthreads();
        for (int c = 0; c <= NC; ++c) {
            if (c + 1 < NC) { S_LOAD1(pr, c + 1, ptt); S_LOAD1(pq, c + 1, ptt + 16); }
            if (c >= 1) {
                const int cp = c - 1;
                const LAS float* ybuf = (const LAS float*)(lds + SC_Y + (cp & 1) * SC_YB);
#pragma unroll
                for (int q = 0; q < SC_T / 4; ++q) {
                    const int tt = hw + 4 * q;
                    const float y = ybuf[tt * 64 + lane];
                    const float mean = wave_sum_dpp(y) * (1.f / 64.f); const float dy = y - mean;
                    const float var = wave_sum_dpp(dy * dy) * (1.f / 64.f);
                    const float yn = dy * __builtin_amdgcn_rsqf(var + 64e-5f) * lnw + lnb;
                    const size_t o_ = (tok0 + (size_t)cp * SC_T + tt) * DM + col;
                    const float bo = *(const LAS float*)(lds + SC_BON + (cp % 3) * 128 + tt * 4), vv = bf2f(ld2_agent(Vb + o_));
                    const float gt = bf2f(ld2_agent(Gb + o_));
                    const float outv = (yn + bo * vv) * gt;
                    Z[o_] = (bf16)(pkbf(outv, outv) & 0xffffu);
                }
            }
            if (c + 1 < NC) { const int bi_ = (c + 1) % 3; S_PREP1(pr, (c + 1) & 1, ptt, bi_); S_PREP1(pq, (c + 1) & 1, ptt + 16, bi_); }
            __syncthreads();
        }
#undef S_LOAD1
#undef S_PREP1
    } else {
        const int sq = lane & 7, si0 = 16 * wid + 2 * (lane >> 3), sj = 8 * sq;
        const bool odd = (sq & 1) != 0;
        f32x4 S0a = {0.f, 0.f, 0.f, 0.f}, S0b = S0a, S1a = S0a, S1b = S0a;
        __syncthreads();
        for (int c = 0; c <= NC; ++c) {
            if (c < NC) {
                const LAS unsigned char* bb = lds + (c & 1) * SC_BUF;
                LAS float* ybuf = (LAS float*)(lds + SC_Y + (c & 1) * SC_YB);
                const LAS unsigned char* vp_ = bb + sj * 4;
                const LAS unsigned char* vv_ = bb + 5 * SC_VEC + si0 * 4;
#define LD8(dstA, dstB, slot, TT) dstA = *(const LAS f32x4*)(vp_ + (slot) * SC_VEC + (TT) * 256); dstB = *(const LAS f32x4*)(vp_ + (slot) * SC_VEC + (TT) * 256 + 16)
                f32x4 rA, rB, wA, wB, kA, kB, aA, aB, bA, bB; f32x2 v2;
                LD8(rA, rB, 0, 0); LD8(wA, wB, 1, 0); LD8(kA, kB, 2, 0); LD8(aA, aB, 3, 0); LD8(bA, bB, 4, 0); v2 = *(const LAS f32x2*)(vv_);
#pragma unroll 2
                for (int tt = 0; tt < SC_T; ++tt) {
                    const int tn = (tt + 1) & (SC_T - 1);
                    f32x4 nrA, nrB, nwA, nwB, nkA, nkB, naA, naB, nbA, nbB;
                    LD8(nrA, nrB, 0, tn); LD8(nwA, nwB, 1, tn); LD8(nkA, nkB, 2, tn); LD8(naA, naB, 3, tn); LD8(nbA, nbB, 4, tn);
                    const f32x2 nv2 = *(const LAS f32x2*)(vv_ + tn * 256);
                    const float sx = red8x2(dot8(S0a, S0b, aA, aB), dot8(S1a, S1b, aA, aB), odd);
                    const float sa0 = __int_as_float(__builtin_amdgcn_update_dpp(0, __float_as_int(sx), 0x00, 0xf, 0xf, true));
                    const float sa1 = __int_as_float(__builtin_amdgcn_update_dpp(0, __float_as_int(sx), 0x55, 0xf, 0xf, true));
                    S0a = S0a * wA + (bA * sa0 + kA * v2.x); S0b = S0b * wB + (bB * sa0 + kB * v2.x);
                    S1a = S1a * wA + (bA * sa1 + kA * v2.y); S1b = S1b * wB + (bB * sa1 + kB * v2.y);
                    const float yx = red8x2(dot8(S0a, S0b, rA, rB), dot8(S1a, S1b, rA, rB), odd);
                    if (sq < 2) ybuf[tt * 64 + si0 + sq] = yx;
                    rA = nrA; rB = nrB; wA = nwA; wB = nwB; kA = nkA; kB = nkB; aA = naA; aB = naB; bA = nbA; bB = nbB; v2 = nv2;
                }
#undef LD8
            }
            __syncthreads();
        }
    }
    __syncthreads();
}

#ifdef DBG_CHECK
__device__ __forceinline__ unsigned hsh(unsigned x) { x ^= x >> 16; x *= 0x7feb352dU; x ^= x >> 15; x *= 0x846ca68bU; x ^= x >> 16; return x; }
__device__ __forceinline__ float dotcol(const bf16* arow, const float* W, int N, int c, int K, int lane) {
    float s = 0.f; for (int k = lane; k < K; k += 64) s += bf2f(arow[k]) * W[(size_t)k * N + c]; return wave_sum(s);
}
#define ERR_ACC(ref, fast) do { const float r_ = (ref), f_ = (fast); d2 += (r_ - f_) * (r_ - f_); r2 += r_ * r_; } while (0)
#define ERR_DONE(stage) do { d2 = wave_sum(d2); r2 = wave_sum(r2); if (lane == 0) CTLp[16 + (stage)] = sqrtf(d2 / fmaxf(r2, 1e-30f)); } while (0)
__device__ __forceinline__ void dbg_check(int ph, const Args* Ap, LAS unsigned char* lds, int lane) {
    asm volatile("" : "+s"(Ap)); const Args& A = *Ap; unsigned char* ws = A.ws; float* CTLp = (float*)(ws + WS_CTL);
    const bf16* HN = (const bf16*)(ws + WS_HN); const bf16* QKV = (const bf16*)(ws + WS_QKV); const bf16* ATT = (const bf16*)(ws + WS_ATT); const bf16* U = (const bf16*)(ws + WS_U);
    const bf16* X6 = (const bf16*)(ws + WS_X6); const bf16* TT = (const bf16*)(ws + WS_T); const bf16* RKV = (const bf16*)(ws + WS_RKV); const bf16* WAG = (const bf16*)(ws + WS_WAG); const bf16* Z = (const bf16*)(ws + WS_Z);
    const float* H = A.out; LAS float* sl = (LAS float*)lds;
    float d2 = 0.f, r2 = 0.f;
    if (ph == 1) {
        for (int smp = 0; smp < 48; ++smp) {
            const int t = hsh(smp) & 65535; int c = hsh(smp + 1000) % 3072; if (smp % 3 == 0) c = (c & ~63) | (hsh(smp + 7) & 15);
            const int sec = c / 512, hc = c & 63; const bf16* ar = HN + (size_t)t * DM;
            float v = dotcol(ar, A.attn_w_in, 3072, c, 1024, lane);
            if (sec != 2 && sec != 5 && hc < 16) { const float vp = dotcol(ar, A.attn_w_in, 3072, c ^ 8, 1024, lane); const float ang = (float)(t & 4095) * powf(500000.f, -(float)(hc & 7) / 8.f);
                v = (hc < 8) ? v * cosf(ang) - vp * sinf(ang) : v * cosf(ang) + vp * sinf(ang); }
            if (sec == 0 || sec == 3) v *= 0.125f * 1.4426950408889634f;
            if (lane == 0) ERR_ACC(v, bf2f(QKV[(size_t)t * QKVC + c]));
        }
        ERR_DONE(1);
    }
    if (ph == 2) {
        const float lam = CTLp[0];
        for (int smp = 0; smp < 7; ++smp) {
            int q = 0; if (smp == 1) q = 63; if (smp == 2) q = 64; if (smp == 3) q = 127; if (smp == 4) q = 128; if (smp == 5) q = 1000; if (smp == 6) q = 4095;
            const int b = hsh(smp + 50) & 15, h = hsh(smp + 60) & 3; const size_t tok0 = (size_t)b * SEQ;
            float mc[2], lc[2];
            for (int c = 0; c < 2; ++c) {
                const bf16* qp = QKV + (tok0 + q) * QKVC + 1536 + h * 128 + c * 64; float m = -INFINITY;
                for (int k = lane; k <= q; k += 64) { const bf16* kp = QKV + (tok0 + k) * QKVC + 2048 + h * 128 + c * 64; float s = 0.f; for (int d = 0; d < 64; ++d) s += bf2f(qp[d]) * bf2f(kp[d]); sl[c * 4096 + k] = s; m = fmaxf(m, s); }
#pragma unroll
                for (int o = 1; o < 64; o <<= 1) m = fmaxf(m, __shfl_xor(m, o));
                float l = 0.f; for (int k = lane; k <= q; k += 64) l += exp2f(sl[c * 4096 + k] - m);
                mc[c] = m; lc[c] = wave_sum(l);
            }
            asm volatile("s_waitcnt lgkmcnt(0)" ::: "memory");
            float o0 = 0.f, o1 = 0.f;
            for (int k = 0; k <= q; ++k) { const float a = exp2f(sl[k] - mc[0]) / lc[0] - lam * exp2f(sl[4096 + k] - mc[1]) / lc[1]; const bf16* vp = QKV + (tok0 + k) * QKVC + 2560 + h * 128; o0 += a * bf2f(vp[lane]); o1 += a * bf2f(vp[64 + lane]); }
            const float ss = wave_sum(o0 * o0 + o1 * o1), rs = 0.8f / sqrtf(ss / 128.f + 1e-5f);
            const bf16* ap = ATT + (tok0 + q) * DM + 512 + h * 128;
            ERR_ACC(o0 * rs * A.diff_subln[lane], bf2f(ap[lane])); ERR_ACC(o1 * rs * A.diff_subln[64 + lane], bf2f(ap[64 + lane]));
        }
        ERR_DONE(2);
    }
    if (ph == 3) {
        for (int smp = 0; smp < 10; ++smp) {
            int t = 0; if (smp == 1) t = 1; if (smp == 2) t = 127; if (smp == 3) t = 128; if (smp == 4) t = 129; if (smp == 5) t = 515; if (smp == 6) t = 2047; if (smp == 7) t = 2048; if (smp == 8) t = 4095; if (smp == 9) t = 3001;
            const int b = hsh(smp + 150) & 15, h = hsh(smp + 160) & 7; const size_t tok0 = (size_t)b * SEQ;
            const bf16* qp = QKV + (tok0 + t) * QKVC + h * 64; float m = -INFINITY;
            for (int e = lane; e < 387; e += 64) { const int pat = e / 129, mm = e % 129, dil = (pat == 0) ? 1 : ((pat == 1) ? 4 : 16), pos = t - mm * dil; float s = -INFINITY;
                if (pos >= 0) { const bf16* kp = QKV + (tok0 + pos) * QKVC + 512 + h * 64; s = 0.f; for (int d = 0; d < 64; ++d) s += bf2f(qp[d]) * bf2f(kp[d]); }
                sl[e] = s; m = fmaxf(m, s); }
#pragma unroll
            for (int o = 1; o < 64; o <<= 1) m = fmaxf(m, __shfl_xor(m, o));
            float l = 0.f; for (int e = lane; e < 387; e += 64) l += exp2f(sl[e] - m);
            l = wave_sum(l);
            asm volatile("s_waitcnt lgkmcnt(0)" ::: "memory");
            float o = 0.f;
            for (int e = 0; e < 387; ++e) { const int pat = e / 129, mm = e % 129, dil = (pat == 0) ? 1 : ((pat == 1) ? 4 : 16), pos = t - mm * dil; if (pos >= 0) o += exp2f(sl[e] - m) / l * bf2f(QKV[(tok0 + pos) * QKVC + 1024 + h * 64 + lane]); }
            ERR_ACC(o, bf2f(ATT[(tok0 + t) * DM + h * 64 + lane]));
        }
        ERR_DONE(3);
    }
    if (ph == 4) {
        for (int smp = 0; smp < 32; ++smp) { const int t = hsh(smp + 300) & 65535, c = hsh(smp + 400) & 1023;
            const float v = A.x[(size_t)t * DM + c] + dotcol(ATT + (size_t)t * DM, A.attn_w_out, 1024, c, 1024, lane); if (lane == 0) ERR_ACC(v, H[(size_t)t * DM + c]); }
        ERR_DONE(4);
    }
    if (ph == 6) {
        for (int smp = 0; smp < 32; ++smp) { const int t = hsh(smp + 500) & 65535, c = hsh(smp + 600) & 4095;
            float v = fmaxf(dotcol(HN + (size_t)t * DM, A.mlp_w1, 4096, c, 1024, lane), 0.f); v *= v; if (lane == 0) ERR_ACC(v, bf2f(U[(size_t)t * DFF + c])); }
        ERR_DONE(6);
    }
    if (ph == 8) {
        for (int smp = 0; smp < 12; ++smp) { int t = hsh(smp + 700) & 65535; if (smp == 0) t = 4096; if (smp == 1) t = 4095; if (smp == 2) t = 32; const int slot = smp % 6, mi = (slot == 1) ? 2 : ((slot == 2) ? 3 : ((slot == 3) ? 1 : slot));
            float s0 = 0.f, s1 = 0.f; const bool hp = (t & 4095) != 0;
            for (int k = lane; k < 1024; k += 64) { const float a = H[(size_t)t * DM + k]; s0 += a * a; if (hp) { const float p = H[(size_t)(t - 1) * DM + k]; s1 += p * p; } }
            const float r0 = 1.f / sqrtf(wave_sum(s0) / 1024.f + 1e-5f), r1 = 1.f / sqrtf(wave_sum(s1) / 1024.f + 1e-5f);
            for (int k = lane; k < 1024; k += 64) { const float g = A.norm_mix[DM + k]; const float hn = H[(size_t)t * DM + k] * r0 * g, hpv = hp ? H[(size_t)(t - 1) * DM + k] * r1 * g : 0.f;
                ERR_ACC(hn + (hpv - hn) * A.rwkv_mu[mi * DM + k], bf2f(X6[(size_t)slot * NTOK * DM + (size_t)t * DM + k])); } }
        ERR_DONE(8);
    }
    if (ph == 9) {
        for (int smp = 0; smp < 30; ++smp) { const int t = hsh(smp + 800) & 65535, wh = smp % 3, nn = (wh == 2) ? 160 : 64, c = hsh(smp + 900) % nn;
            const float* W = (wh == 0) ? A.rwkv_w1 : ((wh == 1) ? A.rwkv_a1 : A.rwkv_g1);
            float v = dotcol(X6 + (size_t)(3 + wh) * NTOK * DM + (size_t)t * DM, W, nn, c, 1024, lane); if (wh == 0) v = tanhf(v); if (wh == 2) v = 1.f / (1.f + expf(-v));
            if (lane == 0) ERR_ACC(v, bf2f(TT[(size_t)wh * NTOK * 256 + (size_t)t * 256 + c])); }
        ERR_DONE(9);
    }
    if (ph == 10) {
        for (int smp = 0; smp < 30; ++smp) { const int t = hsh(smp + 1100) & 65535, wh = smp % 3, c = hsh(smp + 1200) & 1023;
            const float* W = (wh == 0) ? A.rwkv_w_r : ((wh == 1) ? A.rwkv_w_k : A.rwkv_w_v);
            const float v = dotcol(X6 + (size_t)wh * NTOK * DM + (size_t)t * DM, W, 1024, c, 1024, lane); if (lane == 0) ERR_ACC(v, bf2f(RKV[(size_t)wh * NTOK * DM + (size_t)t * DM + c])); }
        ERR_DONE(10);
    }
    if (ph == 11) {
        for (int smp = 0; smp < 30; ++smp) { const int t = hsh(smp + 1300) & 65535, wh = smp % 3, kk = (wh == 2) ? 160 : 64, c = hsh(smp + 1400) & 1023;
            const float* W = (wh == 0) ? A.rwkv_w2 : ((wh == 1) ? A.rwkv_a2 : A.rwkv_g2);
            float v = dotcol(TT + (size_t)wh * NTOK * 256 + (size_t)t * 256, W, 1024, c, kk, lane); float f;
            const unsigned short raw = WAG[(size_t)wh * NTOK * DM + (size_t)t * DM + c];
            if (wh == 0) { const float z = A.rwkv_w0[c] + v; const float sp = fmaxf(-z, 0.f) + log1pf(expf(-fabsf(z))); v = -expf(-sp - 0.5f); f = (float)__builtin_bit_cast(_Float16, raw); }
            else if (wh == 1) { v = 1.f / (1.f + expf(-(A.rwkv_a0[c] + v))); f = bf2f(raw); } else f = bf2f(raw);
            if (lane == 0) ERR_ACC(v, f); }
        ERR_DONE(11);
    }
    if (ph == 12) {
        float ed[5] = {0.f, 0.f, 0.f, 0.f, 0.f}, er[5] = {0.f, 0.f, 0.f, 0.f, 0.f};
#pragma unroll
        for (int smp = 0; smp < 3; ++smp) {
            const int b = 0, h = smp; const size_t tok0 = (size_t)b * SEQ; const int col = h * 64 + lane;
            LAS float* sv = sl + 4096;
            for (int i = 0; i < 64; ++i) sl[i * 64 + lane] = 0.f;
            for (int t = 0; t < 40; ++t) {
                const size_t o = (tok0 + t) * DM + col;
                const float r = bf2f(RKV[o]), k = bf2f(RKV[(size_t)NTOK * DM + o]), v = bf2f(RKV[2 * (size_t)NTOK * DM + o]);
                const float w = expf((float)__builtin_bit_cast(_Float16, (unsigned short)WAG[o])), a = bf2f(WAG[(size_t)NTOK * DM + o]);
                float kk = k * A.rwkv_k_k[col]; kk = kk / fmaxf(sqrtf(wave_sum(kk * kk)), 1e-12f);
                const float km = k * (1.f + (a - 1.f) * A.rwkv_k_a[col]);
                float yl = 0.f;
                sv[lane] = v; asm volatile("s_waitcnt lgkmcnt(0)" ::: "memory");
#pragma unroll 1
                for (int i = 0; i < 64; ++i) { float st = sl[i * 64 + lane]; const float sa = wave_sum(st * (-kk)); st = st * w + sa * (kk * a) + sv[i] * km; sl[i * 64 + lane] = st; const float y = wave_sum(st * r); if (lane == i) yl = sa; }
                const float bonus = wave_sum(r * km * A.rwkv_r_k[col]);
                const float f_ = bf2f(Z[o]);
                if (smp == 0) { const float dd = (yl - f_) * (yl - f_), rr = yl * yl; if (t == 1) { ed[0] += 36.f * dd; er[0] += rr; } if (t == 2) { ed[3] += 36.f * dd; er[3] += rr; } if (t < 32) { ed[4] += dd; er[4] += rr; } }
                if (smp == 1) { ed[1] += (1.f - w - f_) * (1.f - w - f_); er[1] += (1.f - w) * (1.f - w); }
                if (smp == 2) { ed[2] += (kk * a - f_) * (kk * a - f_); er[2] += kk * a * kk * a; }
            }
        }
#pragma unroll
        for (int q = 0; q < 5; ++q) { d2 = ed[q]; r2 = er[q]; ERR_DONE(12 + q); }
    }
    if (ph == 13) {
    }
}
#endif
#define AS4 __attribute__((address_space(4)))
__device__ __forceinline__ const unsigned char AS4* kargs() { const unsigned char AS4* p = (const unsigned char AS4*)__builtin_amdgcn_kernarg_segment_ptr(); asm volatile("" : "+s"(p)); return p; }
#define KA(member) (*(decltype(Args::member) const AS4*)(kargs() + offsetof(Args, member)))
#define WSB(off) ((bf16*)(KA(ws) + (off)))
#define P_W_IN WSB(WS_WIN)
#define P_W_OUT WSB(WS_WOUT)
#define P_W1_0 WSB(WS_W1_0)
#define P_W2_0 WSB(WS_W2_0)
#define P_W1_1 WSB(WS_W1_1)
#define P_W2_1 WSB(WS_W2_1)
#define P_WR WSB(WS_WR)
#define P_WK WSB(WS_WK)
#define P_WV WSB(WS_WV)
#define P_WO WSB(WS_WO)
#define P_LW1 WSB(WS_LW1)
#define P_LA1 WSB(WS_LA1)
#define P_LG1 WSB(WS_LG1)
#define P_LW2 WSB(WS_LW2)
#define P_LA2 WSB(WS_LA2)
#define P_LG2 WSB(WS_LG2)
#define P_HN WSB(WS_HN)
#define P_QKV WSB(WS_QKV)
#define P_ATT WSB(WS_ATT)
#define P_OAP WSB(WS_OAP)
#define P_U WSB(WS_U)
#define P_X6 WSB(WS_X6)
#define P_TT WSB(WS_T)
#define P_RKV WSB(WS_RKV)
#define P_WAG WSB(WS_WAG)
#define P_Z WSB(WS_Z)
#define P_ROPE ((float*)(KA(ws) + WS_ROPE))
#define P_CTL ((float*)(KA(ws) + WS_CTL))
#define P_LSE ((float*)(KA(ws) + WS_LSE))
#define P_H (KA(out))
__global__ void __launch_bounds__(NTHR, 2) hybrid_fwd(Args A_unused) {
    extern __shared__ __attribute__((aligned(16))) unsigned char lds_raw[];
    LAS unsigned char* lds = (LAS unsigned char*)lds_raw;
    cg::grid_group grid = cg::this_grid();
    { int t0_ = threadIdx.x; asm volatile("" : "+v"(t0_)); if (t0_ < 2) ((LAS unsigned*)(lds + LDS_BARST))[t0_] = 0u; }
    __syncthreads();
    (void)xcd_barrier_post((unsigned*)(KA(ws) + WS_BAR), (volatile LAS unsigned*)(lds + LDS_BARST));
    const int G = gridDim.x, bx = blockIdx.x, ngw = G * NWAVES, ngt = G * NTHR;
#define TIDV int tid = threadIdx.x; asm volatile("" : "+v"(tid)); const int lane = tid & 63, wave = __builtin_amdgcn_readfirstlane(tid >> 6), gw = bx * NWAVES + wave, gt = bx * NTHR + tid; (void)lane; (void)gw; (void)gt;
    constexpr int lo = 0, hi = 18;
    int ph = 0;
#define PHASE_BEGIN if (ph >= lo && ph < hi) { TIDV
#ifdef DBG_CHECK
#define PHASE_END   } grid.sync(); { int t2_ = threadIdx.x; asm volatile("" : "+v"(t2_)); if (bx == 0 && t2_ < 64) dbg_check(ph, (const Args*)(const void*)__builtin_amdgcn_kernarg_segment_ptr(), lds, t2_); } grid.sync(); ++ph;
#else
#define PHASE_END   if (ph + 1 < hi) { if (ph == 0) grid.sync(); else { XcdBarrier xb_; xb_.bar = (unsigned*)(KA(ws) + WS_BAR); xb_.x = xb_xcc_id(); xb_.st = (volatile LAS unsigned*)(lds + LDS_BARST); xcd_barrier(xb_); } } } ++ph;
#endif
#define GEMM(EPI, Aptr, Bptr, N_, K_, ...) do { pg8::Gemm g_{(const pg8::bf16_t*)(Aptr), (const pg8::bf16_t*)(Bptr), NTOK, (N_), (K_)}; pg8::StaticOrder S_; S_.init(NTOK, (N_), G, bx); \
        EPI E_{__VA_ARGS__}; pg8::gemm_phase<EPI, pg8::StaticOrder, true, true>(lds, g_, S_, E_); } while (0)

    PHASE_BEGIN
    {
        LAS float* scr = (LAS float*)(lds + wave * 8192);
        int it0 = gw;
#define TJOB(W, K_, N_, WT, PITCH) { const int ni_ = ((K_) / 32) * ((N_) / 32); for (; it0 < ni_; it0 += ngw) transpose_item((W), (N_), (WT), (PITCH), scr, it0, lane); it0 -= ni_; }
        TJOB(KA(attn_w_in), 1024, 3072, P_W_IN, 1024)
        TJOB(KA(attn_w_out), 1024, 1024, P_W_OUT, 1024)
        TJOB(KA(mlp_w1), 1024, 4096, P_W1_0, 1024)
        TJOB(KA(mlp_w1) + (size_t)1024 * 4096, 1024, 4096, P_W1_1, 1024)
        TJOB(KA(mlp_w2), 4096, 1024, P_W2_0, 4096)
        TJOB(KA(mlp_w2) + (size_t)4096 * 1024, 4096, 1024, P_W2_1, 4096)
        TJOB(KA(rwkv_w_r), 1024, 1024, P_WR, 1024)
        TJOB(KA(rwkv_w_k), 1024, 1024, P_WK, 1024)
        TJOB(KA(rwkv_w_v), 1024, 1024, P_WV, 1024)
        TJOB(KA(rwkv_w_o), 1024, 1024, P_WO, 1024)
        TJOB(KA(rwkv_w1), 1024, 64, P_LW1, 1024)
        TJOB(KA(rwkv_a1), 1024, 64, P_LA1, 1024)
        TJOB(KA(rwkv_g1), 1024, 160, P_LG1, 1024)
        TJOB(KA(rwkv_w2), 64, 1024, P_LW2, 256)
        TJOB(KA(rwkv_a2), 64, 1024, P_LA2, 256)
        TJOB(KA(rwkv_g2), 160, 1024, P_LG2, 256)
#undef TJOB
        zero_region(P_LW1, 1024, 64, 256, 0, 1024, gt, ngt); zero_region(P_LA1, 1024, 64, 256, 0, 1024, gt, ngt); zero_region(P_LG1, 1024, 160, 256, 0, 1024, gt, ngt);
        zero_region(P_LW2, 256, 0, 1024, 64, 256, gt, ngt); zero_region(P_LA2, 256, 0, 1024, 64, 256, gt, ngt); zero_region(P_LG2, 256, 0, 1024, 160, 256, gt, ngt);
        for (int i = gt; i < 4096 * 8; i += ngt) {
            const int pos = i >> 3, f = i & 7;
            const float invf = (float)exp(-(double)f * 0.125 * log(500000.0));
            const float ang = (float)pos * invf;
            P_ROPE[pos * 16 + f] = (float)cos((double)ang); P_ROPE[pos * 16 + 8 + f] = (float)sin((double)ang);
        }
        if (bx == 0 && wave == 0) {
            const float* lp = KA(diff_lambda);
            const float s01 = wave_sum(lp[lane] * lp[64 + lane]), s23 = wave_sum(lp[128 + lane] * lp[192 + lane]);
            if (lane == 0) P_CTL[0] = expf(s01) - expf(s23) + 0.2f;
        }
        rms_phase_bf16(KA(x), KA(norm_mix), P_HN, gw, ngw, lane);
    }
    PHASE_END
    PHASE_BEGIN
    GEMM(pg8::Epi16<pg8::M_QKV>, P_HN, P_W_IN, QKVC, 1024, P_QKV, QKVC, P_ROPE);
    PHASE_END
    PHASE_BEGIN
    {
        const float lam = P_CTL[0];
        for (int rep_ = 0; rep_ < REP_ATTN; ++rep_)
        for (int u = bx; u < 2048; u += G) {
            const int i = u >> 8, cidx = u & 255, bh = cidx >> 2, s = (cidx & 3) * 4 + (i >> 1), qb = (i & 1) ? 31 - s : s;
            diffattn_unit(P_QKV, P_ATT, KA(diff_subln), lam, bh >> 2, bh & 3, qb, lds);
        }
        for (int rep_ = 0; rep_ < REP_ATTNA; ++rep_)
        for (int v = bx; v < 6144; v += G) {
            const int bh = v / 48, r48 = v - bh * 48, pat = r48 >> 4, q16 = r48 & 15;
            const int dil = (pat == 0) ? 1 : ((pat == 1) ? 4 : 16);
            const int nper = 16 / dil;
            const int res = q16 / nper, n = q16 - res * nper;
            dilattn_unit(P_QKV, P_OAP, P_LSE, bh >> 3, bh & 7, dil, res, n, lds);
        }
    }
    PHASE_END
    PHASE_BEGIN
    combine_phase(P_OAP, P_LSE, P_ATT, gt, ngt);
    PHASE_END
    PHASE_BEGIN
    GEMM(pg8::EpiRes, P_ATT, P_W_OUT, 1024, 1024, KA(x), P_H, DM);
    PHASE_END
    PHASE_BEGIN
    for (int rep_ = 0; rep_ < REP_RMS; ++rep_)
    rms_phase_bf16(P_H, KA(norm_mlp), P_HN, gw, ngw, lane);
    PHASE_END
    PHASE_BEGIN
    for (int rep_ = 0; rep_ < REP_UP; ++rep_)
    GEMM(pg8::Epi16<pg8::M_RELU2>, P_HN, P_W1_0, DFF, 1024, P_U, DFF, nullptr);
    PHASE_END
    PHASE_BEGIN
    GEMM(pg8::EpiRes, P_U, P_W2_0, 1024, DFF, P_H, P_H, DM);
    PHASE_END
    PHASE_BEGIN
    for (int rep_ = 0; rep_ < REP_XMIX; ++rep_)
    xmix_phase(P_H, KA(norm_mix) + DM, KA(rwkv_mu), P_X6, gw, ngw, lane);
    PHASE_END
    PHASE_BEGIN
    for (int rep_ = 0; rep_ < REP_LORA; ++rep_) {
    GEMM(pg8::Epi16<pg8::M_TANH>, P_X6 + 3 * (size_t)NTOK * DM, P_LW1, 256, 1024, P_TT, 256, nullptr);
    GEMM(pg8::Epi16<pg8::M_PLAIN>, P_X6 + 4 * (size_t)NTOK * DM, P_LA1, 256, 1024, P_TT + (size_t)NTOK * 256, 256, nullptr);
    GEMM(pg8::Epi16<pg8::M_SIGMOID>, P_X6 + 5 * (size_t)NTOK * DM, P_LG1, 256, 1024, P_TT + (size_t)2 * NTOK * 256, 256, nullptr); }
    PHASE_END
    PHASE_BEGIN
    GEMM(pg8::Epi16<pg8::M_PLAIN>, P_X6, P_WR, 1024, 1024, P_RKV, DM, nullptr);
    GEMM(pg8::Epi16<pg8::M_PLAIN>, P_X6 + (size_t)NTOK * DM, P_WK, 1024, 1024, P_RKV + (size_t)NTOK * DM, DM, nullptr);
    GEMM(pg8::Epi16<pg8::M_PLAIN>, P_X6 + 2 * (size_t)NTOK * DM, P_WV, 1024, 1024, P_RKV + 2 * (size_t)NTOK * DM, DM, nullptr);
    PHASE_END
    PHASE_BEGIN
    for (int rep_ = 0; rep_ < REP_LORA; ++rep_) {
    GEMM(pg8::Epi16<pg8::M_WLOG>, P_TT, P_LW2, 1024, 256, P_WAG, DM, KA(rwkv_w0));
    GEMM(pg8::Epi16<pg8::M_ASIG>, P_TT + (size_t)NTOK * 256, P_LA2, 1024, 256, P_WAG + (size_t)NTOK * DM, DM, KA(rwkv_a0));
    GEMM(pg8::Epi16<pg8::M_PLAIN>, P_TT + (size_t)2 * NTOK * 256, P_LG2, 1024, 256, P_WAG + 2 * (size_t)NTOK * DM, DM, nullptr); }
    PHASE_END
    PHASE_BEGIN
    for (int rep_ = 0; rep_ < REP_SCAN; ++rep_)
    for (int u = bx; u < 256; u += G)
        scan_unit(P_RKV, P_RKV + (size_t)NTOK * DM, P_RKV + 2 * (size_t)NTOK * DM, (const unsigned short*)P_WAG, P_WAG + (size_t)NTOK * DM, P_WAG + 2 * (size_t)NTOK * DM,
                  KA(rwkv_k_k), KA(rwkv_k_a), KA(rwkv_r_k), KA(rwkv_ln_w), KA(rwkv_ln_b), P_Z, u >> 4, u & 15, lds);
    PHASE_END
    PHASE_BEGIN
    GEMM(pg8::EpiRes, P_Z, P_WO, 1024, 1024, P_H, P_H, DM);
    PHASE_END
    PHASE_BEGIN
    rms_phase_bf16(P_H, KA(norm_mlp) + DM, P_HN, gw, ngw, lane);
    PHASE_END
    PHASE_BEGIN
    GEMM(pg8::Epi16<pg8::M_RELU2>, P_HN, P_W1_1, DFF, 1024, P_U, DFF, nullptr);
    PHASE_END
    PHASE_BEGIN
    GEMM(pg8::EpiRes, P_U, P_W2_1, 1024, DFF, P_H, P_H, DM);
    PHASE_END
    PHASE_BEGIN
    rms_phase_f32(P_H, KA(norm_final), P_H, gw, ngw, lane);
    PHASE_END
#ifdef DBG_CHECK
    { TIDV
      const float* CTLp = P_CTL; int bad = 0; float ev = 0.f;
      for (int k = 1; k < 20; ++k) { const float e = CTLp[16 + k]; if (bad == 0 && !(e < 0.03f)) { bad = k; ev = (e == e) ? e : 9.99f; } }
      if (bad) { float* o = P_H; const float c = sqrtf(10.f * (float)bad); for (size_t i = gt; i < (size_t)NTOK * DM; i += ngt) o[i] = c; if (gt == 0) o[0] = 1000.f * ev; } }
#endif
}
constexpr int N_PHASES = 18;

extern "C" void kernel_launch(void* const* d_in, const int* in_sizes, int n_in, void* d_out, int out_size, void* d_ws, size_t ws_size, hipStream_t stream) {
    static int grid = 0;
    if (grid == 0) {
        if (n_in != 28 || in_sizes[0] != NTOK * DM || out_size != NTOK * DM || ws_size < WS_END) { fprintf(stderr, "kernel_launch: unexpected shapes (n_in %d, ws %zu)\n", n_in, ws_size); grid = -1; return; }
        int dev = 0, cus = 0, per_cu = 0;
        hipGetDevice(&dev); hipDeviceGetAttribute(&cus, hipDeviceAttributeMultiprocessorCount, dev);
        if (hipFuncSetAttribute((const void*)hybrid_fwd, hipFuncAttributeMaxDynamicSharedMemorySize, LDS_BYTES) != hipSuccess) { fprintf(stderr, "kernel_launch: hipFuncSetAttribute failed\n"); grid = -1; return; }
        hipOccupancyMaxActiveBlocksPerMultiprocessor(&per_cu, (const void*)hybrid_fwd, NTHR, LDS_BYTES);
        (void)hipGetLastError();
        if (per_cu < 1) per_cu = 1;
        grid = cus * per_cu;
        fprintf(stderr, "kernel_launch: %d CUs x %d -> grid %d\n", cus, per_cu, grid);
    }
    if (grid < 0) return;
    if (hipMemsetAsync(d_ws, 0, CTL_ZERO_BYTES, stream) != hipSuccess) { fprintf(stderr, "kernel_launch: hipMemsetAsync failed\n"); return; }
    Args a{};
    const float** fp = (const float**)&a;
    for (int i = 0; i < 28; ++i) fp[i] = (const float*)d_in[i];
    a.out = (float*)d_out; a.ws = (unsigned char*)d_ws; a.ph_lo = 0; a.ph_hi = N_PHASES;
    void* args[] = {&a};
    hipError_t e = hipLaunchCooperativeKernel((const void*)hybrid_fwd, dim3(grid), dim3(NTHR), args, LDS_BYTES, stream);
    if (e != hipSuccess) fprintf(stderr, "cooperative launch failed: %s (grid %d)\n", hipGetErrorString(e), grid);
}
```

```cpp
#include <hip/hip_runtime.h>
#include <hip/hip_cooperative_groups.h>
#include <cstdio>
#include <cstdint>
namespace cg = cooperative_groups;
namespace pg8 {
#define PG8_LAS __attribute__((address_space(3)))
typedef unsigned short bf16_t;
typedef short bf16x8 __attribute__((ext_vector_type(8)));
typedef float f32x4 __attribute__((ext_vector_type(4)));
typedef unsigned u32x4 __attribute__((ext_vector_type(4)));
constexpr int BM = 256, BK = 64, HALF = 128, HTB = HALF * BK * 2  , STAGE_BYTES = 8 * HTB, NXCD = 8, WGM = 8;

__host__ __device__ __forceinline__ int lds_byte(int r, int c) { const int st = (r >> 4) * 2 + (c >> 5), rr = r & 15, cc = c & 31, ob = rr * 64 + cc * 2; return st * 1024 + (ob ^ (((ob >> 9) & 1) << 5)); }
__host__ __device__ __forceinline__ void stage_rc(int b, int& R, int& C) { const int st = b / 1024, sb = b % 1024, swz = sb ^ (((sb >> 9) & 1) << 5); R = (st >> 1) * 16 + swz / 64; C = (st & 1) * 32 + (swz % 64) / 2; }
__host__ __device__ __forceinline__ int perm32(int rho) { const int n = rho >> 4, i = rho & 15; return 8 * (i >> 2) + 4 * n + (i & 3); }

struct Unit { int pm, pn; };
struct Gemm { const bf16_t* A; const bf16_t* Bt; int M, N, K; };

struct StaticOrder {
    int nM, nN, nwg, G, c;
    __host__ __device__ void init(int M, int N, int G_, int c_) { nM = M / BM; nN = N / BM; nwg = nM * nN; G = G_; c = c_; }
    __host__ __device__ bool next(int i, Unit& u) const {
        const long L = (long)i * G + c; if (L >= nwg) return false;
        int wgid = (int)L; { const int q = nwg / NXCD, r = nwg % NXCD, xcd = wgid % NXCD, off = wgid / NXCD; wgid = (xcd < r ? xcd * (q + 1) : r * (q + 1) + (xcd - r) * q) + off; }
        const int nig = WGM * nN, gid = wgid / nig, fm = gid * WGM, gsz = (nM - fm) < WGM ? (nM - fm) : WGM;
        u.pm = fm + ((wgid % nig) % gsz); u.pn = (wgid % nig) / gsz; return true;
    }
    __device__ __forceinline__ void a_ready(const Unit&) const {}
    __device__ __forceinline__ void done(const Unit&) const {}
};

__device__ __forceinline__ unsigned cvt_pk_bf16(float lo, float hi) { unsigned r; asm volatile("v_cvt_pk_bf16_f32 %0, %1, %2" : "=v"(r) : "v"(lo), "v"(hi)); return r; }
typedef float f32x2 __attribute__((ext_vector_type(2)));
typedef unsigned u32x4 __attribute__((ext_vector_type(4)));
typedef _Float16 f16x2 __attribute__((ext_vector_type(2)));
__device__ __forceinline__ unsigned cvt_pk_f16(float lo, float hi) { f32x2 v = {lo, hi}; f16x2 h = __builtin_convertvector(v, f16x2); return __builtin_bit_cast(unsigned, h); }
enum { M_PLAIN = 0, M_RELU2 = 1, M_TANH = 2, M_SIGMOID = 3, M_QKV = 4, M_ASIG = 5, M_WLOG = 6 };
template <int MODE> struct Epi16 {
    static constexpr bool PERM = true, AFTER_DRAIN = false;
    bf16_t* O; int ldc; const float* vec;
    __device__ __forceinline__ void operator()(const f32x4 (&acc)[2][2][4][2], const Unit& u, int wr, int wc, int fr, int fq) const {
        const int row0 = u.pm * BM + wr * 64 + fr;
        const int col0 = u.pn * BM + wc * 32 + 8 * fq;
        const int sec = u.pn >> 1;
        const bool rope = (MODE == M_QKV) && (sec != 2) && (sec != 5);
        const bool rot_wave = rope && ((wc & 1) == 0);
        const float qs = (MODE == M_QKV && (sec == 0 || sec == 3)) ? (0.125f * 1.4426950408889634f) : 1.0f;
        f32x4 bias_[2][2];
        if (MODE == M_ASIG || MODE == M_WLOG) {
#pragma unroll
            for (int bj = 0; bj < 2; ++bj) { bias_[bj][0] = *(const f32x4*)(vec + col0 + bj * HALF); bias_[bj][1] = *(const f32x4*)(vec + col0 + bj * HALF + 4); }
        }
#pragma unroll
        for (int ai = 0; ai < 2; ++ai) {
            f32x4 tab[4][4];
            if (MODE == M_QKV) { if (rot_wave) {
#pragma unroll
                for (int m = 0; m < 4; ++m) { const float* t = vec + (size_t)((row0 + ai * HALF + m * 16) & 4095) * 16;
#pragma unroll
                    for (int q = 0; q < 4; ++q) tab[m][q] = *(const f32x4*)(t + 4 * q); } } }
#pragma unroll
            for (int m = 0; m < 4; ++m) {
                const int row = row0 + ai * HALF + m * 16;
                bf16_t* rowp = O + (size_t)row * ldc + col0;
                f32x4 cs0 = {1.f, 1.f, 1.f, 1.f}, cs1 = cs0, sn0 = {0.f, 0.f, 0.f, 0.f}, sn1 = sn0;
                if (MODE == M_QKV) { if (rot_wave) { cs0 = tab[m][0]; cs1 = tab[m][1]; sn0 = tab[m][2]; sn1 = tab[m][3]; } }
#pragma unroll
                for (int bj = 0; bj < 2; ++bj) {
                    f32x4 v0 = acc[ai][bj][m][0], v1 = acc[ai][bj][m][1];
                    if (MODE == M_QKV) {
                        if (rot_wave) {
                            f32x4 p0, p1;
#pragma unroll
                            for (int e = 0; e < 4; ++e) {
                                const unsigned b0_ = __float_as_uint(v0[e]), b1_ = __float_as_uint(v1[e]);
                                auto r0_ = __builtin_amdgcn_permlane16_swap(b0_, b0_, false, false); auto r1_ = __builtin_amdgcn_permlane16_swap(b1_, b1_, false, false);
                                p0[e] = __uint_as_float((fq & 1) ? r0_[0] : r0_[1]); p1[e] = __uint_as_float((fq & 1) ? r1_[0] : r1_[1]);
                            }
                            if (fq < 2) { const float sg = (fq == 0) ? -1.f : 1.f; v0 = v0 * cs0 + (p0 * sn0) * sg; v1 = v1 * cs1 + (p1 * sn1) * sg; }
                        }
                        v0 = v0 * qs; v1 = v1 * qs;
                    }
                    if (MODE == M_RELU2) {
#pragma unroll
                        for (int e = 0; e < 4; ++e) { const float a = fmaxf(v0[e], 0.f), b = fmaxf(v1[e], 0.f); v0[e] = a * a; v1[e] = b * b; }
                    }
                    if (MODE == M_TANH) {
#pragma unroll
                        for (int e = 0; e < 4; ++e) { v0[e] = 1.f - 2.f * __builtin_amdgcn_rcpf(1.f + __builtin_amdgcn_exp2f(fminf(v0[e] * 2.885390081777927f, 60.f))); v1[e] = 1.f - 2.f * __builtin_amdgcn_rcpf(1.f + __builtin_amdgcn_exp2f(fminf(v1[e] * 2.885390081777927f, 60.f))); }
                    }
                    if (MODE == M_SIGMOID) {
#pragma unroll
                        for (int e = 0; e < 4; ++e) { v0[e] = 1.f / (1.f + __expf(-v0[e])); v1[e] = 1.f / (1.f + __expf(-v1[e])); }
                    }
                    if (MODE == M_ASIG) {
                        const f32x4 b0 = bias_[bj][0], b1 = bias_[bj][1];
#pragma unroll
                        for (int e = 0; e < 4; ++e) { v0[e] = 1.f / (1.f + __expf(-(v0[e] + b0[e]))); v1[e] = 1.f / (1.f + __expf(-(v1[e] + b1[e]))); }
                    }
                    u32x4 w;
                    if (MODE == M_WLOG) {
                        const f32x4 b0 = bias_[bj][0], b1 = bias_[bj][1];
#pragma unroll
                        for (int e = 0; e < 4; ++e) {
                            const float x0 = -(v0[e] + b0[e]), x1 = -(v1[e] + b1[e]);
                            const float s0 = fmaxf(x0, 0.f) + 0.6931471805599453f * __builtin_amdgcn_logf(1.f + __builtin_amdgcn_exp2f(-1.4426950408889634f * fabsf(x0)));
                            const float s1 = fmaxf(x1, 0.f) + 0.6931471805599453f * __builtin_amdgcn_logf(1.f + __builtin_amdgcn_exp2f(-1.4426950408889634f * fabsf(x1)));
                            v0[e] = -__builtin_amdgcn_exp2f(-1.4426950408889634f * (s0 + 0.5f)); v1[e] = -__builtin_amdgcn_exp2f(-1.4426950408889634f * (s1 + 0.5f));
                        }
                        w.x = cvt_pk_f16(v0[0], v0[1]); w.y = cvt_pk_f16(v0[2], v0[3]); w.z = cvt_pk_f16(v1[0], v1[1]); w.w = cvt_pk_f16(v1[2], v1[3]);
                    } else {
                        w.x = cvt_pk_bf16(v0[0], v0[1]); w.y = cvt_pk_bf16(v0[2], v0[3]); w.z = cvt_pk_bf16(v1[0], v1[1]); w.w = cvt_pk_bf16(v1[2], v1[3]);
                    }
                    *(u32x4*)(rowp + bj * HALF) = w;
                }
            }
        }
    }
};
struct EpiRes {
    static constexpr bool PERM = false, AFTER_DRAIN = false;
    const float* res; float* out; int ldc;
    __device__ __forceinline__ void operator()(const f32x4 (&acc)[2][2][4][2], const Unit& u, int wr, int wc, int fr, int fq) const {
        const int row0 = u.pm * BM + wr * 64 + fr, col0 = u.pn * BM + wc * 32 + 4 * fq;
#pragma unroll
        for (int ai = 0; ai < 2; ++ai)
#pragma unroll
            for (int m = 0; m < 4; ++m) {
                const size_t off = (size_t)(row0 + ai * HALF + m * 16) * ldc + col0;
#pragma unroll
                for (int bj = 0; bj < 2; ++bj)
#pragma unroll
                    for (int n = 0; n < 2; ++n) { const f32x4 r = *(const f32x4*)(res + off + bj * HALF + n * 16); *(f32x4*)(out + off + bj * HALF + n * 16) = r + acc[ai][bj][m][n]; }
            }
    }
};
template <class Epi, class Sched, bool ALIGN_EPI = false, bool SP2 = false>
__device__ __forceinline__ void gemm_phase(PG8_LAS unsigned char* lds, const Gemm g, const Sched& S, const Epi& E) {
    int tid = threadIdx.x; asm volatile("" : "+v"(tid)); const int wid = __builtin_amdgcn_readfirstlane(tid >> 6), lane = tid & 63, wr = wid >> 2, wc = wid & 3, fr = lane & 15, fq = lane >> 4;
    const int K = g.K, nt = K / BK;
    unsigned voffA[2], voffB[2];
#pragma unroll
    for (int i = 0; i < 2; ++i) { int R, C; stage_rc(tid * 16 + i * 8192, R, C); const int Rb = Epi::PERM ? ((R & ~31) + perm32(R & 31)) : R;
        voffA[i] = (unsigned)(R * K + C) * 2u; voffB[i] = (unsigned)(Rb * K + C) * 2u; }
    const size_t kstep = (size_t)(BK * 2);
    const size_t hstep = (size_t)HALF * K * 2;
    const size_t tstep = 2 * hstep;
    const unsigned ldsw = (unsigned)wid * 1024u;
    const int aoff = lds_byte(wr * 64 + fr, fq * 8), boff = lds_byte(wc * 32 + fr, fq * 8);
#define PG8_SA(b, h) (((b) * 2 + (h)) * HTB)
#define PG8_SB(b, h) ((4 + (b) * 2 + (h)) * HTB)
#define PG8_STAGE(bufoff, gbase, voff) do { _Pragma("unroll") for (int _i = 0; _i < 2; ++_i) \
        __builtin_amdgcn_global_load_lds((const unsigned*)((const char*)(gbase) + (voff)[_i]), (PG8_LAS unsigned*)(lds + (bufoff) + ldsw + _i * 8192), 16, 0, 0); } while (0)
#define PG8_LDA(dst, b, h) do { _Pragma("unroll") for (int m = 0; m < 4; ++m) _Pragma("unroll") for (int k = 0; k < 2; ++k) dst[m][k] = *(const PG8_LAS bf16x8*)(lds + PG8_SA(b, h) + aoff + m * 2048 + k * 1024); } while (0)
#define PG8_LDB(dst, b, h) do { _Pragma("unroll") for (int n = 0; n < 2; ++n) _Pragma("unroll") for (int k = 0; k < 2; ++k) dst[n][k] = *(const PG8_LAS bf16x8*)(lds + PG8_SB(b, h) + boff + n * 2048 + k * 1024); } while (0)
#define PG8_MMA(ai, bj, At, Bt) do { __builtin_amdgcn_s_setprio(1); _Pragma("unroll") for (int m = 0; m < 4; ++m) _Pragma("unroll") for (int n = 0; n < 2; ++n) _Pragma("unroll") for (int k = 0; k < 2; ++k) \
        acc[ai][bj][m][n] = __builtin_amdgcn_mfma_f32_16x16x32_bf16(Bt[n][k], At[m][k], acc[ai][bj][m][n], 0, 0, 0); __builtin_amdgcn_s_setprio(0); } while (0)
#define PG8_WAIT_V(n) asm volatile("s_waitcnt vmcnt(" #n ")" ::: "memory")
#define PG8_WAIT_L(n) asm volatile("s_waitcnt lgkmcnt(" #n ")" ::: "memory")
#define PG8_BAR __builtin_amdgcn_s_barrier()
#define PG8_SCHED __builtin_amdgcn_sched_barrier(0)
    Unit cur, nxt; int ui = 0;
    if (!S.next(0, cur)) return;
    f32x4 acc[2][2][4][2];
#pragma unroll
    for (int a = 0; a < 2; ++a)
#pragma unroll
        for (int b = 0; b < 2; ++b)
#pragma unroll
            for (int m = 0; m < 4; ++m)
#pragma unroll
                for (int n = 0; n < 2; ++n) acc[a][b][m][n] = (f32x4){0.f, 0.f, 0.f, 0.f};
    bf16x8 At[4][2], B0[2][2], B1[2][2];
    const char* cA = (const char*)g.A + (size_t)cur.pm * tstep; const char* cB = (const char*)g.Bt + (size_t)cur.pn * tstep;
    S.a_ready(cur);
    if constexpr (SP2) {
        PG8_STAGE(PG8_SB(0, 0), cB, voffB); PG8_STAGE(PG8_SB(0, 1), cB + hstep, voffB); PG8_STAGE(PG8_SA(0, 0), cA, voffA); PG8_STAGE(PG8_SA(0, 1), cA + hstep, voffA);
        if (wr == 1) PG8_BAR;
        PG8_WAIT_V(2); PG8_BAR;
        PG8_STAGE(PG8_SB(1, 0), cB + kstep, voffB); PG8_STAGE(PG8_SA(1, 0), cA + kstep, voffA); PG8_STAGE(PG8_SB(1, 1), cB + hstep + kstep, voffB);
        PG8_WAIT_V(6); PG8_BAR;
    } else {
        PG8_STAGE(PG8_SB(0, 0), cB, voffB); PG8_STAGE(PG8_SA(0, 0), cA, voffA); PG8_STAGE(PG8_SB(0, 1), cB + hstep, voffB); PG8_STAGE(PG8_SA(0, 1), cA + hstep, voffA);
        if (wr == 1) PG8_BAR;
        PG8_WAIT_V(4); PG8_BAR;
        PG8_STAGE(PG8_SB(1, 0), cB + kstep, voffB); PG8_STAGE(PG8_SA(1, 0), cA + kstep, voffA); PG8_STAGE(PG8_SB(1, 1), cB + hstep + kstep, voffB);
        PG8_WAIT_V(6); PG8_BAR;
    }
    for (;;) {
        const bool has_next = S.next(ui + 1, nxt);
        const char* nA = has_next ? (const char*)g.A + (size_t)nxt.pm * tstep : cA; const char* nB = has_next ? (const char*)g.Bt + (size_t)nxt.pn * tstep : cB;
        for (int t = 0; t < nt; t += 2) {
            const bool last = (t == nt - 2);
            const char* a1 = cA + (size_t)(t + 1) * kstep;
            const char* a2 = last ? nA : cA + (size_t)(t + 2) * kstep; const char* b2 = last ? nB : cB + (size_t)(t + 2) * kstep;
            const char* a3 = a2 + kstep; const char* b3 = b2 + kstep;
            if (last && has_next) S.a_ready(nxt);
            if constexpr (SP2) {
            PG8_LDB(B0, 0, 0); PG8_LDB(B1, 0, 1); PG8_SCHED; PG8_LDA(At, 0, 0); PG8_STAGE(PG8_SA(1, 1), a1 + hstep, voffA);
            PG8_WAIT_V(8); PG8_WAIT_L(0); PG8_BAR; PG8_MMA(0, 0, At, B0); PG8_MMA(0, 1, At, B1); PG8_BAR; PG8_SCHED;
            PG8_LDA(At, 0, 1); PG8_STAGE(PG8_SB(0, 0), b2, voffB); PG8_STAGE(PG8_SB(0, 1), b2 + hstep, voffB); PG8_STAGE(PG8_SA(0, 0), a2, voffA);
            PG8_WAIT_V(8); PG8_WAIT_L(0); PG8_BAR; PG8_MMA(1, 0, At, B0); PG8_MMA(1, 1, At, B1); PG8_BAR; PG8_SCHED;
            PG8_LDB(B0, 1, 0); PG8_LDB(B1, 1, 1); PG8_SCHED; PG8_LDA(At, 1, 0); PG8_STAGE(PG8_SA(0, 1), a2 + hstep, voffA);
            PG8_WAIT_V(8); PG8_WAIT_L(0); PG8_BAR; PG8_MMA(0, 0, At, B0); PG8_MMA(0, 1, At, B1); PG8_BAR; PG8_SCHED;
            PG8_LDA(At, 1, 1); PG8_STAGE(PG8_SB(1, 0), b3, voffB); PG8_STAGE(PG8_SB(1, 1), b3 + hstep, voffB); PG8_STAGE(PG8_SA(1, 0), a3, voffA);
            PG8_WAIT_V(8); PG8_WAIT_L(0); PG8_BAR; PG8_MMA(1, 0, At, B0); PG8_MMA(1, 1, At, B1); PG8_BAR; PG8_SCHED;
            } else {
            PG8_LDB(B0, 0, 0); PG8_SCHED; PG8_LDA(At, 0, 0); PG8_STAGE(PG8_SA(1, 1), a1 + hstep, voffA);
            PG8_WAIT_L(8); PG8_BAR; PG8_WAIT_L(0); PG8_MMA(0, 0, At, B0); PG8_BAR; PG8_SCHED;
            PG8_LDB(B1, 0, 1); PG8_STAGE(PG8_SB(0, 0), b2, voffB);
            PG8_BAR; PG8_WAIT_L(0); PG8_MMA(0, 1, At, B1); PG8_BAR;
            PG8_LDA(At, 0, 1); PG8_STAGE(PG8_SA(0, 0), a2, voffA);
            PG8_BAR; PG8_WAIT_L(0); PG8_MMA(1, 0, At, B0); PG8_BAR; PG8_SCHED;
            PG8_STAGE(PG8_SB(0, 1), b2 + hstep, voffB);
            PG8_WAIT_V(6); PG8_BAR; PG8_MMA(1, 1, At, B1); PG8_BAR;
            PG8_LDB(B0, 1, 0); PG8_SCHED; PG8_LDA(At, 1, 0); PG8_STAGE(PG8_SA(0, 1), a2 + hstep, voffA);
            PG8_WAIT_L(8); PG8_BAR; PG8_WAIT_L(0); PG8_MMA(0, 0, At, B0); PG8_BAR; PG8_SCHED;
            PG8_LDB(B1, 1, 1); PG8_STAGE(PG8_SB(1, 0), b3, voffB);
            PG8_BAR; PG8_WAIT_L(0); PG8_MMA(0, 1, At, B1); PG8_BAR;
            PG8_LDA(At, 1, 1); PG8_STAGE(PG8_SA(1, 0), a3, voffA);
            PG8_BAR; PG8_WAIT_L(0); PG8_MMA(1, 0, At, B0); PG8_BAR; PG8_SCHED;
            PG8_STAGE(PG8_SB(1, 1), b3 + hstep, voffB);
            PG8_WAIT_V(6); PG8_BAR; PG8_MMA(1, 1, At, B1); PG8_BAR;
            }
        }
        if constexpr (ALIGN_EPI) { if (wr == 0) PG8_BAR; }
        if constexpr (!Epi::AFTER_DRAIN) { E(acc, cur, wr, wc, fr, fq); S.done(cur); }
        if (!has_next) break;
#pragma unroll
        for (int a = 0; a < 2; ++a)
#pragma unroll
            for (int b = 0; b < 2; ++b)
#pragma unroll
                for (int m = 0; m < 4; ++m)
#pragma unroll
                    for (int n = 0; n < 2; ++n) acc[a][b][m][n] = (f32x4){0.f, 0.f, 0.f, 0.f};
        cur = nxt; cA = nA; cB = nB; ++ui;
        if constexpr (ALIGN_EPI) { if (wr == 1) PG8_BAR; }
    }
    PG8_WAIT_V(0);
    if constexpr (!ALIGN_EPI) { if (wr == 0) PG8_BAR; }
    PG8_BAR;
    if constexpr (Epi::AFTER_DRAIN) { E.fused(acc, cur, wr, wc, fr, fq, lds, wid, lane); S.done(cur); }
#undef PG8_SA
#undef PG8_SB
#undef PG8_STAGE
#undef PG8_LDA
#undef PG8_LDB
#undef PG8_MMA
#undef PG8_WAIT_V
#undef PG8_WAIT_L
#undef PG8_BAR
#undef PG8_SCHED
}
}
#define LAS __attribute__((address_space(3)))
typedef unsigned short bf16;
typedef float f32x4 __attribute__((ext_vector_type(4)));
typedef float f32x2 __attribute__((ext_vector_type(2)));
typedef float f32x16 __attribute__((ext_vector_type(16)));
typedef short bf16x8 __attribute__((ext_vector_type(8)));
typedef short s16x4 __attribute__((ext_vector_type(4)));
typedef unsigned u32x4 __attribute__((ext_vector_type(4)));
typedef unsigned u32x2 __attribute__((ext_vector_type(2)));

#ifndef REP_LORA
#define REP_LORA 1
#endif
#ifndef REP_UP
#define REP_UP 1
#endif
#ifndef REP_RMS
#define REP_RMS 1
#endif
#ifndef REP_XMIX
#define REP_XMIX 1
#endif
#ifndef REP_ATTN
#define REP_ATTN 1
#endif
#ifndef REP_ATTNA
#define REP_ATTNA 1
#endif
#ifndef REP_SCAN
#define REP_SCAN 1
#endif
constexpr int NWAVES = 8, NTHR = 512;
constexpr int NTOK = 65536, DM = 1024, SEQ = 4096, NBATCH = 16, DFF = 4096, QKVC = 3072;
constexpr size_t MiB = (size_t)1 << 20;
constexpr size_t WS_CTL = 0;
constexpr size_t WS_WIN = 1 * MiB, WS_WOUT = 7 * MiB, WS_W1_0 = 9 * MiB, WS_W2_0 = 17 * MiB, WS_W1_1 = 25 * MiB, WS_W2_1 = 33 * MiB;
constexpr size_t WS_WR = 41 * MiB, WS_WK = 43 * MiB, WS_WV = 45 * MiB, WS_WO = 47 * MiB;
constexpr size_t WS_LW1 = 49 * MiB, WS_LA1 = WS_LW1 + 512 * 1024, WS_LG1 = 50 * MiB, WS_LW2 = WS_LG1 + 512 * 1024, WS_LA2 = 51 * MiB, WS_LG2 = WS_LA2 + 512 * 1024;
constexpr size_t WS_ROPE = 52 * MiB;
constexpr size_t WS_HN = 65 * MiB;
constexpr size_t WS_QKV = 193 * MiB;
constexpr size_t WS_ATT = 577 * MiB;
constexpr size_t WS_OAP = 705 * MiB;
constexpr size_t WS_LSE = 897 * MiB;
constexpr size_t WS_U = 193 * MiB;
constexpr size_t WS_X6 = 65 * MiB;
constexpr size_t WS_T = 833 * MiB;
constexpr size_t WS_RKV = 449 * MiB;
constexpr size_t WS_WAG = 65 * MiB;
constexpr size_t WS_Z = 833 * MiB;
constexpr size_t WS_END = 961 * MiB;
constexpr size_t ACT = (size_t)NTOK * DM * 2;

constexpr int RING_BYTES = 131072, LDS_BYTES = 147456;
constexpr int LDS_BARST = 147200;
constexpr size_t WS_BAR = 16384;
constexpr size_t CTL_ZERO_BYTES = 65536;
#define XB_TMO      128
#define XB_XCNT(j)  (256  + 64 * (j))
#define XB_XSUB(j)  (1280 + 64 * (j))
#define XB_XGEN(j)  (2304 + 64 * (j))
#define XB_TOP      3328
#define XB_TOPGEN   3392
#define XCD_BAR_WORDS 3456
#define XB_SPIN_CAP (1u << 18)

__device__ __forceinline__ unsigned xb_ld(unsigned* p)              { return __hip_atomic_load(p, __ATOMIC_RELAXED, __HIP_MEMORY_SCOPE_AGENT); }
__device__ __forceinline__ unsigned xb_add(unsigned* p, unsigned v) { return __hip_atomic_fetch_add(p, v, __ATOMIC_RELAXED, __HIP_MEMORY_SCOPE_AGENT); }
__device__ __forceinline__ unsigned xb_xcc_id() { return (unsigned)__builtin_amdgcn_s_getreg((3 << 11) | 20) & 0xFu; }
#define XB_SPIN(cond, bar) do { unsigned _sp = 0; while (cond) { __builtin_amdgcn_s_sleep(1); \
    if ((++_sp & 255u) == 0u) { if (xb_ld(&(bar)[XB_TMO])) break; if (_sp > XB_SPIN_CAP) { atomicAdd(&(bar)[XB_TMO], 1u); break; } } } } while (0)

struct XcdBarrier {
    unsigned* bar; unsigned x;
    volatile LAS unsigned* st;
};

__device__ __forceinline__ XcdBarrier xcd_barrier_post(unsigned* bar, volatile LAS unsigned* st) {
    XcdBarrier b; b.bar = bar; b.x = xb_xcc_id(); b.st = st;
    if (threadIdx.x == 0) (void)xb_add(&bar[XB_XCNT(b.x)], 1u);
    return b;
}
__device__ __forceinline__ void xcd_barrier_complete(unsigned* bar, unsigned x, unsigned& nloc, unsigned& nx) {
    const unsigned G = gridDim.x * gridDim.y * gridDim.z;
    unsigned sum, cnt, mine, sp = 0u;
    for (;;) {
        sum = 0u; cnt = 0u; mine = 0u;
#pragma unroll
        for (unsigned j = 0; j < 16; ++j) { const unsigned c = xb_ld(&bar[XB_XCNT(j)]); sum += c; cnt += (c > 0u) ? 1u : 0u; mine = (j == x) ? c : mine; }
        if (sum == G) break;
        __builtin_amdgcn_s_sleep(1);
        if ((++sp & 255u) == 0u) { if (xb_ld(&bar[XB_TMO])) break; if (sp > XB_SPIN_CAP) { atomicAdd(&bar[XB_TMO], 1u); break; } }
    }
    nloc = mine > 0u ? mine : 1u; nx = cnt > 0u ? cnt : 1u;
}

__device__ __forceinline__ void xcd_barrier(const XcdBarrier& b) {
    asm volatile("s_waitcnt vmcnt(0)" ::: "memory");
    __syncthreads();
    if (threadIdx.x == 0) {
        unsigned* bar = b.bar;
        __builtin_amdgcn_s_waitcnt(0);
        unsigned nloc = b.st[0], nx = b.st[1];
        if (nloc == 0u) { xcd_barrier_complete(bar, b.x, nloc, nx); b.st[0] = nloc; b.st[1] = nx; }
        const unsigned old = xb_add(&bar[XB_XSUB(b.x)], 1u);
        const unsigned gen = old / nloc;
        if (old + 1u == (gen + 1u) * nloc) {
            __builtin_amdgcn_fence(__ATOMIC_RELEASE, "agent");
            asm volatile("s_waitcnt vmcnt(0)" ::: "memory");
            const unsigned og = xb_add(&bar[XB_TOP], 1u);
            const unsigned tg = og / nx;
            if (og + 1u == (tg + 1u) * nx) xb_add(&bar[XB_TOPGEN], 1u);
            else XB_SPIN(xb_ld(&bar[XB_TOPGEN]) == tg, bar);
            __builtin_amdgcn_fence(__ATOMIC_ACQUIRE, "agent");
            xb_add(&bar[XB_XGEN(b.x)], 1u);
            asm volatile("s_waitcnt vmcnt(0)" ::: "memory");
        } else {
            XB_SPIN(xb_ld(&bar[XB_XGEN(b.x)]) == gen, bar);
            __builtin_amdgcn_fence(__ATOMIC_ACQUIRE, "agent");
            asm volatile("s_waitcnt vmcnt(0)" ::: "memory");
        }
    }
    __syncthreads();
}


__device__ __forceinline__ unsigned pkbf(float lo, float hi) { return pg8::cvt_pk_bf16(lo, hi); }
__device__ __forceinline__ float bf2f(unsigned short h) { return __uint_as_float(((unsigned)h) << 16); }
__device__ __forceinline__ float bflo(unsigned w) { return __uint_as_float(w << 16); }
__device__ __forceinline__ float bfhi(unsigned w) { return __uint_as_float(w & 0xffff0000u); }
__device__ __forceinline__ float wave_sum(float v) {
#define WS_DPP_(x, ctrl, rmask, bctl) __int_as_float(__builtin_amdgcn_update_dpp(0, __float_as_int(x), (ctrl), (rmask), 0xF, (bctl)))
    v += WS_DPP_(v, 0xB1, 0xF, true);
    v += WS_DPP_(v, 0x4E, 0xF, true);
    v += WS_DPP_(v, 0x124, 0xF, true);
    v += WS_DPP_(v, 0x128, 0xF, true);
    v += WS_DPP_(v, 0x142, 0xA, false);
    v += WS_DPP_(v, 0x143, 0xC, false);
#undef WS_DPP_
    return __int_as_float(__builtin_amdgcn_readlane(__float_as_int(v), 63));
}

struct Args {
    const float* x; const float* norm_mix; const float* norm_mlp; const float* norm_final;
    const float* attn_w_in; const float* attn_w_out; const float* diff_lambda; const float* diff_subln;
    const float* rwkv_mu; const float* rwkv_w_r; const float* rwkv_w_k; const float* rwkv_w_v; const float* rwkv_w_o;
    const float* rwkv_w0; const float* rwkv_w1; const float* rwkv_w2; const float* rwkv_a0; const float* rwkv_a1; const float* rwkv_a2;
    const float* rwkv_g1; const float* rwkv_g2; const float* rwkv_k_k; const float* rwkv_k_a; const float* rwkv_r_k;
    const float* rwkv_ln_w; const float* rwkv_ln_b; const float* mlp_w1; const float* mlp_w2;
    float* out; unsigned char* ws; int ph_lo, ph_hi;
};

__device__ __forceinline__ void transpose_item(const float* __restrict__ W, int N, bf16* __restrict__ WT, int pitch, LAS float* scr, int item, int lane) {
    const int nblk = N >> 5, kb = item / nblk, nb = item - kb * nblk, k0 = kb * 32, n0 = nb * 32;
#pragma unroll 4
    for (int i = 0; i < 16; ++i) { const int kk = 2 * i + (lane >> 5); scr[kk * 33 + (lane & 31)] = W[(size_t)(k0 + kk) * N + n0 + (lane & 31)]; }
    asm volatile("s_waitcnt lgkmcnt(0)" ::: "memory");
    const int c = lane & 3;
#pragma unroll
    for (int j = 0; j < 2; ++j) { const int n = (lane >> 2) + 16 * j; const LAS float* s = scr + (8 * c) * 33 + n;
        u32x4 o; o.x = pkbf(s[0], s[33]); o.y = pkbf(s[66], s[99]); o.z = pkbf(s[132], s[165]); o.w = pkbf(s[198], s[231]);
        *(u32x4*)(WT + (size_t)(n0 + n) * pitch + k0 + 8 * c) = o; }
    asm volatile("s_waitcnt lgkmcnt(0)" ::: "memory");
}
__device__ __forceinline__ void zero_region(bf16* p, int pitch, int r0, int r1, int c0, int c1, int gt, int ngt) {
    const int cw = (c1 - c0) >> 3, n = (r1 - r0) * cw;
    for (int i = gt; i < n; i += ngt) { const int r = r0 + i / cw, c = c0 + (i % cw) * 8; *(u32x4*)(p + (size_t)r * pitch + c) = (u32x4){0u, 0u, 0u, 0u}; }
}
__device__ __forceinline__ void rms_row_bf16(const float* xrow, const float* gain, bf16* orow, int lane) {
    const f32x4* xr = (const f32x4*)xrow + lane; const f32x4* gr = (const f32x4*)gain + lane;
    f32x4 v[4]; float s = 0.f;
#pragma unroll
    for (int j = 0; j < 4; ++j) { v[j] = xr[64 * j]; s += (v[j].x * v[j].x + v[j].y * v[j].y) + (v[j].z * v[j].z + v[j].w * v[j].w); }
    const float rstd = __builtin_amdgcn_rsqf(wave_sum(s) * (1.f / 1024.f) + 1e-5f);
    u32x2* o8 = (u32x2*)orow + lane;
#pragma unroll
    for (int j = 0; j < 4; ++j) { const f32x4 g = gr[64 * j]; u32x2 w; w.x = pkbf(v[j].x * rstd * g.x, v[j].y * rstd * g.y); w.y = pkbf(v[j].z * rstd * g.z, v[j].w * rstd * g.w); o8[64 * j] = w; }
}
__device__ __forceinline__ void rms_phase_bf16(const float* __restrict__ src, const float* __restrict__ gain, bf16* __restrict__ dst, int gw, int ngw, int lane) {
    const f32x4* gr = (const f32x4*)gain + lane;
    for (int m = 2 * gw; m < NTOK; m += 2 * ngw) {
        const f32x4* x0 = (const f32x4*)(src + (size_t)m * DM) + lane; const f32x4* x1 = x0 + DM / 4;
        f32x4 v[4], u[4]; float s = 0.f, t = 0.f;
#pragma unroll
        for (int j = 0; j < 4; ++j) { v[j] = x0[64 * j]; u[j] = x1[64 * j]; }
#pragma unroll
        for (int j = 0; j < 4; ++j) { s += (v[j].x * v[j].x + v[j].y * v[j].y) + (v[j].z * v[j].z + v[j].w * v[j].w); t += (u[j].x * u[j].x + u[j].y * u[j].y) + (u[j].z * u[j].z + u[j].w * u[j].w); }
        const float r0 = __builtin_amdgcn_rsqf(wave_sum(s) * (1.f / 1024.f) + 1e-5f), r1 = __builtin_amdgcn_rsqf(wave_sum(t) * (1.f / 1024.f) + 1e-5f);
        u32x2* o0 = (u32x2*)(dst + (size_t)m * DM) + lane; u32x2* o1 = o0 + DM / 4;
#pragma unroll
        for (int j = 0; j < 4; ++j) { const f32x4 g = gr[64 * j];
            u32x2 w; w.x = pkbf(v[j].x * r0 * g.x, v[j].y * r0 * g.y); w.y = pkbf(v[j].z * r0 * g.z, v[j].w * r0 * g.w); o0[64 * j] = w;
            u32x2 z; z.x = pkbf(u[j].x * r1 * g.x, u[j].y * r1 * g.y); z.y = pkbf(u[j].z * r1 * g.z, u[j].w * r1 * g.w); o1[64 * j] = z; }
    }
}
__device__ __forceinline__ void rms_phase_f32(const float* src, const float* gain, float* dst, int gw, int ngw, int lane) {
    const f32x4* gr = (const f32x4*)gain + lane;
    for (int m = 2 * gw; m < NTOK; m += 2 * ngw) {
        const f32x4* x0 = (const f32x4*)(src + (size_t)m * DM) + lane; const f32x4* x1 = x0 + DM / 4;
        f32x4 v[4], u[4]; float s = 0.f, t = 0.f;
#pragma unroll
        for (int j = 0; j < 4; ++j) { v[j] = x0[64 * j]; u[j] = x1[64 * j]; }
#pragma unroll
        for (int j = 0; j < 4; ++j) { s += (v[j].x * v[j].x + v[j].y * v[j].y) + (v[j].z * v[j].z + v[j].w * v[j].w); t += (u[j].x * u[j].x + u[j].y * u[j].y) + (u[j].z * u[j].z + u[j].w * u[j].w); }
        const float r0 = __builtin_amdgcn_rsqf(wave_sum(s) * (1.f / 1024.f) + 1e-5f), r1 = __builtin_amdgcn_rsqf(wave_sum(t) * (1.f / 1024.f) + 1e-5f);
        f32x4* o0 = (f32x4*)(dst + (size_t)m * DM) + lane; f32x4* o1 = o0 + DM / 4;
#pragma unroll
        for (int j = 0; j < 4; ++j) { const f32x4 g = gr[64 * j]; o0[64 * j] = v[j] * r0 * g; o1[64 * j] = u[j] * r1 * g; }
    }
}

__device__ __forceinline__ void xmix_phase(const float* __restrict__ h, const float* __restrict__ gain, const float* __restrict__ mu, bf16* __restrict__ X6, int gw, int ngw, int lane) {
    f32x4 g4[4], m6[6][4];
#pragma unroll
    for (int j = 0; j < 4; ++j) g4[j] = ((const f32x4*)gain + lane)[64 * j];
#pragma unroll
    for (int i = 0; i < 6; ++i) {
        const int mi = (i == 1) ? 2 : ((i == 2) ? 3 : ((i == 3) ? 1 : i));
#pragma unroll
        for (int j = 0; j < 4; ++j) m6[i][j] = ((const f32x4*)(mu + mi * DM) + lane)[64 * j];
    }
    for (int chunk = gw; chunk < NTOK / 32; chunk += ngw) {
        const int t0 = chunk * 32;
        f32x4 prev[4];
        if ((t0 & (SEQ - 1)) == 0) {
#pragma unroll
            for (int j = 0; j < 4; ++j) prev[j] = (f32x4){0.f, 0.f, 0.f, 0.f};
        } else {
            const f32x4* xr = (const f32x4*)(h + (size_t)(t0 - 1) * DM) + lane; float s = 0.f;
#pragma unroll
            for (int j = 0; j < 4; ++j) { prev[j] = xr[64 * j]; s += (prev[j].x * prev[j].x + prev[j].y * prev[j].y) + (prev[j].z * prev[j].z + prev[j].w * prev[j].w); }
            const float rstd = __builtin_amdgcn_rsqf(wave_sum(s) * (1.f / 1024.f) + 1e-5f);
#pragma unroll
            for (int j = 0; j < 4; ++j) prev[j] = prev[j] * rstd * g4[j];
        }
        f32x4 nx[4];
        { const f32x4* xr = (const f32x4*)(h + (size_t)t0 * DM) + lane;
#pragma unroll
          for (int j = 0; j < 4; ++j) nx[j] = xr[64 * j]; }
        for (int t = t0; t < t0 + 32; ++t) {
            f32x4 v[4]; float s = 0.f;
#pragma unroll
            for (int j = 0; j < 4; ++j) v[j] = nx[j];
            if (t + 1 < t0 + 32) { const f32x4* xr = (const f32x4*)(h + (size_t)(t + 1) * DM) + lane;
#pragma unroll
              for (int j = 0; j < 4; ++j) nx[j] = xr[64 * j]; }
#pragma unroll
            for (int j = 0; j < 4; ++j) s += (v[j].x * v[j].x + v[j].y * v[j].y) + (v[j].z * v[j].z + v[j].w * v[j].w);
            const float rstd = __builtin_amdgcn_rsqf(wave_sum(s) * (1.f / 1024.f) + 1e-5f);
#pragma unroll
            for (int j = 0; j < 4; ++j) v[j] = v[j] * rstd * g4[j];
#pragma unroll
            for (int i = 0; i < 6; ++i) {
                u32x2* o8 = (u32x2*)(X6 + (size_t)i * NTOK * DM + (size_t)t * DM) + lane;
#pragma unroll
                for (int j = 0; j < 4; ++j) { const f32x4 xx = v[j] + (prev[j] - v[j]) * m6[i][j]; u32x2 w; w.x = pkbf(xx.x, xx.y); w.y = pkbf(xx.z, xx.w); o8[64 * j] = w; }
            }
#pragma unroll
            for (int j = 0; j < 4; ++j) prev[j] = v[j];
        }
    }
}

__device__ __forceinline__ int crow(int r, int hi) { return (r & 3) + 8 * (r >> 2) + 4 * hi; }
__device__ __forceinline__ s16x4 vtr(const LAS unsigned char* p) {
    typedef short v4i16_t __attribute__((ext_vector_type(4)));
    return __builtin_bit_cast(s16x4, __builtin_amdgcn_ds_read_tr16_b64_v4i16((LAS v4i16_t*)p));
}
__device__ __forceinline__ bf16x8 vfrag(const LAS unsigned char* p, int row8) {
    const s16x4 lo = vtr(p), hi = vtr(p + row8);
    return (bf16x8){lo[0], lo[1], lo[2], lo[3], hi[0], hi[1], hi[2], hi[3]};
}
__device__ __forceinline__ bf16x8 packp(const f32x16& p, int b) {
    u32x4 w; w.x = pkbf(p[b], p[b + 1]); w.y = pkbf(p[b + 2], p[b + 3]); w.z = pkbf(p[b + 4], p[b + 5]); w.w = pkbf(p[b + 6], p[b + 7]);
    return __builtin_bit_cast(bf16x8, w);
}
__device__ __forceinline__ float max16(const f32x16& p) {
    float a = fmaxf(fmaxf(p[0], p[1]), fmaxf(p[2], p[3])), b = fmaxf(fmaxf(p[4], p[5]), fmaxf(p[6], p[7]));
    float c = fmaxf(fmaxf(p[8], p[9]), fmaxf(p[10], p[11])), d = fmaxf(fmaxf(p[12], p[13]), fmaxf(p[14], p[15]));
    return fmaxf(fmaxf(a, b), fmaxf(c, d));
}
__device__ __forceinline__ float sum16(const f32x16& p) {
    return ((p[0] + p[1]) + (p[2] + p[3])) + ((p[4] + p[5]) + (p[6] + p[7])) + ((p[8] + p[9]) + (p[10] + p[11])) + ((p[12] + p[13]) + (p[14] + p[15]));
}
__device__ __forceinline__ float other_half(float v) {
    const unsigned b = __float_as_uint(v);
    auto rr = __builtin_amdgcn_permlane32_swap(b, b, false, false);
    return __uint_as_float(((threadIdx.x & 32) != 0) ? rr[0] : rr[1]);
}
#define MFMA32(a, b, c) __builtin_amdgcn_mfma_f32_32x32x16_bf16((a), (b), (c), 0, 0, 0)

constexpr int KB_STR = 144, VB_STR = 320, KB_BYTES = 64 * KB_STR, VB_BYTES = 64 * VB_STR, BBUF = 2 * KB_BYTES + VB_BYTES;
constexpr int BX_OFF = 2 * BBUF;
__device__ __forceinline__ void diffattn_unit(const bf16* __restrict__ QKV, bf16* __restrict__ ATT, const float* subln, float lam, int b, int h, int qb, LAS unsigned char* lds) {
    int tid = threadIdx.x; asm volatile("" : "+v"(tid)); const int lane = tid & 63, wid = __builtin_amdgcn_readfirstlane(tid >> 6), c = wid >> 2, g = wid & 3, i32 = lane & 31, hi = lane >> 5;
    const size_t tok0 = (size_t)b * SEQ;
    const int qrow = qb * 128 + 32 * g + i32;
    bf16x8 qf[4];
    { const bf16* qp = QKV + (tok0 + qrow) * QKVC + 1536 + h * 128 + c * 64 + 8 * hi;
#pragma unroll
      for (int s = 0; s < 4; ++s) qf[s] = *(const bf16x8*)(qp + 16 * s); }
    const int krow = tid >> 3, kch = tid & 7;
    const bf16* ksrc = QKV + (tok0 + krow) * QKVC + 2048 + h * 128 + kch * 8;
    const int vrow0 = tid >> 4, vch = tid & 15;
    const bf16* vsrc = QKV + (tok0 + vrow0) * QKVC + 2560 + h * 128 + vch * 8;
    const int kdst = krow * KB_STR + kch * 16, vdst = vrow0 * VB_STR + vch * 16;
    const int NT = 2 * qb + 2;
    u32x4 rk0, rk1, rv0, rv1;
#define B_LOAD(t) do { const size_t o_ = (size_t)(t) * 64 * QKVC; rk0 = *(const u32x4*)(ksrc + o_); rk1 = *(const u32x4*)(ksrc + o_ + 64); rv0 = *(const u32x4*)(vsrc + o_); rv1 = *(const u32x4*)(vsrc + o_ + (size_t)32 * QKVC); } while (0)
#define B_STORE(buf) do { LAS unsigned char* b_ = lds + (buf) * BBUF; *(LAS u32x4*)(b_ + kdst) = rk0; *(LAS u32x4*)(b_ + KB_BYTES + kdst) = rk1; *(LAS u32x4*)(b_ + 2 * KB_BYTES + vdst) = rv0; *(LAS u32x4*)(b_ + 2 * KB_BYTES + vdst + 32 * VB_STR) = rv1; } while (0)
    B_LOAD(0);
    f32x16 o[4];
#pragma unroll
    for (int d = 0; d < 4; ++d) o[d] = (f32x16){};
    float m_ref = 0.f, l_run = 0.f;
    const int qmin = qb * 128 + 32 * g;
    const int lg = lane & 15, gg = (lane >> 4) & 1;
    const int voff = (4 * hi + (lg >> 2)) * VB_STR + (16 * gg + 4 * (lg & 3)) * 2;
    for (int t = 0; t < NT; ++t) {
        B_STORE(t & 1);
        __syncthreads();
        if (t + 1 < NT) B_LOAD(t + 1);
        const int k0 = 64 * t;
        if (k0 <= qmin + 31) {
            const LAS unsigned char* kb = lds + (t & 1) * BBUF + c * KB_BYTES;
            const LAS unsigned char* vb = lds + (t & 1) * BBUF + 2 * KB_BYTES + voff;
            f32x16 p0 = (f32x16){}, p1 = (f32x16){};
#pragma unroll
            for (int s = 0; s < 4; ++s) {
                const bf16x8 a0 = *(const LAS bf16x8*)(kb + i32 * KB_STR + 32 * s + 16 * hi);
                const bf16x8 a1 = *(const LAS bf16x8*)(kb + (32 + i32) * KB_STR + 32 * s + 16 * hi);
                p0 = MFMA32(a0, qf[s], p0); p1 = MFMA32(a1, qf[s], p1);
            }
            if (k0 + 63 > qmin) {
#pragma unroll
                for (int r = 0; r < 16; ++r) { const int kv = k0 + crow(r, hi); if (kv > qrow) p0[r] = -INFINITY; if (kv + 32 > qrow) p1[r] = -INFINITY; }
            }
            float mx = fmaxf(max16(p0), max16(p1));
            mx = fmaxf(mx, other_half(mx));
            if (t == 0) m_ref = mx;
            else if (__any(mx - m_ref > 8.f)) {
                const float dl = fmaxf(mx - m_ref, 0.f);
                m_ref += dl;
                const float alpha = __builtin_amdgcn_exp2f(-dl);
                l_run *= alpha;
#pragma unroll
                for (int d = 0; d < 4; ++d) o[d] = o[d] * alpha;
            }
#pragma unroll
            for (int r = 0; r < 16; ++r) { p0[r] = __builtin_amdgcn_exp2f(p0[r] - m_ref); p1[r] = __builtin_amdgcn_exp2f(p1[r] - m_ref); }
            l_run += sum16(p0) + sum16(p1);
#pragma unroll
            for (int s4 = 0; s4 < 4; ++s4) {
                const bf16x8 pfs = packp((s4 < 2) ? p0 : p1, 8 * (s4 & 1));
#pragma unroll
                for (int d = 0; d < 4; ++d) { const bf16x8 a = vfrag(vb + s4 * 16 * VB_STR + d * 64, 8 * VB_STR); o[d] = MFMA32(a, pfs, o[d]); }
                __builtin_amdgcn_sched_barrier(0);
            }
        }
    }
#undef B_LOAD
#undef B_STORE
    __syncthreads();
    float l_tot = l_run + __shfl_xor(l_run, 32);
    const float inv = 1.f / l_tot;
    LAS float* X = (LAS float*)(lds + BX_OFF) + g * 4096;
    if (c == 1) {
        const float sc = inv * lam;
#pragma unroll
        for (int d = 0; d < 4; ++d)
#pragma unroll
            for (int r = 0; r < 16; ++r) X[(32 * d + crow(r, hi)) * 32 + i32] = o[d][r] * sc;
    }
    __syncthreads();
    if (c == 0) {
        float ss = 0.f;
#pragma unroll
        for (int d = 0; d < 4; ++d)
#pragma unroll
            for (int r = 0; r < 16; ++r) { const float v = o[d][r] * inv - X[(32 * d + crow(r, hi)) * 32 + i32]; o[d][r] = v; ss += v * v; }
        ss += __shfl_xor(ss, 32);
        const float rs = (1.f / sqrtf(ss * (1.f / 128.f) + 1e-5f)) * 0.8f;
        bf16* op = ATT + (tok0 + qrow) * DM + 512 + h * 128;
#pragma unroll
        for (int d = 0; d < 4; ++d)
#pragma unroll
            for (int r4 = 0; r4 < 4; ++r4) {
                const int dv = 32 * d + 8 * r4 + 4 * hi; const f32x4 gn = *(const f32x4*)(subln + dv);
                u32x2 w; w.x = pkbf(o[d][4 * r4] * rs * gn.x, o[d][4 * r4 + 1] * rs * gn.y); w.y = pkbf(o[d][4 * r4 + 2] * rs * gn.z, o[d][4 * r4 + 3] * rs * gn.w);
                *(u32x2*)(op + dv) = w;
            }
    }
    __syncthreads();
}

constexpr int KA_STR = 144, VA_STR = 192, KA_BYTES = 384 * KA_STR, VA_BYTES = 384 * VA_STR;
__device__ __forceinline__ void dilattn_unit(const bf16* __restrict__ QKV, bf16* __restrict__ OAP, float* __restrict__ LSE, int b, int h, int dil, int res, int n, LAS unsigned char* lds) {
    int tid = threadIdx.x; asm volatile("" : "+v"(tid)); const int lane = tid & 63, wid = __builtin_amdgcn_readfirstlane(tid >> 6), i32 = lane & 31, hi = lane >> 5;
    const size_t tok0 = (size_t)b * SEQ;
    {
#pragma unroll
        for (int i = 0; i < 6; ++i) {
            const int e = tid + 512 * i, kr = e >> 3, ch = e & 7, j = 256 * n - 128 + kr;
            u32x4 kv = (u32x4){0u, 0u, 0u, 0u}, vv = kv;
            if (j >= 0) { const bf16* p = QKV + (tok0 + (size_t)j * dil + res) * QKVC + h * 64 + ch * 8; kv = *(const u32x4*)(p + 512); vv = *(const u32x4*)(p + 1024); }
            *(LAS u32x4*)(lds + kr * KA_STR + ch * 16) = kv;
            *(LAS u32x4*)(lds + KA_BYTES + kr * VA_STR + ch * 16) = vv;
        }
    }
    const int jq = 256 * n + 32 * wid + i32;
    const size_t qtok = tok0 + (size_t)jq * dil + res;
    bf16x8 qf[4];
    { const bf16* qp = QKV + qtok * QKVC + h * 64 + 8 * hi;
#pragma unroll
      for (int s = 0; s < 4; ++s) qf[s] = *(const bf16x8*)(qp + 16 * s); }
    __syncthreads();
    f32x16 p[5];
    const int ufirst = (n == 0) ? ((wid < 4) ? 4 - wid : 0) : 0;
#pragma unroll
    for (int u = 0; u < 5; ++u) {
        p[u] = (f32x16){};
        if (u >= ufirst) {
            const LAS unsigned char* kb = lds + (32 * (wid + u) + i32) * KA_STR + 16 * hi;
#pragma unroll
            for (int s = 0; s < 4; ++s) { const bf16x8 a = *(const LAS bf16x8*)(kb + 32 * s); p[u] = MFMA32(a, qf[s], p[u]); }
        } else {
#pragma unroll
            for (int r = 0; r < 16; ++r) p[u][r] = -INFINITY;
        }
    }
#pragma unroll
    for (int r = 0; r < 16; ++r) { const int kl = crow(r, hi); if (kl < i32) p[0][r] = -INFINITY; if (kl > i32) p[4][r] = -INFINITY; }
    float mx = fmaxf(fmaxf(fmaxf(max16(p[0]), max16(p[1])), fmaxf(max16(p[2]), max16(p[3]))), max16(p[4]));
    mx = fmaxf(mx, other_half(mx));
    float l = 0.f;
#pragma unroll
    for (int u = 0; u < 5; ++u) {
#pragma unroll
        for (int r = 0; r < 16; ++r) p[u][r] = __builtin_amdgcn_exp2f(p[u][r] - mx);
        l += sum16(p[u]);
    }
    l += __shfl_xor(l, 32);
    f32x16 o[2]; o[0] = (f32x16){}; o[1] = (f32x16){};
    const int lg = lane & 15, gg = (lane >> 4) & 1;
    const LAS unsigned char* vb = lds + KA_BYTES + (4 * hi + (lg >> 2)) * VA_STR + (16 * gg + 4 * (lg & 3)) * 2;
#pragma unroll
    for (int u = 0; u < 5; ++u) {
        if (u >= ufirst) {
#pragma unroll
            for (int s2 = 0; s2 < 2; ++s2) {
                const bf16x8 pf = packp(p[u], 8 * s2);
#pragma unroll
                for (int d = 0; d < 2; ++d) { const bf16x8 a = vfrag(vb + (32 * (wid + u) + 16 * s2) * VA_STR + d * 64, 8 * VA_STR); o[d] = MFMA32(a, pf, o[d]); }
            }
        }
    }
    const float inv = 1.f / l;
    const int pat = (dil == 1) ? 0 : ((dil == 4) ? 1 : 2);
    bf16* op = OAP + (size_t)pat * NTOK * 512 + qtok * 512 + h * 64;
#pragma unroll
    for (int d = 0; d < 2; ++d)
#pragma unroll
        for (int r4 = 0; r4 < 4; ++r4) {
            const int dv = 32 * d + 8 * r4 + 4 * hi;
            u32x2 w; w.x = pkbf(o[d][4 * r4] * inv, o[d][4 * r4 + 1] * inv); w.y = pkbf(o[d][4 * r4 + 2] * inv, o[d][4 * r4 + 3] * inv);
            *(u32x2*)(op + dv) = w;
        }
    if (hi == 0) LSE[(size_t)pat * NTOK * 8 + qtok * 8 + h] = mx + __builtin_amdgcn_logf(l);
    __syncthreads();
}

__device__ __forceinline__ void combine_phase(const bf16* __restrict__ OAP, const float* __restrict__ LSE, bf16* __restrict__ ATT, int gt, int ngt) {
    for (int i = gt; i < NTOK * 64; i += ngt) {
        const int tokh = i >> 3, ch = i & 7; const size_t tok = (size_t)(tokh >> 3); const int h = tokh & 7;
        const float l0 = LSE[tokh], l1 = LSE[(size_t)NTOK * 8 + tokh], l2 = LSE[(size_t)2 * NTOK * 8 + tokh];
        const float m = fmaxf(l0, fmaxf(l1, l2));
        float w0 = __builtin_amdgcn_exp2f(l0 - m), w1 = __builtin_amdgcn_exp2f(l1 - m), w2 = __builtin_amdgcn_exp2f(l2 - m);
        const float is = 1.f / (w0 + w1 + w2); w0 *= is; w1 *= is; w2 *= is;
        const size_t off = tok * 512 + h * 64 + ch * 8;
        const u32x4 a = *(const u32x4*)(OAP + off), bq = *(const u32x4*)(OAP + (size_t)NTOK * 512 + off), cq = *(const u32x4*)(OAP + (size_t)2 * NTOK * 512 + off);
        u32x4 o;
#pragma unroll
        for (int e = 0; e < 4; ++e) o[e] = pkbf(w0 * bflo(a[e]) + w1 * bflo(bq[e]) + w2 * bflo(cq[e]), w0 * bfhi(a[e]) + w1 * bfhi(bq[e]) + w2 * bfhi(cq[e]));
        *(u32x4*)(ATT + tok * DM + h * 64 + ch * 8) = o;
    }
}

constexpr int SC_T = 32, SC_VEC = SC_T * 64 * 4, SC_BUF = 6 * SC_VEC + 256;
constexpr int SC_BON = 2 * SC_BUF + 2 * SC_T * 64 * 4;
constexpr int SC_Y = 2 * SC_BUF;
template <int CTRL> __device__ __forceinline__ float dpp_add(float v) {
    const int m = __builtin_amdgcn_update_dpp(0, __float_as_int(v), CTRL, 0xf, 0xf, true);
    return v + __int_as_float(m);
}
#ifdef DBG_SHFL
__device__ __forceinline__ float red8(float v) { v += __shfl_xor(v, 1); v += __shfl_xor(v, 2); v += __shfl_xor(v, 4); return v; }
#else
__device__ __forceinline__ float red8(float v) { v = dpp_add<0xB1>(v); v = dpp_add<0x4E>(v); v = dpp_add<0x141>(v); return v; }
#endif
__device__ __forceinline__ float red16x2(float v0, float v1, bool odd) {
    const float keep = odd ? v1 : v0, send = odd ? v0 : v1;
    float x = keep + __int_as_float(__builtin_amdgcn_update_dpp(0, __float_as_int(send), 0xB1, 0xf, 0xf, true));
    x = dpp_add<0x4E>(x);
    x = dpp_add<0x124>(x);
    x = dpp_add<0x128>(x);
    return x;
}
__device__ __forceinline__ u32x2 ld8_agent(const void* p) {
    const unsigned long long v = __hip_atomic_load((const unsigned long long*)p, __ATOMIC_RELAXED, __HIP_MEMORY_SCOPE_AGENT);
    return __builtin_bit_cast(u32x2, v);
}
__device__ __forceinline__ unsigned short ld2_agent(const unsigned short* p) {
    const unsigned odd = (unsigned)(((size_t)p >> 1) & 1);
    const unsigned w = __hip_atomic_load((const unsigned*)(p - odd), __ATOMIC_RELAXED, __HIP_MEMORY_SCOPE_AGENT);
    return (unsigned short)(odd ? (w >> 16) : (w & 0xffffu));
}
__device__ __forceinline__ float wave_sum_dpp(float v) {
    v = dpp_add<0xB1>(v);
    v = dpp_add<0x4E>(v);
    v = dpp_add<0x124>(v);
    v = dpp_add<0x128>(v);
    v += __int_as_float(__builtin_amdgcn_update_dpp(0, __float_as_int(v), 0x142, 0xA, 0xF, false));
    v += __int_as_float(__builtin_amdgcn_update_dpp(0, __float_as_int(v), 0x143, 0xC, 0xF, false));
    return __int_as_float(__builtin_amdgcn_readlane(__float_as_int(v), 63));
}
struct ScanRegs { u32x2 r, k, v, a, w; };
__device__ __forceinline__ float red8x2(float v0, float v1, bool odd) {
    const float keep = odd ? v1 : v0, send = odd ? v0 : v1;
    float x = keep + __int_as_float(__builtin_amdgcn_update_dpp(0, __float_as_int(send), 0xB1, 0xf, 0xf, true));
    x = dpp_add<0x4E>(x);
    int t = __builtin_amdgcn_update_dpp(0, __float_as_int(x), 0x104, 0xf, 0x5, false);
    t = __builtin_amdgcn_update_dpp(t, __float_as_int(x), 0x114, 0xf, 0xA, false);
    return x + __int_as_float(t);
}
__device__ __forceinline__ float dot8(const f32x4& sa, const f32x4& sb, const f32x4& va, const f32x4& vb) {
    f32x2 acc = (f32x2){sa.x, sa.y} * (f32x2){va.x, va.y};
    acc = __builtin_elementwise_fma((f32x2){sa.z, sa.w}, (f32x2){va.z, va.w}, acc);
    acc = __builtin_elementwise_fma((f32x2){sb.x, sb.y}, (f32x2){vb.x, vb.y}, acc);
    acc = __builtin_elementwise_fma((f32x2){sb.z, sb.w}, (f32x2){vb.z, vb.w}, acc);
    asm volatile("" : "+v"(acc));
    return acc.x + acc.y;
}
__device__ __forceinline__ void scan_unit(const bf16* __restrict__ R, const bf16* __restrict__ Kb, const bf16* __restrict__ Vb, const unsigned short* __restrict__ W16, const bf16* __restrict__ Ab,
                                          const bf16* __restrict__ Gb, const float* k_k, const float* k_a, const float* r_k, const float* ln_w, const float* ln_b, bf16* __restrict__ Z,
                                          int b, int h, LAS unsigned char* lds) {
    int tid = threadIdx.x; asm volatile("" : "+v"(tid)); const int lane = tid & 63, wid = __builtin_amdgcn_readfirstlane(tid >> 6);
    const size_t tok0 = (size_t)b * SEQ;
    constexpr int NC = SEQ / SC_T;
    constexpr int SC_YB = SC_T * 64 * 4;
    if (wid >= 4) {
        const int ht = tid - 256, ptt = ht >> 4, pj0 = 4 * (ht & 15), pcol = h * 64 + pj0, hw = wid - 4;
        const f32x4 kk4 = *(const f32x4*)(k_k + pcol), ka4 = *(const f32x4*)(k_a + pcol), rk4 = *(const f32x4*)(r_k + pcol);
        const int col = h * 64 + lane;
        const float lnw = ln_w[col], lnb = ln_b[col];
        ScanRegs pr, pq;
#define S_LOAD1(P, c, TT) do { const size_t o_ = (tok0 + (size_t)(c) * SC_T + (TT)) * DM + pcol; P.r = ld8_agent(R + o_); P.k = ld8_agent(Kb + o_); P.v = ld8_agent(Vb + o_); P.a = ld8_agent(Ab + o_); P.w = ld8_agent(W16 + o_); } while (0)
#define S_PREP1(P, buf, TT, BIDX) do { \
        LAS unsigned char* b_ = lds + (buf) * SC_BUF; \
        const f32x4 r4 = {bflo(P.r[0]), bfhi(P.r[0]), bflo(P.r[1]), bfhi(P.r[1])}; \
        const f32x4 k4 = {bflo(P.k[0]), bfhi(P.k[0]), bflo(P.k[1]), bfhi(P.k[1])}; \
        const f32x4 v4 = {bflo(P.v[0]), bfhi(P.v[0]), bflo(P.v[1]), bfhi(P.v[1])}; \
        const f32x4 a4 = {bflo(P.a[0]), bfhi(P.a[0]), bflo(P.a[1]), bfhi(P.a[1])}; \
        const unsigned wx_ = P.w[0], wy_ = P.w[1]; \
        const pg8::f16x2 wlo_ = __builtin_bit_cast(pg8::f16x2, wx_); const pg8::f16x2 whi_ = __builtin_bit_cast(pg8::f16x2, wy_); \
        const f32x4 w4 = {__expf((float)wlo_.x), __expf((float)wlo_.y), __expf((float)whi_.x), __expf((float)whi_.y)}; \
        f32x4 kk = k4 * kk4; float ss = (kk.x * kk.x + kk.y * kk.y) + (kk.z * kk.z + kk.w * kk.w); \
        ss += __shfl_xor(ss, 1); ss += __shfl_xor(ss, 2); ss += __shfl_xor(ss, 4); ss += __shfl_xor(ss, 8); \
        kk = kk * fminf(__builtin_amdgcn_rsqf(ss), 1e12f); \
        const f32x4 km = k4 * (1.f + (a4 - 1.f) * ka4); \
        float bo = (r4.x * km.x * rk4.x + r4.y * km.y * rk4.y) + (r4.z * km.z * rk4.z + r4.w * km.w * rk4.w); \
        bo += __shfl_xor(bo, 1); bo += __shfl_xor(bo, 2); bo += __shfl_xor(bo, 4); bo += __shfl_xor(bo, 8); \
        const int eo_ = ((TT) * 64 + pj0) * 4; \
        *(LAS f32x4*)(b_ + 0 * SC_VEC + eo_) = r4; *(LAS f32x4*)(b_ + 1 * SC_VEC + eo_) = w4; *(LAS f32x4*)(b_ + 2 * SC_VEC + eo_) = km; \
        *(LAS f32x4*)(b_ + 3 * SC_VEC + eo_) = -kk; *(LAS f32x4*)(b_ + 4 * SC_VEC + eo_) = kk * a4; *(LAS f32x4*)(b_ + 5 * SC_VEC + eo_) = v4; \
        if ((ht & 15) == 0) *(LAS float*)(lds + SC_BON + (BIDX) * 128 + (TT) * 4) = bo; } while (0)
        S_LOAD1(pr, 0, ptt); S_LOAD1(pq, 0, ptt + 16); S_PREP1(pr, 0, ptt, 0); S_PREP1(pq, 0, ptt + 16, 0);
        __syncthreads();
        for (int c = 0; c <= NC; ++c) {
            if (c + 1 < NC) { S_LOAD1(pr, c + 1, ptt); S_LOAD1(pq, c + 1, ptt + 16); }
            if (c >= 1) {
                const int cp = c - 1;
                const LAS float* ybuf = (const LAS float*)(lds + SC_Y + (cp & 1) * SC_YB);
#pragma unroll
                for (int q = 0; q < SC_T / 4; ++q) {
                    const int tt = hw + 4 * q;
                    const float y = ybuf[tt * 64 + lane];
                    const float mean = wave_sum_dpp(y) * (1.f / 64.f); const float dy = y - mean;
                    const float var = wave_sum_dpp(dy * dy) * (1.f / 64.f);
                    const float yn = dy * __builtin_amdgcn_rsqf(var + 64e-5f) * lnw + lnb;
                    const size_t o_ = (tok0 + (size_t)cp * SC_T + tt) * DM + col;
                    const float bo = *(const LAS float*)(lds + SC_BON + (cp % 3) * 128 + tt * 4), vv = bf2f(ld2_agent(Vb + o_));
                    const float gt = bf2f(ld2_agent(Gb + o_));
                    const float outv = (yn + bo * vv) * gt;
                    Z[o_] = (bf16)(pkbf(outv, outv) & 0xffffu);
                }
            }
            if (c + 1 < NC) { const int bi_ = (c + 1) % 3; S_PREP1(pr, (c + 1) & 1, ptt, bi_); S_PREP1(pq, (c + 1) & 1, ptt + 16, bi_); }
            __syncthreads();
        }
#undef S_LOAD1
#undef S_PREP1
    } else {
        const int sq = lane & 7, si0 = 16 * wid + 2 * (lane >> 3), sj = 8 * sq;
        const bool odd = (sq & 1) != 0;
        f32x4 S0a = {0.f, 0.f, 0.f, 0.f}, S0b = S0a, S1a = S0a, S1b = S0a;
        __syncthreads();
        for (int c = 0; c <= NC; ++c) {
            if (c < NC) {
                const LAS unsigned char* bb = lds + (c & 1) * SC_BUF;
                LAS float* ybuf = (LAS float*)(lds + SC_Y + (c & 1) * SC_YB);
                const LAS unsigned char* vp_ = bb + sj * 4;
                const LAS unsigned char* vv_ = bb + 5 * SC_VEC + si0 * 4;
#define LD8(dstA, dstB, slot, TT) dstA = *(const LAS f32x4*)(vp_ + (slot) * SC_VEC + (TT) * 256); dstB = *(const LAS f32x4*)(vp_ + (slot) * SC_VEC + (TT) * 256 + 16)
                f32x4 rA, rB, wA, wB, kA, kB, aA, aB, bA, bB; f32x2 v2;
                LD8(rA, rB, 0, 0); LD8(wA, wB, 1, 0); LD8(kA, kB, 2, 0); LD8(aA, aB, 3, 0); LD8(bA, bB, 4, 0); v2 = *(const LAS f32x2*)(vv_);
#pragma unroll 2
                for (int tt = 0; tt < SC_T; ++tt) {
                    const int tn = (tt + 1) & (SC_T - 1);
                    f32x4 nrA, nrB, nwA, nwB, nkA, nkB, naA, naB, nbA, nbB;
                    LD8(nrA, nrB, 0, tn); LD8(nwA, nwB, 1, tn); LD8(nkA, nkB, 2, tn); LD8(naA, naB, 3, tn); LD8(nbA, nbB, 4, tn);
                    const f32x2 nv2 = *(const LAS f32x2*)(vv_ + tn * 256);
                    const float sx = red8x2(dot8(S0a, S0b, aA, aB), dot8(S1a, S1b, aA, aB), odd);
                    const float sa0 = __int_as_float(__builtin_amdgcn_update_dpp(0, __float_as_int(sx), 0x00, 0xf, 0xf, true));
                    const float sa1 = __int_as_float(__builtin_amdgcn_update_dpp(0, __float_as_int(sx), 0x55, 0xf, 0xf, true));
                    S0a = S0a * wA + (bA * sa0 + kA * v2.x); S0b = S0b * wB + (bB * sa0 + kB * v2.x);
                    S1a = S1a * wA + (bA * sa1 + kA * v2.y); S1b = S1b * wB + (bB * sa1 + kB * v2.y);
                    const float yx = red8x2(dot8(S0a, S0b, rA, rB), dot8(S1a, S1b, rA, rB), odd);
                    if (sq < 2) ybuf[tt * 64 + si0 + sq] = yx;
                    rA = nrA; rB = nrB; wA = nwA; wB = nwB; kA = nkA; kB = nkB; aA = naA; aB = naB; bA = nbA; bB = nbB; v2 = nv2;
                }
#undef LD8
            }
            __syncthreads();
        }
    }
    __syncthreads();
}

#ifdef DBG_CHECK
__device__ __forceinline__ unsigned hsh(unsigned x) { x ^= x >> 16; x *= 0x7feb352dU; x ^= x >> 15; x *= 0x846ca68bU; x ^= x >> 16; return x; }
__device__ __forceinline__ float dotcol(const bf16* arow, const float* W, int N, int c, int K, int lane) {
    float s = 0.f; for (int k = lane; k < K; k += 64) s += bf2f(arow[k]) * W[(size_t)k * N + c]; return wave_sum(s);
}
#define ERR_ACC(ref, fast) do { const float r_ = (ref), f_ = (fast); d2 += (r_ - f_) * (r_ - f_); r2 += r_ * r_; } while (0)
#define ERR_DONE(stage) do { d2 = wave_sum(d2); r2 = wave_sum(r2); if (lane == 0) CTLp[16 + (stage)] = sqrtf(d2 / fmaxf(r2, 1e-30f)); } while (0)
__device__ __forceinline__ void dbg_check(int ph, const Args* Ap, LAS unsigned char* lds, int lane) {
    asm volatile("" : "+s"(Ap)); const Args& A = *Ap; unsigned char* ws = A.ws; float* CTLp = (float*)(ws + WS_CTL);
    const bf16* HN = (const bf16*)(ws + WS_HN); const bf16* QKV = (const bf16*)(ws + WS_QKV); const bf16* ATT = (const bf16*)(ws + WS_ATT); const bf16* U = (const bf16*)(ws + WS_U);
    const bf16* X6 = (const bf16*)(ws + WS_X6); const bf16* TT = (const bf16*)(ws + WS_T); const bf16* RKV = (const bf16*)(ws + WS_RKV); const bf16* WAG = (const bf16*)(ws + WS_WAG); const bf16* Z = (const bf16*)(ws + WS_Z);
    const float* H = A.out; LAS float* sl = (LAS float*)lds;
    float d2 = 0.f, r2 = 0.f;
    if (ph == 1) {
        for (int smp = 0; smp < 48; ++smp) {
            const int t = hsh(smp) & 65535; int c = hsh(smp + 1000) % 3072; if (smp % 3 == 0) c = (c & ~63) | (hsh(smp + 7) & 15);
            const int sec = c / 512, hc = c & 63; const bf16* ar = HN + (size_t)t * DM;
            float v = dotcol(ar, A.attn_w_in, 3072, c, 1024, lane);
            if (sec != 2 && sec != 5 && hc < 16) { const float vp = dotcol(ar, A.attn_w_in, 3072, c ^ 8, 1024, lane); const float ang = (float)(t & 4095) * powf(500000.f, -(float)(hc & 7) / 8.f);
                v = (hc < 8) ? v * cosf(ang) - vp * sinf(ang) : v * cosf(ang) + vp * sinf(ang); }
            if (sec == 0 || sec == 3) v *= 0.125f * 1.4426950408889634f;
            if (lane == 0) ERR_ACC(v, bf2f(QKV[(size_t)t * QKVC + c]));
        }
        ERR_DONE(1);
    }
    if (ph == 2) {
        const float lam = CTLp[0];
        for (int smp = 0; smp < 7; ++smp) {
            int q = 0; if (smp == 1) q = 63; if (smp == 2) q = 64; if (smp == 3) q = 127; if (smp == 4) q = 128; if (smp == 5) q = 1000; if (smp == 6) q = 4095;
            const int b = hsh(smp + 50) & 15, h = hsh(smp + 60) & 3; const size_t tok0 = (size_t)b * SEQ;
            float mc[2], lc[2];
            for (int c = 0; c < 2; ++c) {
                const bf16* qp = QKV + (tok0 + q) * QKVC + 1536 + h * 128 + c * 64; float m = -INFINITY;
                for (int k = lane; k <= q; k += 64) { const bf16* kp = QKV + (tok0 + k) * QKVC + 2048 + h * 128 + c * 64; float s = 0.f; for (int d = 0; d < 64; ++d) s += bf2f(qp[d]) * bf2f(kp[d]); sl[c * 4096 + k] = s; m = fmaxf(m, s); }
#pragma unroll
                for (int o = 1; o < 64; o <<= 1) m = fmaxf(m, __shfl_xor(m, o));
                float l = 0.f; for (int k = lane; k <= q; k += 64) l += exp2f(sl[c * 4096 + k] - m);
                mc[c] = m; lc[c] = wave_sum(l);
            }
            asm volatile("s_waitcnt lgkmcnt(0)" ::: "memory");
            float o0 = 0.f, o1 = 0.f;
            for (int k = 0; k <= q; ++k) { const float a = exp2f(sl[k] - mc[0]) / lc[0] - lam * exp2f(sl[4096 + k] - mc[1]) / lc[1]; const bf16* vp = QKV + (tok0 + k) * QKVC + 2560 + h * 128; o0 += a * bf2f(vp[lane]); o1 += a * bf2f(vp[64 + lane]); }
            const float ss = wave_sum(o0 * o0 + o1 * o1), rs = 0.8f / sqrtf(ss / 128.f + 1e-5f);
            const bf16* ap = ATT + (tok0 + q) * DM + 512 + h * 128;
            ERR_ACC(o0 * rs * A.diff_subln[lane], bf2f(ap[lane])); ERR_ACC(o1 * rs * A.diff_subln[64 + lane], bf2f(ap[64 + lane]));
        }
        ERR_DONE(2);
    }
    if (ph == 3) {
        for (int smp = 0; smp < 10; ++smp) {
            int t = 0; if (smp == 1) t = 1; if (smp == 2) t = 127; if (smp == 3) t = 128; if (smp == 4) t = 129; if (smp == 5) t = 515; if (smp == 6) t = 2047; if (smp == 7) t = 2048; if (smp == 8) t = 4095; if (smp == 9) t = 3001;
            const int b = hsh(smp + 150) & 15, h = hsh(smp + 160) & 7; const size_t tok0 = (size_t)b * SEQ;
            const bf16* qp = QKV + (tok0 + t) * QKVC + h * 64; float m = -INFINITY;
            for (int e = lane; e < 387; e += 64) { const int pat = e / 129, mm = e % 129, dil = (pat == 0) ? 1 : ((pat == 1) ? 4 : 16), pos = t - mm * dil; float s = -INFINITY;
                if (pos >= 0) { const bf16* kp = QKV + (tok0 + pos) * QKVC + 512 + h * 64; s = 0.f; for (int d = 0; d < 64; ++d) s += bf2f(qp[d]) * bf2f(kp[d]); }
                sl[e] = s; m = fmaxf(m, s); }
#pragma unroll
            for (int o = 1; o < 64; o <<= 1) m = fmaxf(m, __shfl_xor(m, o));
            float l = 0.f; for (int e = lane; e < 387; e += 64) l += exp2f(sl[e] - m);
            l = wave_sum(l);
            asm volatile("s_waitcnt lgkmcnt(0)" ::: "memory");
            float o = 0.f;
            for (int e = 0; e < 387; ++e) { const int pat = e / 129, mm = e % 129, dil = (pat == 0) ? 1 : ((pat == 1) ? 4 : 16), pos = t - mm * dil; if (pos >= 0) o += exp2f(sl[e] - m) / l * bf2f(QKV[(tok0 + pos) * QKVC + 1024 + h * 64 + lane]); }
            ERR_ACC(o, bf2f(ATT[(tok0 + t) * DM + h * 64 + lane]));
        }
        ERR_DONE(3);
    }
    if (ph == 4) {
        for (int smp = 0; smp < 32; ++smp) { const int t = hsh(smp + 300) & 65535, c = hsh(smp + 400) & 1023;
            const float v = A.x[(size_t)t * DM + c] + dotcol(ATT + (size_t)t * DM, A.attn_w_out, 1024, c, 1024, lane); if (lane == 0) ERR_ACC(v, H[(size_t)t * DM + c]); }
        ERR_DONE(4);
    }
    if (ph == 6) {
        for (int smp = 0; smp < 32; ++smp) { const int t = hsh(smp + 500) & 65535, c = hsh(smp + 600) & 4095;
            float v = fmaxf(dotcol(HN + (size_t)t * DM, A.mlp_w1, 4096, c, 1024, lane), 0.f); v *= v; if (lane == 0) ERR_ACC(v, bf2f(U[(size_t)t * DFF + c])); }
        ERR_DONE(6);
    }
    if (ph == 8) {
        for (int smp = 0; smp < 12; ++smp) { int t = hsh(smp + 700) & 65535; if (smp == 0) t = 4096; if (smp == 1) t = 4095; if (smp == 2) t = 32; const int slot = smp % 6, mi = (slot == 1) ? 2 : ((slot == 2) ? 3 : ((slot == 3) ? 1 : slot));
            float s0 = 0.f, s1 = 0.f; const bool hp = (t & 4095) != 0;
            for (int k = lane; k < 1024; k += 64) { const float a = H[(size_t)t * DM + k]; s0 += a * a; if (hp) { const float p = H[(size_t)(t - 1) * DM + k]; s1 += p * p; } }
            const float r0 = 1.f / sqrtf(wave_sum(s0) / 1024.f + 1e-5f), r1 = 1.f / sqrtf(wave_sum(s1) / 1024.f + 1e-5f);
            for (int k = lane; k < 1024; k += 64) { const float g = A.norm_mix[DM + k]; const float hn = H[(size_t)t * DM + k] * r0 * g, hpv = hp ? H[(size_t)(t - 1) * DM + k] * r1 * g : 0.f;
                ERR_ACC(hn + (hpv - hn) * A.rwkv_mu[mi * DM + k], bf2f(X6[(size_t)slot * NTOK * DM + (size_t)t * DM + k])); } }
        ERR_DONE(8);
    }
    if (ph == 9) {
        for (int smp = 0; smp < 30; ++smp) { const int t = hsh(smp + 800) & 65535, wh = smp % 3, nn = (wh == 2) ? 160 : 64, c = hsh(smp + 900) % nn;
            const float* W = (wh == 0) ? A.rwkv_w1 : ((wh == 1) ? A.rwkv_a1 : A.rwkv_g1);
            float v = dotcol(X6 + (size_t)(3 + wh) * NTOK * DM + (size_t)t * DM, W, nn, c, 1024, lane); if (wh == 0) v = tanhf(v); if (wh == 2) v = 1.f / (1.f + expf(-v));
            if (lane == 0) ERR_ACC(v, bf2f(TT[(size_t)wh * NTOK * 256 + (size_t)t * 256 + c])); }
        ERR_DONE(9);
    }
    if (ph == 10) {
        for (int smp = 0; smp < 30; ++smp) { const int t = hsh(smp + 1100) & 65535, wh = smp % 3, c = hsh(smp + 1200) & 1023;
            const float* W = (wh == 0) ? A.rwkv_w_r : ((wh == 1) ? A.rwkv_w_k : A.rwkv_w_v);
            const float v = dotcol(X6 + (size_t)wh * NTOK * DM + (size_t)t * DM, W, 1024, c, 1024, lane); if (lane == 0) ERR_ACC(v, bf2f(RKV[(size_t)wh * NTOK * DM + (size_t)t * DM + c])); }
        ERR_DONE(10);
    }
    if (ph == 11) {
        for (int smp = 0; smp < 30; ++smp) { const int t = hsh(smp + 1300) & 65535, wh = smp % 3, kk = (wh == 2) ? 160 : 64, c = hsh(smp + 1400) & 1023;
            const float* W = (wh == 0) ? A.rwkv_w2 : ((wh == 1) ? A.rwkv_a2 : A.rwkv_g2);
            float v = dotcol(TT + (size_t)wh * NTOK * 256 + (size_t)t * 256, W, 1024, c, kk, lane); float f;
            const unsigned short raw = WAG[(size_t)wh * NTOK * DM + (size_t)t * DM + c];
            if (wh == 0) { const float z = A.rwkv_w0[c] + v; const float sp = fmaxf(-z, 0.f) + log1pf(expf(-fabsf(z))); v = -expf(-sp - 0.5f); f = (float)__builtin_bit_cast(_Float16, raw); }
            else if (wh == 1) { v = 1.f / (1.f + expf(-(A.rwkv_a0[c] + v))); f = bf2f(raw); } else f = bf2f(raw);
            if (lane == 0) ERR_ACC(v, f); }
        ERR_DONE(11);
    }
    if (ph == 12) {
        float ed[5] = {0.f, 0.f, 0.f, 0.f, 0.f}, er[5] = {0.f, 0.f, 0.f, 0.f, 0.f};
#pragma unroll
        for (int smp = 0; smp < 3; ++smp) {
            const int b = 0, h = smp; const size_t tok0 = (size_t)b * SEQ; const int col = h * 64 + lane;
            LAS float* sv = sl + 4096;
            for (int i = 0; i < 64; ++i) sl[i * 64 + lane] = 0.f;
            for (int t = 0; t < 40; ++t) {
                const size_t o = (tok0 + t) * DM + col;
                const float r = bf2f(RKV[o]), k = bf2f(RKV[(size_t)NTOK * DM + o]), v = bf2f(RKV[2 * (size_t)NTOK * DM + o]);
                const float w = expf((float)__builtin_bit_cast(_Float16, (unsigned short)WAG[o])), a = bf2f(WAG[(size_t)NTOK * DM + o]);
                float kk = k * A.rwkv_k_k[col]; kk = kk / fmaxf(sqrtf(wave_sum(kk * kk)), 1e-12f);
                const float km = k * (1.f + (a - 1.f) * A.rwkv_k_a[col]);
                float yl = 0.f;
                sv[lane] = v; asm volatile("s_waitcnt lgkmcnt(0)" ::: "memory");
#pragma unroll 1
                for (int i = 0; i < 64; ++i) { float st = sl[i * 64 + lane]; const float sa = wave_sum(st * (-kk)); st = st * w + sa * (kk * a) + sv[i] * km; sl[i * 64 + lane] = st; const float y = wave_sum(st * r); if (lane == i) yl = sa; }
                const float bonus = wave_sum(r * km * A.rwkv_r_k[col]);
                const float f_ = bf2f(Z[o]);
                if (smp == 0) { const float dd = (yl - f_) * (yl - f_), rr = yl * yl; if (t == 1) { ed[0] += 36.f * dd; er[0] += rr; } if (t == 2) { ed[3] += 36.f * dd; er[3] += rr; } if (t < 32) { ed[4] += dd; er[4] += rr; } }
                if (smp == 1) { ed[1] += (1.f - w - f_) * (1.f - w - f_); er[1] += (1.f - w) * (1.f - w); }
                if (smp == 2) { ed[2] += (kk * a - f_) * (kk * a - f_); er[2] += kk * a * kk * a; }
            }
        }
#pragma unroll
        for (int q = 0; q < 5; ++q) { d2 = ed[q]; r2 = er[q]; ERR_DONE(12 + q); }
    }
    if (ph == 13) {
    }
}
#endif
#define AS4 __attribute__((address_space(4)))
__device__ __forceinline__ const unsigned char AS4* kargs() { const unsigned char AS4* p = (const unsigned char AS4*)__builtin_amdgcn_kernarg_segment_ptr(); asm volatile("" : "+s"(p)); return p; }
#define KA(member) (*(decltype(Args::member) const AS4*)(kargs() + offsetof(Args, member)))
#define WSB(off) ((bf16*)(KA(ws) + (off)))
#define P_W_IN WSB(WS_WIN)
#define P_W_OUT WSB(WS_WOUT)
#define P_W1_0 WSB(WS_W1_0)
#define P_W2_0 WSB(WS_W2_0)
#define P_W1_1 WSB(WS_W1_1)
#define P_W2_1 WSB(WS_W2_1)
#define P_WR WSB(WS_WR)
#define P_WK WSB(WS_WK)
#define P_WV WSB(WS_WV)
#define P_WO WSB(WS_WO)
#define P_LW1 WSB(WS_LW1)
#define P_LA1 WSB(WS_LA1)
#define P_LG1 WSB(WS_LG1)
#define P_LW2 WSB(WS_LW2)
#define P_LA2 WSB(WS_LA2)
#define P_LG2 WSB(WS_LG2)
#define P_HN WSB(WS_HN)
#define P_QKV WSB(WS_QKV)
#define P_ATT WSB(WS_ATT)
#define P_OAP WSB(WS_OAP)
#define P_U WSB(WS_U)
#define P_X6 WSB(WS_X6)
#define P_TT WSB(WS_T)
#define P_RKV WSB(WS_RKV)
#define P_WAG WSB(WS_WAG)
#define P_Z WSB(WS_Z)
#define P_ROPE ((float*)(KA(ws) + WS_ROPE))
#define P_CTL ((float*)(KA(ws) + WS_CTL))
#define P_LSE ((float*)(KA(ws) + WS_LSE))
#define P_H (KA(out))
__global__ void __launch_bounds__(NTHR, 2) hybrid_fwd(Args A_unused) {
    extern __shared__ __attribute__((aligned(16))) unsigned char lds_raw[];
    LAS unsigned char* lds = (LAS unsigned char*)lds_raw;
    cg::grid_group grid = cg::this_grid();
    { int t0_ = threadIdx.x; asm volatile("" : "+v"(t0_)); if (t0_ < 2) ((LAS unsigned*)(lds + LDS_BARST))[t0_] = 0u; }
    __syncthreads();
    (void)xcd_barrier_post((unsigned*)(KA(ws) + WS_BAR), (volatile LAS unsigned*)(lds + LDS_BARST));
    const int G = gridDim.x, bx = blockIdx.x, ngw = G * NWAVES, ngt = G * NTHR;
#define TIDV int tid = threadIdx.x; asm volatile("" : "+v"(tid)); const int lane = tid & 63, wave = __builtin_amdgcn_readfirstlane(tid >> 6), gw = bx * NWAVES + wave, gt = bx * NTHR + tid; (void)lane; (void)gw; (void)gt;
    constexpr int lo = 0, hi = 18;
    int ph = 0;
#define PHASE_BEGIN if (ph >= lo && ph < hi) { TIDV
#ifdef DBG_CHECK
#define PHASE_END   } grid.sync(); { int t2_ = threadIdx.x; asm volatile("" : "+v"(t2_)); if (bx == 0 && t2_ < 64) dbg_check(ph, (const Args*)(const void*)__builtin_amdgcn_kernarg_segment_ptr(), lds, t2_); } grid.sync(); ++ph;
#else
#define PHASE_END   if (ph + 1 < hi) { if (ph == 0) grid.sync(); else { XcdBarrier xb_; xb_.bar = (unsigned*)(KA(ws) + WS_BAR); xb_.x = xb_xcc_id(); xb_.st = (volatile LAS unsigned*)(lds + LDS_BARST); xcd_barrier(xb_); } } } ++ph;
#endif
#define GEMM(EPI, Aptr, Bptr, N_, K_, ...) do { pg8::Gemm g_{(const pg8::bf16_t*)(Aptr), (const pg8::bf16_t*)(Bptr), NTOK, (N_), (K_)}; pg8::StaticOrder S_; S_.init(NTOK, (N_), G, bx); \
        EPI E_{__VA_ARGS__}; pg8::gemm_phase<EPI, pg8::StaticOrder, true, true>(lds, g_, S_, E_); } while (0)

    PHASE_BEGIN
    {
        LAS float* scr = (LAS float*)(lds + wave * 8192);
        int it0 = gw;
#define TJOB(W, K_, N_, WT, PITCH) { const int ni_ = ((K_) / 32) * ((N_) / 32); for (; it0 < ni_; it0 += ngw) transpose_item((W), (N_), (WT), (PITCH), scr, it0, lane); it0 -= ni_; }
        TJOB(KA(attn_w_in), 1024, 3072, P_W_IN, 1024)
        TJOB(KA(attn_w_out), 1024, 1024, P_W_OUT, 1024)
        TJOB(KA(mlp_w1), 1024, 4096, P_W1_0, 1024)
        TJOB(KA(mlp_w1) + (size_t)1024 * 4096, 1024, 4096, P_W1_1, 1024)
        TJOB(KA(mlp_w2), 4096, 1024, P_W2_0, 4096)
        TJOB(KA(mlp_w2) + (size_t)4096 * 1024, 4096, 1024, P_W2_1, 4096)
        TJOB(KA(rwkv_w_r), 1024, 1024, P_WR, 1024)
        TJOB(KA(rwkv_w_k), 1024, 1024, P_WK, 1024)
        TJOB(KA(rwkv_w_v), 1024, 1024, P_WV, 1024)
        TJOB(KA(rwkv_w_o), 1024, 1024, P_WO, 1024)
        TJOB(KA(rwkv_w1), 1024, 64, P_LW1, 1024)
        TJOB(KA(rwkv_a1), 1024, 64, P_LA1, 1024)
        TJOB(KA(rwkv_g1), 1024, 160, P_LG1, 1024)
        TJOB(KA(rwkv_w2), 64, 1024, P_LW2, 256)
        TJOB(KA(rwkv_a2), 64, 1024, P_LA2, 256)
        TJOB(KA(rwkv_g2), 160, 1024, P_LG2, 256)
#undef TJOB
        zero_region(P_LW1, 1024, 64, 256, 0, 1024, gt, ngt); zero_region(P_LA1, 1024, 64, 256, 0, 1024, gt, ngt); zero_region(P_LG1, 1024, 160, 256, 0, 1024, gt, ngt);
        zero_region(P_LW2, 256, 0, 1024, 64, 256, gt, ngt); zero_region(P_LA2, 256, 0, 1024, 64, 256, gt, ngt); zero_region(P_LG2, 256, 0, 1024, 160, 256, gt, ngt);
        for (int i = gt; i < 4096 * 8; i += ngt) {
            const int pos = i >> 3, f = i & 7;
            const float invf = (float)exp(-(double)f * 0.125 * log(500000.0));
            const float ang = (float)pos * invf;
            P_ROPE[pos * 16 + f] = (float)cos((double)ang); P_ROPE[pos * 16 + 8 + f] = (float)sin((double)ang);
        }
        if (bx == 0 && wave == 0) {
            const float* lp = KA(diff_lambda);
            const float s01 = wave_sum(lp[lane] * lp[64 + lane]), s23 = wave_sum(lp[128 + lane] * lp[192 + lane]);
            if (lane == 0) P_CTL[0] = expf(s01) - expf(s23) + 0.2f;
        }
        rms_phase_bf16(KA(x), KA(norm_mix), P_HN, gw, ngw, lane);
    }
    PHASE_END
    PHASE_BEGIN
    GEMM(pg8::Epi16<pg8::M_QKV>, P_HN, P_W_IN, QKVC, 1024, P_QKV, QKVC, P_ROPE);
    PHASE_END
    PHASE_BEGIN
    {
        const float lam = P_CTL[0];
        for (int rep_ = 0; rep_ < REP_ATTN; ++rep_)
        for (int u = bx; u < 2048; u += G) {
            const int i = u >> 8, cidx = u & 255, bh = cidx >> 2, s = (cidx & 3) * 4 + (i >> 1), qb = (i & 1) ? 31 - s : s;
            diffattn_unit(P_QKV, P_ATT, KA(diff_subln), lam, bh >> 2, bh & 3, qb, lds);
        }
        for (int rep_ = 0; rep_ < REP_ATTNA; ++rep_)
        for (int v = bx; v < 6144; v += G) {
            const int bh = v / 48, r48 = v - bh * 48, pat = r48 >> 4, q16 = r48 & 15;
            const int dil = (pat == 0) ? 1 : ((pat == 1) ? 4 : 16);
            const int nper = 16 / dil;
            const int res = q16 / nper, n = q16 - res * nper;
            dilattn_unit(P_QKV, P_OAP, P_LSE, bh >> 3, bh & 7, dil, res, n, lds);
        }
    }
    PHASE_END
    PHASE_BEGIN
    combine_phase(P_OAP, P_LSE, P_ATT, gt, ngt);
    PHASE_END
    PHASE_BEGIN
    GEMM(pg8::EpiRes, P_ATT, P_W_OUT, 1024, 1024, KA(x), P_H, DM);
    PHASE_END
    PHASE_BEGIN
    for (int rep_ = 0; rep_ < REP_RMS; ++rep_)
    rms_phase_bf16(P_H, KA(norm_mlp), P_HN, gw, ngw, lane);
    PHASE_END
    PHASE_BEGIN
    for (int rep_ = 0; rep_ < REP_UP; ++rep_)
    GEMM(pg8::Epi16<pg8::M_RELU2>, P_HN, P_W1_0, DFF, 1024, P_U, DFF, nullptr);
    PHASE_END
    PHASE_BEGIN
    GEMM(pg8::EpiRes, P_U, P_W2_0, 1024, DFF, P_H, P_H, DM);
    PHASE_END
    PHASE_BEGIN
    for (int rep_ = 0; rep_ < REP_XMIX; ++rep_)
    xmix_phase(P_H, KA(norm_mix) + DM, KA(rwkv_mu), P_X6, gw, ngw, lane);
    PHASE_END
    PHASE_BEGIN
    for (int rep_ = 0; rep_ < REP_LORA; ++rep_) {
    GEMM(pg8::Epi16<pg8::M_TANH>, P_X6 + 3 * (size_t)NTOK * DM, P_LW1, 256, 1024, P_TT, 256, nullptr);
    GEMM(pg8::Epi16<pg8::M_PLAIN>, P_X6 + 4 * (size_t)NTOK * DM, P_LA1, 256, 1024, P_TT + (size_t)NTOK * 256, 256, nullptr);
    GEMM(pg8::Epi16<pg8::M_SIGMOID>, P_X6 + 5 * (size_t)NTOK * DM, P_LG1, 256, 1024, P_TT + (size_t)2 * NTOK * 256, 256, nullptr); }
    PHASE_END
    PHASE_BEGIN
    GEMM(pg8::Epi16<pg8::M_PLAIN>, P_X6, P_WR, 1024, 1024, P_RKV, DM, nullptr);
    GEMM(pg8::Epi16<pg8::M_PLAIN>, P_X6 + (size_t)NTOK * DM, P_WK, 1024, 1024, P_RKV + (size_t)NTOK * DM, DM, nullptr);
    GEMM(pg8::Epi16<pg8::M_PLAIN>, P_X6 + 2 * (size_t)NTOK * DM, P_WV, 1024, 1024, P_RKV + 2 * (size_t)NTOK * DM, DM, nullptr);
    PHASE_END
    PHASE_BEGIN
    for (int rep_ = 0; rep_ < REP_LORA; ++rep_) {
    GEMM(pg8::Epi16<pg8::M_WLOG>, P_TT, P_LW2, 1024, 256, P_WAG, DM, KA(rwkv_w0));
    GEMM(pg8::Epi16<pg8::M_ASIG>, P_TT + (size_t)NTOK * 256, P_LA2, 1024, 256, P_WAG + (size_t)NTOK * DM, DM, KA(rwkv_a0));
    GEMM(pg8::Epi16<pg8::M_PLAIN>, P_TT + (size_t)2 * NTOK * 256, P_LG2, 1024, 256, P_WAG + 2 * (size_t)NTOK * DM, DM, nullptr); }
    PHASE_END
    PHASE_BEGIN
    for (int rep_ = 0; rep_ < REP_SCAN; ++rep_)
    for (int u = bx; u < 256; u += G)
        scan_unit(P_RKV, P_RKV + (size_t)NTOK * DM, P_RKV + 2 * (size_t)NTOK * DM, (const unsigned short*)P_WAG, P_WAG + (size_t)NTOK * DM, P_WAG + 2 * (size_t)NTOK * DM,
                  KA(rwkv_k_k), KA(rwkv_k_a), KA(rwkv_r_k), KA(rwkv_ln_w), KA(rwkv_ln_b), P_Z, u >> 4, u & 15, lds);
    PHASE_END
    PHASE_BEGIN
    GEMM(pg8::EpiRes, P_Z, P_WO, 1024, 1024, P_H, P_H, DM);
    PHASE_END
    PHASE_BEGIN
    rms_phase_bf16(P_H, KA(norm_mlp) + DM, P_HN, gw, ngw, lane);
    PHASE_END
    PHASE_BEGIN
    GEMM(pg8::Epi16<pg8::M_RELU2>, P_HN, P_W1_1, DFF, 1024, P_U, DFF, nullptr);
    PHASE_END
    PHASE_BEGIN
    GEMM(pg8::EpiRes, P_U, P_W2_1, 1024, DFF, P_H, P_H, DM);
    PHASE_END
    PHASE_BEGIN
    rms_phase_f32(P_H, KA(norm_final), P_H, gw, ngw, lane);
    PHASE_END
#ifdef DBG_CHECK
    { TIDV
      const float* CTLp = P_CTL; int bad = 0; float ev = 0.f;
      for (int k = 1; k < 20; ++k) { const float e = CTLp[16 + k]; if (bad == 0 && !(e < 0.03f)) { bad = k; ev = (e == e) ? e : 9.99f; } }
      if (bad) { float* o = P_H; const float c = sqrtf(10.f * (float)bad); for (size_t i = gt; i < (size_t)NTOK * DM; i += ngt) o[i] = c; if (gt == 0) o[0] = 1000.f * ev; } }
#endif
}
constexpr int N_PHASES = 18;

extern "C" void kernel_launch(void* const* d_in, const int* in_sizes, int n_in, void* d_out, int out_size, void* d_ws, size_t ws_size, hipStream_t stream) {
    static int grid = 0;
    if (grid == 0) {
        if (n_in != 28 || in_sizes[0] != NTOK * DM || out_size != NTOK * DM || ws_size < WS_END) { fprintf(stderr, "kernel_launch: unexpected shapes (n_in %d, ws %zu)\n", n_in, ws_size); grid = -1; return; }
        int dev = 0, cus = 0, per_cu = 0;
        hipGetDevice(&dev); hipDeviceGetAttribute(&cus, hipDeviceAttributeMultiprocessorCount, dev);
        if (hipFuncSetAttribute((const void*)hybrid_fwd, hipFuncAttributeMaxDynamicSharedMemorySize, LDS_BYTES) != hipSuccess) { fprintf(stderr, "kernel_launch: hipFuncSetAttribute failed\n"); grid = -1; return; }
        hipOccupancyMaxActiveBlocksPerMultiprocessor(&per_cu, (const void*)hybrid_fwd, NTHR, LDS_BYTES);
        (void)hipGetLastError();
        if (per_cu < 1) per_cu = 1;
        grid = cus * per_cu;
        fprintf(stderr, "kernel_launch: %d CUs x %d -> grid %d\n", cus, per_cu, grid);
    }
    if (grid < 0) return;
    if (hipMemsetAsync(d_ws, 0, CTL_ZERO_BYTES, stream) != hipSuccess) { fprintf(stderr, "kernel_launch: hipMemsetAsync failed\n"); return; }
    Args a{};
    const float** fp = (const float**)&a;
    for (int i = 0; i < 28; ++i) fp[i] = (const float*)d_in[i];
    a.out = (float*)d_out; a.ws = (unsigned char*)d_ws; a.ph_lo = 0; a.ph_hi = N_PHASES;
    void* args[] = {&a};
    hipError_t e = hipLaunchCooperativeKernel((const void*)hybrid_fwd, dim3(grid), dim3(NTHR), args, LDS_BYTES, stream);
    if (e != hipSuccess) fprintf(stderr, "cooperative launch failed: %s (grid %d)\n", hipGetErrorString(e), grid);
}
```
